# Optimizing an MI355X kernel written in HIP

```python
import jax, jax.numpy as jnp
from jax import lax
import numpy as np

D_MODEL = 4096
BATCH = 16
SEQ = 256
DEPTH = 2
DEC_BATCH = 4
DEC_SEQ = 2048
PAST_LEN = 256

GRID_W = 64
Q_BLOCK = 128
ROPE_THETA = 10000.0
NORM_EPS = 1e-6
N_EVEN = (DEPTH + 1) // 2
N_ODD = DEPTH // 2

A_WIDTH = D_MODEL // 2
A_HEAD = 64
A_HEADS = A_WIDTH // A_HEAD
A_DECAY_LORA = 128
A_ICLR_LORA = 128
A_LORA_COLS = 2 * (A_DECAY_LORA + A_ICLR_LORA)
A_SHIFT = 3 * A_WIDTH + A_LORA_COLS
A_GN_EPS = 64e-5
B_HEAD = 128
B_Q_HEADS = (D_MODEL // 2) // B_HEAD
B_KV_HEADS = 4
B_GROUP = B_Q_HEADS // B_KV_HEADS
B_WIDTH = B_Q_HEADS * B_HEAD
B_KV_WIDTH = B_KV_HEADS * B_HEAD
AB_IN = A_SHIFT + A_WIDTH + 2 * B_WIDTH + 2 * B_KV_WIDTH
C_HEADS = 64
C_NOPE = 128
C_ROPE = 64
C_V = 128
C_Q_LORA = 1536
C_KV_LORA = 512
C_WIDTH = C_HEADS * C_V
C_IN = C_Q_LORA + C_KV_LORA + C_ROPE + C_WIDTH

kernel_name = "hybrid_rwkv7_gqa_mla_diffusion_step"


def rms_norm(x, g, eps=NORM_EPS):
    xf = x.astype(jnp.float32)
    y = xf * lax.rsqrt(jnp.mean(xf * xf, axis=-1, keepdims=True) + eps)
    return y.astype(x.dtype) * g


def split_cols(a, sizes):
    idx = np.cumsum(sizes)[:-1].tolist()
    return jnp.split(a, idx, axis=-1)


def centred_shift(p):
    prev = jnp.pad(p[:, :-1], ((0, 0), (1, 0), (0, 0)))
    nxt = jnp.pad(p[:, 1:], ((0, 0), (0, 1), (0, 0)))
    return 0.5 * (prev + nxt)


def axial_rope_tables(n_tokens, rot_dim, dtype):
    rows = n_tokens // GRID_W
    row = jnp.repeat(jnp.arange(rows, dtype=jnp.float32), GRID_W)
    col = jnp.tile(jnp.arange(GRID_W, dtype=jnp.float32), rows)
    n_freq = rot_dim // 4
    inv_freq = ROPE_THETA ** (-jnp.arange(n_freq, dtype=jnp.float32) / n_freq)
    ang = jnp.concatenate([row[:, None] * inv_freq, col[:, None] * inv_freq], axis=-1)
    return jnp.cos(ang).astype(dtype), jnp.sin(ang).astype(dtype)


def apply_rope(x, cos, sin):
    x2 = x.reshape(*x.shape[:-1], -1, 2)
    xr, xi = x2[..., 0], x2[..., 1]
    return jnp.stack([xr * cos - xi * sin, xr * sin + xi * cos], axis=-1).reshape(x.shape)


def blocked_attention(q_parts, score_fn, v, scale):
    Bn, Tq = q_parts[0].shape[:2]
    nb = Tq // Q_BLOCK
    qb = tuple(jnp.moveaxis(a.reshape(Bn, nb, Q_BLOCK, *a.shape[2:]), 1, 0) for a in q_parts)

    def one_block(blk):
        s = score_fn(blk).astype(jnp.float32) * scale
        p = jax.nn.softmax(s, axis=-1).astype(v.dtype)
        return jnp.einsum('bhgqk,bkhd->bqhgd', p, v)

    o = lax.map(one_block, qb)
    return jnp.moveaxis(o, 0, 1).reshape(Bn, Tq, -1)


def rwkv7_scan(s0, r, w, k, v, kk, a, reverse):
    xs = tuple(jnp.moveaxis(t, 1, 0) for t in (r, w, k, v, kk, a))

    def step(S, inp):
        r_t, w_t, k_t, v_t, kk_t, a_t = inp
        sa = jnp.einsum('bhij,bhj->bhi', S, -kk_t)
        S = (S * w_t[:, :, None, :] + sa[..., None] * (kk_t * a_t)[:, :, None, :]
             + v_t[..., None] * k_t[:, :, None, :])
        return S, jnp.einsum('bhij,bhj->bhi', S, r_t)

    s_fin, ys = lax.scan(step, s0, xs, reverse=reverse)
    return s_fin, jnp.moveaxis(ys, 0, 1)


def rwkv7_mixer(r, k, v, lora, p, s0):
    Bn, T, _ = r.shape
    f32 = jnp.float32

    def heads(t):
        return t.reshape(*t.shape[:-1], A_HEADS, A_HEAD)

    rf, kf, vf = heads(r.astype(f32)), heads(k.astype(f32)), heads(v.astype(f32))
    kk = kf * heads(p["k_k"].astype(f32))
    kk = kk / jnp.maximum(jnp.sqrt(jnp.sum(kk * kk, axis=-1, keepdims=True)), 1e-12)
    k_a = heads(p["k_a"].astype(f32))
    r_k = p["r_k"].astype(f32)
    y = 0.0
    bonus = 0.0
    finals = []
    for d in range(2):
        wl = lora[:, :, d, :A_DECAY_LORA]
        al = lora[:, :, d, A_DECAY_LORA:]
        w_pre = (p["w0"][d] + jnp.tanh(wl) @ p["w2"][d]).astype(f32)
        decay = jnp.exp(-jnp.exp(-jax.nn.softplus(-w_pre) - 0.5))
        a = heads(jax.nn.sigmoid((p["a0"][d] + al @ p["a2"][d]).astype(f32)))
        kd = kf * (1.0 + (a - 1.0) * k_a)
        init = (jnp.zeros((Bn, A_HEADS, A_HEAD, A_HEAD), f32) if s0 is None
                else s0[:, d].astype(f32))
        s_fin, y_d = rwkv7_scan(init, rf, heads(decay), kd, vf, kk, a, reverse=(d == 1))
        y = y + y_d
        bonus = bonus + jnp.sum(rf * kd * r_k, axis=-1, keepdims=True) * vf
        finals.append(s_fin)
    mean = jnp.mean(y, axis=-1, keepdims=True)
    var = jnp.mean(jnp.square(y - mean), axis=-1, keepdims=True)
    gn = ((y - mean) * lax.rsqrt(var + A_GN_EPS)).reshape(Bn, T, A_WIDTH) * p["ln_w"] + p["ln_b"]
    out = gn + bonus.reshape(Bn, T, A_WIDTH)
    return out.astype(r.dtype), jnp.stack(finals, axis=1).astype(r.dtype)


def gqa_mixer(q_b, k_b, v_b, p, ctx_kv, rope):
    Bn, T, _ = q_b.shape
    q = rms_norm(q_b.reshape(Bn, T, B_Q_HEADS, B_HEAD), p["q_g"])
    k = rms_norm(k_b.reshape(Bn, T, B_KV_HEADS, B_HEAD), p["k_g"])
    v = v_b.reshape(Bn, T, B_KV_HEADS, B_HEAD)
    if ctx_kv is None:
        keys, vals = k, v
    else:
        cos, sin = rope
        q = apply_rope(q, cos[None, :, None, :], sin[None, :, None, :])
        k = apply_rope(k, cos[None, :, None, :], sin[None, :, None, :])
        keys = jnp.concatenate([ctx_kv[0], k], axis=1)
        vals = jnp.concatenate([ctx_kv[1], v], axis=1)
    qg = q.reshape(Bn, T, B_KV_HEADS, B_GROUP, B_HEAD)
    o = blocked_attention((qg,), lambda qb: jnp.einsum('bqhgd,bkhd->bhgqk', qb[0], keys),
                          vals, B_HEAD ** -0.5)
    return o, k, v


def mixer_ab(h, p, ctx, rope):
    Bn, T, _ = h.shape
    proj = h @ p["w_in"]
    shifted, g_a, q_b, k_b, v_b, g_b = split_cols(
        proj, [A_SHIFT, A_WIDTH, B_WIDTH, B_KV_WIDTH, B_KV_WIDTH, B_WIDTH])
    shifted = shifted + p["mix"] * (centred_shift(shifted) - shifted)
    r, k, v, lora = split_cols(shifted, [A_WIDTH, A_WIDTH, A_WIDTH, A_LORA_COLS])
    lora = lora.reshape(Bn, T, 2, A_DECAY_LORA + A_ICLR_LORA)
    y_a, s_fin = rwkv7_mixer(r, k, v, lora, p, None if ctx is None else ctx[0])
    y_b, k_new, v_new = gqa_mixer(q_b, k_b, v_b, p, None if ctx is None else (ctx[1], ctx[2]), rope)
    mixed = jnp.concatenate([y_a * jax.nn.silu(g_a), y_b * jax.nn.silu(g_b)], axis=-1)
    return mixed @ p["w_out"], (s_fin, k_new, v_new)


def mixer_mla(h, p, ctx, rope):
    Bn, T, _ = h.shape
    proj = h @ p["w_in"]
    q_a, kv_a, k_pe, gate = split_cols(proj, [C_Q_LORA, C_KV_LORA, C_ROPE, C_WIDTH])
    q = (rms_norm(q_a, p["q_a_g"]) @ p["w_uq"]).reshape(Bn, T, C_HEADS, C_NOPE + C_ROPE)
    q_nope, q_pe = q[..., :C_NOPE], q[..., C_NOPE:]
    c_kv = rms_norm(kv_a, p["kv_a_g"])
    if ctx is None:
        ckv_all, kpe_all = c_kv, k_pe
    else:
        cos, sin = rope
        q_pe = apply_rope(q_pe, cos[None, :, None, :], sin[None, :, None, :])
        k_pe = apply_rope(k_pe, cos[None], sin[None])
        ckv_all = jnp.concatenate([ctx[0], c_kv], axis=1)
        kpe_all = jnp.concatenate([ctx[1], k_pe], axis=1)
    Tk = ckv_all.shape[1]
    kv = (ckv_all @ p["w_ukv"]).reshape(Bn, Tk, C_HEADS, C_NOPE + C_V)
    k_nope, v = kv[..., :C_NOPE], kv[..., C_NOPE:]

    def score_fn(qb):
        return (jnp.einsum('bqhgd,bkhd->bhgqk', qb[0], k_nope)
                + jnp.einsum('bqhgr,bkr->bhgqk', qb[1], kpe_all))

    o = blocked_attention((q_nope[:, :, :, None, :], q_pe[:, :, :, None, :]), score_fn, v,
                          (C_NOPE + C_ROPE) ** -0.5)
    return (o * jax.nn.silu(gate)) @ p["w_out"], (c_kv, k_pe)


def setup_inputs(seed: int = 0) -> dict:
    key = jax.random.key(seed)
    ks = iter(jax.random.split(key, 48))
    f32 = jnp.float32
    D = D_MODEL

    def normal(shape, scale=1.0):
        return scale * jax.random.normal(next(ks), shape, f32)

    def gain(shape):
        return 1.0 + normal(shape, 0.02)

    return {
        "x_prompt": normal((BATCH, SEQ, D)),
        "x_sample": normal((DEC_BATCH, DEC_SEQ, D)),
        "c": normal((DEC_BATCH, D)),
        "state_rwkv": normal((DEC_BATCH, N_EVEN, 2, A_HEADS, A_HEAD, A_HEAD)),
        "cache_gqa_k": normal((DEC_BATCH, N_EVEN, PAST_LEN, B_KV_HEADS, B_HEAD)),
        "cache_gqa_v": normal((DEC_BATCH, N_EVEN, PAST_LEN, B_KV_HEADS, B_HEAD)),
        "cache_mla_ckv": normal((DEC_BATCH, N_ODD, PAST_LEN, C_KV_LORA)),
        "cache_mla_kpe": normal((DEC_BATCH, N_ODD, PAST_LEN, C_ROPE)),
        "c_ctx": normal((D,)),
        "mod_w": normal((DEPTH, D, 3 * D), 0.5 * D ** -0.5),
        "mod_b": normal((DEPTH, 3 * D), 0.01),
        "norm_g": gain((DEPTH, D)),
        "ab_w_in": normal((N_EVEN, D, AB_IN), D ** -0.5),
        "ab_mix": jax.random.uniform(next(ks), (N_EVEN, A_SHIFT), f32),
        "rwkv_w0": -2.0 + normal((N_EVEN, 2, A_WIDTH), 1.0),
        "rwkv_w2": normal((N_EVEN, 2, A_DECAY_LORA, A_WIDTH), 0.1 * A_DECAY_LORA ** -0.5),
        "rwkv_a0": normal((N_EVEN, 2, A_WIDTH), 0.5),
        "rwkv_a2": normal((N_EVEN, 2, A_ICLR_LORA, A_WIDTH), 0.1 * A_ICLR_LORA ** -0.5),
        "rwkv_k_k": 0.85 + normal((N_EVEN, A_WIDTH), 0.02),
        "rwkv_k_a": gain((N_EVEN, A_WIDTH)),
        "rwkv_r_k": normal((N_EVEN, A_HEADS, A_HEAD), 0.1),
        "rwkv_ln_w": gain((N_EVEN, A_WIDTH)),
        "rwkv_ln_b": normal((N_EVEN, A_WIDTH), 0.01),
        "gqa_q_g": gain((N_EVEN, B_HEAD)),
        "gqa_k_g": gain((N_EVEN, B_HEAD)),
        "ab_w_out": normal((N_EVEN, A_WIDTH + B_WIDTH, D), (A_WIDTH + B_WIDTH) ** -0.5),
        "mla_w_in": normal((N_ODD, D, C_IN), D ** -0.5),
        "mla_q_a_g": gain((N_ODD, C_Q_LORA)),
        "mla_kv_a_g": gain((N_ODD, C_KV_LORA)),
        "mla_w_uq": normal((N_ODD, C_Q_LORA, C_HEADS * (C_NOPE + C_ROPE)), C_Q_LORA ** -0.5),
        "mla_w_ukv": normal((N_ODD, C_KV_LORA, C_HEADS * (C_NOPE + C_V)), C_KV_LORA ** -0.5),
        "mla_w_out": normal((N_ODD, C_WIDTH, D), C_WIDTH ** -0.5),
        "final_g": gain((D,)),
    }


def reference(x_prompt, x_sample, c, state_rwkv, cache_gqa_k, cache_gqa_v, cache_mla_ckv,
              cache_mla_kpe, c_ctx, mod_w, mod_b, norm_g, ab_w_in, ab_mix, rwkv_w0, rwkv_w2,
              rwkv_a0, rwkv_a2, rwkv_k_k, rwkv_k_a, rwkv_r_k, rwkv_ln_w, rwkv_ln_b, gqa_q_g,
              gqa_k_g, ab_w_out, mla_w_in, mla_q_a_g, mla_kv_a_g, mla_w_uq, mla_w_ukv,
              mla_w_out, final_g):
    def ab_params(j):
        return {"w_in": ab_w_in[j], "mix": ab_mix[j], "w0": rwkv_w0[j], "w2": rwkv_w2[j],
                "a0": rwkv_a0[j], "a2": rwkv_a2[j], "k_k": rwkv_k_k[j], "k_a": rwkv_k_a[j],
                "r_k": rwkv_r_k[j], "ln_w": rwkv_ln_w[j], "ln_b": rwkv_ln_b[j],
                "q_g": gqa_q_g[j], "k_g": gqa_k_g[j], "w_out": ab_w_out[j]}

    def mla_params(j):
        return {"w_in": mla_w_in[j], "q_a_g": mla_q_a_g[j], "kv_a_g": mla_kv_a_g[j],
                "w_uq": mla_w_uq[j], "w_ukv": mla_w_ukv[j], "w_out": mla_w_out[j]}

    def run_trunk(x, cond, caches):
        T = x.shape[1]
        rope_b = rope_c = None
        if caches is not None:
            rope_b = axial_rope_tables(T, B_HEAD, x.dtype)
            rope_c = axial_rope_tables(T, C_ROPE, x.dtype)
        s_l, gk_l, gv_l, ckv_l, kpe_l = [], [], [], [], []
        for layer in range(DEPTH):
            mod = jax.nn.silu(cond) @ mod_w[layer] + mod_b[layer]
            shift, scale, gate = jnp.split(mod[:, None, :], 3, axis=-1)
            h = rms_norm(x, norm_g[layer]) * (1.0 + scale) + shift
            j = layer // 2
            if layer % 2 == 0:
                ctx = None if caches is None else (caches[0][:, j], caches[1][:, j], caches[2][:, j])
                out, (s_new, k_new, v_new) = mixer_ab(h, ab_params(j), ctx, rope_b)
                if caches is None:
                    s_l.append(s_new)
                    gk_l.append(k_new)
                    gv_l.append(v_new)
            else:
                ctx = None if caches is None else (caches[3][:, j], caches[4][:, j])
                out, (ckv_new, kpe_new) = mixer_mla(h, mla_params(j), ctx, rope_c)
                if caches is None:
                    ckv_l.append(ckv_new)
                    kpe_l.append(kpe_new)
            x = x + gate * out
        y = rms_norm(x, final_g)
        if caches is None:
            return y, (jnp.stack(s_l, 1), jnp.stack(gk_l, 1), jnp.stack(gv_l, 1),
                       jnp.stack(ckv_l, 1), jnp.stack(kpe_l, 1))
        return y, None

    y_prompt, ctx_out = run_trunk(x_prompt, c_ctx[None, :], None)
    y_sample, _ = run_trunk(x_sample, c, (state_rwkv, cache_gqa_k, cache_gqa_v,
                                          cache_mla_ckv, cache_mla_kpe))
    new_state_rwkv, new_cache_gqa_k, new_cache_gqa_v, new_cache_mla_ckv, new_cache_mla_kpe = ctx_out
    return (y_prompt, y_sample, new_state_rwkv, new_cache_gqa_k, new_cache_gqa_v,
            new_cache_mla_ckv, new_cache_mla_kpe)
```

```cpp
#include <hip/hip_runtime.h>
#include <stdint.h>

#ifndef MK_PER_PHASE
#define MK_PER_PHASE 0
#endif

#define LAS __attribute__((address_space(3)))

#define TID_TAB_OFF (8 * 18688 + 128)
__device__ __forceinline__ int lane_id() { unsigned x; asm volatile("v_mbcnt_lo_u32_b32 %0, -1, 0\n\tv_mbcnt_hi_u32_b32 %0, -1, %0" : "=v"(x)); return (int)x; }
__device__ __forceinline__ unsigned hw_wave_slot() { return (unsigned)__builtin_amdgcn_s_getreg((5 << 11) | 4) & 63u; }
__device__ __forceinline__ int get_tid() {
    const unsigned w = *(const volatile LAS unsigned*)(LAS char*)(uintptr_t)(TID_TAB_OFF + 4u * hw_wave_slot());
    return (int)__builtin_amdgcn_readfirstlane(w) * 64 + lane_id();
}
#define TIDX get_tid()
typedef unsigned short bf16_t;
typedef short bf16x8 __attribute__((ext_vector_type(8)));
typedef short s16x4 __attribute__((ext_vector_type(4)));
typedef float f32x4 __attribute__((ext_vector_type(4)));
typedef float f32x2 __attribute__((ext_vector_type(2)));
typedef float f32x16 __attribute__((ext_vector_type(16)));
typedef unsigned u32x4 __attribute__((ext_vector_type(4)));
typedef unsigned u32x2 __attribute__((ext_vector_type(2)));

#define XB_TMO      128
#define XB_XCNT(j)  (256  + 64 * (j))
#define XB_XSUB(j)  (1280 + 64 * (j))
#define XB_XGEN(j)  (2304 + 64 * (j))
#define XB_TOP      3328
#define XB_TOPGEN   3392
#define XCD_BAR_WORDS 3456
#define XB_SPIN_CAP (1u << 22)

__device__ __forceinline__ unsigned xb_ld(unsigned* p)              { return __hip_atomic_load(p, __ATOMIC_RELAXED, __HIP_MEMORY_SCOPE_AGENT); }
__device__ __forceinline__ unsigned xb_add(unsigned* p, unsigned v) { return __hip_atomic_fetch_add(p, v, __ATOMIC_RELAXED, __HIP_MEMORY_SCOPE_AGENT); }
__device__ __forceinline__ unsigned xb_xcc_id() { return (unsigned)__builtin_amdgcn_s_getreg((3 << 11) | 20) & 0xFu; }
#define XB_SPIN(cond, bar) do { unsigned _sp = 0; while (cond) { __builtin_amdgcn_s_sleep(1); \
    if ((++_sp & 255u) == 0u) { if (xb_ld(&(bar)[XB_TMO])) break; if (_sp > XB_SPIN_CAP) { atomicAdd(&(bar)[XB_TMO], 1u); break; } } } } while (0)

struct XcdBarrier { unsigned* bar; unsigned x; volatile LAS unsigned* st; };

__device__ __forceinline__ XcdBarrier xcd_barrier_post(unsigned* bar, volatile LAS unsigned* st) {
    XcdBarrier b; b.bar = bar; b.x = xb_xcc_id(); b.st = st;
    if (TIDX == 0) (void)xb_add(&bar[XB_XCNT(b.x)], 1u);
    return b;
}
__device__ __forceinline__ void xcd_barrier_complete(unsigned* bar, unsigned x, unsigned& nloc, unsigned& nx) {
    const unsigned G = gridDim.x * gridDim.y * gridDim.z;
    unsigned sum, cnt, mine, sp = 0u;
    for (;;) {
        sum = 0u; cnt = 0u; mine = 0u;
#pragma unroll
        for (unsigned j = 0; j < 16; ++j) { const unsigned c = xb_ld(&bar[XB_XCNT(j)]); sum += c; cnt += (c > 0u) ? 1u : 0u; mine = (j == x) ? c : mine; }
        if (sum == G) break;
        __builtin_amdgcn_s_sleep(1);
        if ((++sp & 255u) == 0u) { if (xb_ld(&bar[XB_TMO])) break; if (sp > XB_SPIN_CAP) { atomicAdd(&bar[XB_TMO], 1u); break; } }
    }
    nloc = mine > 0u ? mine : 1u; nx = cnt > 0u ? cnt : 1u;
}
__device__ __forceinline__ void xcd_barrier(const XcdBarrier& b) {
    asm volatile("s_waitcnt vmcnt(0)" ::: "memory");
    __syncthreads();
    if (TIDX == 0) {
        unsigned* bar = b.bar;
        __builtin_amdgcn_s_waitcnt(0);
        unsigned nloc = b.st[0], nx = b.st[1];
        if (nloc == 0u) { xcd_barrier_complete(bar, b.x, nloc, nx); b.st[0] = nloc; b.st[1] = nx; }
        const unsigned old = xb_add(&bar[XB_XSUB(b.x)], 1u);
        const unsigned gen = old / nloc;
        if (old + 1u == (gen + 1u) * nloc) {
            __builtin_amdgcn_fence(__ATOMIC_RELEASE, "agent");
            asm volatile("s_waitcnt vmcnt(0)" ::: "memory");
            const unsigned og = xb_add(&bar[XB_TOP], 1u);
            const unsigned tg = og / nx;
            if (og + 1u == (tg + 1u) * nx) xb_add(&bar[XB_TOPGEN], 1u);
            else XB_SPIN(xb_ld(&bar[XB_TOPGEN]) == tg, bar);
            __builtin_amdgcn_fence(__ATOMIC_ACQUIRE, "agent");
            xb_add(&bar[XB_XGEN(b.x)], 1u);
            asm volatile("s_waitcnt vmcnt(0)" ::: "memory");
        } else {
            XB_SPIN(xb_ld(&bar[XB_XGEN(b.x)]) == gen, bar);
            __builtin_amdgcn_fence(__ATOMIC_ACQUIRE, "agent");
            asm volatile("s_waitcnt vmcnt(0)" ::: "memory");
        }
    }
    __syncthreads();
}

typedef __bf16 bf16v2 __attribute__((ext_vector_type(2)));
__device__ __forceinline__ unsigned cvt_pk_bf16(float lo, float hi) { f32x2 v = {lo, hi}; bf16v2 b = __builtin_convertvector(v, bf16v2); return __builtin_bit_cast(unsigned, b); }
__device__ __forceinline__ float bf_lo(unsigned w) { return __uint_as_float(w << 16); }
__device__ __forceinline__ float bf_hi(unsigned w) { return __uint_as_float(w & 0xffff0000u); }
__device__ __forceinline__ float bf2f(bf16_t b) { return __uint_as_float(((unsigned)b) << 16); }
__device__ __forceinline__ float ldh(const bf16_t* base, unsigned boff) { return bf2f(*(const bf16_t*)((const char*)base + boff)); }
__device__ __forceinline__ u32x2 pk4(const f32x4 v) { return (u32x2){cvt_pk_bf16(v[0], v[1]), cvt_pk_bf16(v[2], v[3])}; }
__device__ __forceinline__ f32x4 up4(const u32x2 w) { return (f32x4){bf_lo(w.x), bf_hi(w.x), bf_lo(w.y), bf_hi(w.y)}; }
__device__ __forceinline__ float sigmoid_f(float x) { return __builtin_amdgcn_rcpf(1.0f + __expf(-x)); }
__device__ __forceinline__ float silu_f(float x) { return x * __builtin_amdgcn_rcpf(1.0f + __expf(-x)); }
__device__ __forceinline__ float wave_sum(float v) {
#pragma unroll
    for (int o = 32; o >= 1; o >>= 1) v += __shfl_xor(v, o);
    return v;
}
__device__ __forceinline__ float sum16(float v) {
#pragma unroll
    for (int o = 8; o >= 1; o >>= 1) v += __shfl_xor(v, o);
    return v;
}

namespace pg8 {
constexpr int BM = 256, BK = 64, HALF = 128, HTB = HALF * BK * 2, STAGE_BYTES = 8 * HTB, NXCD = 8, WGM = 8;
__host__ __device__ __forceinline__ int lds_byte(int r, int c) { const int st = (r >> 4) * 2 + (c >> 5), rr = r & 15, cc = c & 31, ob = rr * 64 + cc * 2; return st * 1024 + (ob ^ (((ob >> 9) & 1) << 5)); }
__host__ __device__ __forceinline__ void stage_rc(int b, int& R, int& C) { const int st = b / 1024, sb = b % 1024, swz = sb ^ (((sb >> 9) & 1) << 5); R = (st >> 1) * 16 + swz / 64; C = (st & 1) * 32 + (swz % 64) / 2; }
__host__ __device__ __forceinline__ int perm32(int rho) { const int n = rho >> 4, i = rho & 15; return 8 * (i >> 2) + 4 * n + (i & 3); }
struct Unit { int pm, pn; };
struct Gemm { const bf16_t* A; const bf16_t* Bt; int M, N, K; };
struct StaticOrder {
    int nM, nN, nwg, G, c;
    __host__ __device__ void init(int M, int N, int G_, int c_) { nM = M / BM; nN = N / BM; nwg = nM * nN; G = G_; c = c_; }
    __host__ __device__ bool next(int i, Unit& u) const {
        const long L = (long)i * G + c; if (L >= nwg) return false;
        int wgid = (int)L; { const int q = nwg / NXCD, r = nwg % NXCD, xcd = wgid % NXCD, off = wgid / NXCD; wgid = (xcd < r ? xcd * (q + 1) : r * (q + 1) + (xcd - r) * q) + off; }
        const int nig = WGM * nN, gid = wgid / nig, fm = gid * WGM, gsz = (nM - fm) < WGM ? (nM - fm) : WGM;
        u.pm = fm + ((wgid % nig) % gsz); u.pn = (wgid % nig) / gsz; return true;
    }
    __device__ __forceinline__ void a_ready(const Unit&) const {}
    __device__ __forceinline__ void done(const Unit&) const {}
};
template <class Epi, class Sched>
__device__ __forceinline__ void gemm_phase(LAS unsigned char* lds, const Gemm g, const Sched& S, const Epi& E) {
    const int tid = TIDX, wid = __builtin_amdgcn_readfirstlane(tid >> 6), lane = tid & 63, wr = wid >> 2, wc = wid & 3, fr = lane & 15, fq = lane >> 4;
    const int K = g.K, nt = K / BK;
    unsigned voffA[2], voffB[2];
#pragma unroll
    for (int i = 0; i < 2; ++i) { int R, C; stage_rc(tid * 16 + i * 8192, R, C); const int Rb = (R & ~31) + perm32(R & 31);
        voffA[i] = (unsigned)(R * K + C) * 2u; voffB[i] = (unsigned)(Rb * K + C) * 2u; }
    const size_t kstep = (size_t)(BK * 2);
    const size_t hstep = (size_t)HALF * K * 2;
    const size_t tstep = 2 * hstep;
    const unsigned ldsw = (unsigned)wid * 1024u;
    const int aoff = lds_byte(wr * 64 + fr, fq * 8), boff = lds_byte(wc * 32 + fr, fq * 8);
#define PG8_SA(b, h) (((b) * 2 + (h)) * HTB)
#define PG8_SB(b, h) ((4 + (b) * 2 + (h)) * HTB)
#define PG8_STAGE(bufoff, gbase, voff) do { _Pragma("unroll") for (int _i = 0; _i < 2; ++_i) \
        __builtin_amdgcn_global_load_lds((const unsigned*)((const char*)(gbase) + (voff)[_i]), (LAS unsigned*)(lds + (bufoff) + ldsw + _i * 8192), 16, 0, 0); } while (0)
#define PG8_LDA(dst, b, h) do { _Pragma("unroll") for (int m = 0; m < 4; ++m) _Pragma("unroll") for (int k = 0; k < 2; ++k) dst[m][k] = *(const LAS bf16x8*)(lds + PG8_SA(b, h) + aoff + m * 2048 + k * 1024); } while (0)
#define PG8_LDB(dst, b, h) do { _Pragma("unroll") for (int n = 0; n < 2; ++n) _Pragma("unroll") for (int k = 0; k < 2; ++k) dst[n][k] = *(const LAS bf16x8*)(lds + PG8_SB(b, h) + boff + n * 2048 + k * 1024); } while (0)
#define PG8_MMA(ai, bj, At, Bt) do { __builtin_amdgcn_s_setprio(1); _Pragma("unroll") for (int m = 0; m < 4; ++m) _Pragma("unroll") for (int n = 0; n < 2; ++n) _Pragma("unroll") for (int k = 0; k < 2; ++k) \
        acc[ai][bj][m][n] = __builtin_amdgcn_mfma_f32_16x16x32_bf16(Bt[n][k], At[m][k], acc[ai][bj][m][n], 0, 0, 0); __builtin_amdgcn_s_setprio(0); } while (0)
#define PG8_WAIT_V(n) asm volatile("s_waitcnt vmcnt(" #n ")" ::: "memory")
#define PG8_WAIT_L(n) asm volatile("s_waitcnt lgkmcnt(" #n ")" ::: "memory")
#define PG8_BAR __builtin_amdgcn_s_barrier()
#define PG8_SCHED __builtin_amdgcn_sched_barrier(0)
    Unit cur, nxt; int ui = 0;
    if (!S.next(0, cur)) return;
    f32x4 acc[2][2][4][2];
#pragma unroll
    for (int a = 0; a < 2; ++a)
#pragma unroll
        for (int b = 0; b < 2; ++b)
#pragma unroll
            for (int m = 0; m < 4; ++m)
#pragma unroll
                for (int n = 0; n < 2; ++n) acc[a][b][m][n] = (f32x4){0.f, 0.f, 0.f, 0.f};
    bf16x8 At[4][2], B0[2][2], B1[2][2];
    const char* cA = (const char*)g.A + (size_t)cur.pm * tstep; const char* cB = (const char*)g.Bt + (size_t)cur.pn * tstep;
    S.a_ready(cur);
    PG8_STAGE(PG8_SB(0, 0), cB, voffB); PG8_STAGE(PG8_SA(0, 0), cA, voffA); PG8_STAGE(PG8_SB(0, 1), cB + hstep, voffB); PG8_STAGE(PG8_SA(0, 1), cA + hstep, voffA);
    if (wr == 1) PG8_BAR;
    PG8_WAIT_V(4); PG8_BAR;
    PG8_STAGE(PG8_SB(1, 0), cB + kstep, voffB); PG8_STAGE(PG8_SA(1, 0), cA + kstep, voffA); PG8_STAGE(PG8_SB(1, 1), cB + hstep + kstep, voffB);
    PG8_WAIT_V(6); PG8_BAR;
    for (;;) {
        const bool has_next = S.next(ui + 1, nxt);
        const char* nA = has_next ? (const char*)g.A + (size_t)nxt.pm * tstep : cA; const char* nB = has_next ? (const char*)g.Bt + (size_t)nxt.pn * tstep : cB;
        for (int t = 0; t < nt; t += 2) {
            const bool last = (t == nt - 2);
            const char* a1 = cA + (size_t)(t + 1) * kstep;
            const char* a2 = last ? nA : cA + (size_t)(t + 2) * kstep; const char* b2 = last ? nB : cB + (size_t)(t + 2) * kstep;
            const char* a3 = a2 + kstep; const char* b3 = b2 + kstep;
            if (last && has_next) S.a_ready(nxt);
            PG8_LDB(B0, 0, 0); PG8_SCHED; PG8_LDA(At, 0, 0); PG8_STAGE(PG8_SA(1, 1), a1 + hstep, voffA);
            PG8_WAIT_L(8); PG8_BAR; PG8_WAIT_L(0); PG8_MMA(0, 0, At, B0); PG8_BAR; PG8_SCHED;
            PG8_LDB(B1, 0, 1); PG8_STAGE(PG8_SB(0, 0), b2, voffB);
            PG8_BAR; PG8_WAIT_L(0); PG8_MMA(0, 1, At, B1); PG8_BAR;
            PG8_LDA(At, 0, 1); PG8_STAGE(PG8_SA(0, 0), a2, voffA);
            PG8_BAR; PG8_WAIT_L(0); PG8_MMA(1, 0, At, B0); PG8_BAR; PG8_SCHED;
            PG8_STAGE(PG8_SB(0, 1), b2 + hstep, voffB);
            PG8_WAIT_V(6); PG8_BAR; PG8_MMA(1, 1, At, B1); PG8_BAR;
            PG8_LDB(B0, 1, 0); PG8_SCHED; PG8_LDA(At, 1, 0); PG8_STAGE(PG8_SA(0, 1), a2 + hstep, voffA);
            PG8_WAIT_L(8); PG8_BAR; PG8_WAIT_L(0); PG8_MMA(0, 0, At, B0); PG8_BAR; PG8_SCHED;
            PG8_LDB(B1, 1, 1); PG8_STAGE(PG8_SB(1, 0), b3, voffB);
            PG8_BAR; PG8_WAIT_L(0); PG8_MMA(0, 1, At, B1); PG8_BAR;
            PG8_LDA(At, 1, 1); PG8_STAGE(PG8_SA(1, 0), a3, voffA);
            PG8_BAR; PG8_WAIT_L(0); PG8_MMA(1, 0, At, B0); PG8_BAR; PG8_SCHED;
            PG8_STAGE(PG8_SB(1, 1), b3 + hstep, voffB);
            PG8_WAIT_V(6); PG8_BAR; PG8_MMA(1, 1, At, B1); PG8_BAR;
        }
        E(acc, cur, wr, wc, fr, fq); S.done(cur);
        if (!has_next) break;
#pragma unroll
        for (int a = 0; a < 2; ++a)
#pragma unroll
            for (int b = 0; b < 2; ++b)
#pragma unroll
                for (int m = 0; m < 4; ++m)
#pragma unroll
                    for (int n = 0; n < 2; ++n) acc[a][b][m][n] = (f32x4){0.f, 0.f, 0.f, 0.f};
        cur = nxt; cA = nA; cB = nB; ++ui;
    }
    PG8_WAIT_V(0);
    if (wr == 0) PG8_BAR;
    PG8_BAR;
#undef PG8_SA
#undef PG8_SB
#undef PG8_STAGE
#undef PG8_LDA
#undef PG8_LDB
#undef PG8_MMA
#undef PG8_WAIT_V
#undef PG8_WAIT_L
#undef PG8_BAR
#undef PG8_SCHED
}
}

constexpr int DM = 4096, NP = 4096, NS = 8192, NT = 12288, AW = 2048;
constexpr int N1 = 13824, N1F = 6656, N1B = 7168;
constexpr int N3 = 10496, N3G = 8192, N3C = 2304;
constexpr int NKV = 13312;
constexpr size_t SZA = (size_t)NT * AW * 4;

constexpr size_t WS_CTL = 0;
constexpr size_t WS_MOD = 65536;
constexpr size_t WS_ROPEB_COS = 589824, WS_ROPEB_SIN = WS_ROPEB_COS + 524288;
constexpr size_t WS_ROPEC_COS = WS_ROPEB_SIN + 524288, WS_ROPEC_SIN = WS_ROPEC_COS + 262144;
constexpr size_t WS_R0 = 2228224;
constexpr size_t WS_PROJF = WS_R0;
constexpr size_t WS_YA = WS_R0;
constexpr size_t WS_MIXED = WS_R0 + 2 * SZA;
constexpr size_t WS_R1 = WS_R0 + (size_t)NT * N1F * 4;
constexpr size_t WS_PROJB = WS_R1;
constexpr size_t WS_R2 = WS_R1 + (size_t)NT * N1B * 2;
constexpr size_t WS_WTA = WS_R2;
constexpr size_t WS_H0 = WS_R2 + (size_t)N1 * DM * 2;
constexpr size_t WS_R = WS_R2;
constexpr size_t WS_K = WS_R2 + SZA;
constexpr size_t WS_R4 = WS_R2 + (size_t)N1 * DM * 2 + (size_t)NT * DM * 2;
constexpr size_t WS_WD = WS_R4;
constexpr size_t WS_R5 = WS_R4 + 4 * SZA;
constexpr size_t WS_LORA = WS_R5;
constexpr size_t WS_KBP = WS_LORA + (size_t)NT * 512 * 2;
constexpr size_t WS_VBP = WS_KBP + (size_t)NP * 512 * 2;
constexpr size_t WS_KBS = WS_VBP + (size_t)NP * 512 * 2;
constexpr size_t WS_VBS = WS_KBS + (size_t)9216 * 512 * 2;
constexpr size_t WS_R6 = WS_VBS + (size_t)9216 * 512 * 2;
constexpr size_t WS_WTOUT = WS_R6;
constexpr size_t WS_WTLORA = WS_WTOUT + (size_t)DM * DM * 2;
constexpr size_t WS_END0 = WS_WTLORA + (size_t)2 * 4096 * 256 * 2;
constexpr size_t WS_Q = WS_R0;
constexpr size_t WS_CKV = WS_Q + (size_t)NT * 12288 * 2;
constexpr size_t WS_KPE = WS_CKV + (size_t)NKV * 512 * 2;
constexpr size_t WS_H1 = WS_R1;
constexpr size_t WS_OG = WS_H1;
constexpr size_t WS_PROJC = WS_H1 + (size_t)NT * DM * 2;
constexpr size_t WS_GATEB = WS_PROJC + (size_t)NT * N3C * 4;
constexpr size_t WS_QN = WS_GATEB + (size_t)NT * 8192 * 2;
constexpr size_t WS_KV = WS_QN + (size_t)NT * 1536 * 2;
constexpr size_t WS_L1END = WS_KV + (size_t)NKV * 16384 * 2;
constexpr size_t WS_WTC = WS_L1END > WS_END0 ? WS_L1END : WS_END0;
constexpr size_t WS_WTUQ = WS_WTC + (size_t)N3 * DM * 2;
constexpr size_t WS_WTUKV = WS_WTUQ + (size_t)12288 * 1536 * 2;
constexpr size_t WS_WTCOUT = WS_WTUKV + (size_t)16384 * 512 * 2;
constexpr size_t WS_END1 = WS_WTCOUT + (size_t)DM * 8192 * 2;
static_assert(WS_KPE + (size_t)NKV * 64 * 2 <= WS_R1, "q, ckv, kpe must fit in R0");
constexpr size_t WS_NEED = WS_END0 > WS_END1 ? WS_END0 : WS_END1;
static_assert((size_t)NT * (DM * 2 + N3C * 4) >= (size_t)NT * 8192 * 2, "og must fit over h1 + projC");
static_assert(WS_R2 + 2 * SZA <= WS_R4, "r,k must fit in R2");

constexpr size_t OUT_Y = 0, OUT_STATE = 50331648, OUT_GK = 54525952, OUT_GV = 56623104, OUT_CKV = 58720256, OUT_KPE = 60817408, OUT_TOTAL = 61079552;

constexpr int LDS_X = 8 * 18688;
constexpr int LDS_BYTES = LDS_X + 512;
static_assert(TID_TAB_OFF == LDS_X + 128, "tid table behind the barrier / queue words");
constexpr int NPH = 15;

struct Params { const float* in[33]; float* out; unsigned char* ws; int ph_lo, ph_hi; };
typedef const __attribute__((address_space(4))) Params* KP;
__device__ __forceinline__ KP get_params() { unsigned long long a = (unsigned long long)__builtin_amdgcn_kernarg_segment_ptr(); asm volatile("" : "+s"(a)); return (KP)a; }

enum { I_XP = 0, I_XS, I_C, I_STATE, I_CGK, I_CGV, I_CCKV, I_CKPE, I_CCTX, I_MODW, I_MODB, I_NORMG, I_ABWIN, I_ABMIX, I_W0, I_W2, I_A0, I_A2, I_KK, I_KA, I_RK, I_LNW, I_LNB,
       I_QG, I_KG, I_ABWOUT, I_CWIN, I_QAG, I_KVAG, I_WUQ, I_WUKV, I_CWOUT, I_FINALG };

__device__ __forceinline__ void transpose_tile(const float* __restrict__ src, int ldn, int K, int k0, int n0, bf16_t* __restrict__ dst, int drow0, unsigned char* lds) {
    const int t = TIDX;
    constexpr int RS = 528;
    __syncthreads();
    {
        const int nq = t & 15, kr = t >> 4;
#pragma unroll
        for (int it = 0; it < 4; ++it) {
            const int k = 2 * kr + 64 * it;
            const f32x4 a = *(const f32x4*)(src + (size_t)(k0 + k) * ldn + n0 + nq * 4);
            const f32x4 b = *(const f32x4*)(src + (size_t)(k0 + k + 1) * ldn + n0 + nq * 4);
#pragma unroll
            for (int e = 0; e < 4; ++e) *(unsigned*)(lds + (nq * 4 + e) * RS + k * 2) = cvt_pk_bf16(a[e], b[e]);
        }
    }
    __syncthreads();
    {
        const int n = t >> 3, kc = (t & 7) * 32;
        bf16_t* d = dst + (size_t)(drow0 + n) * K + k0 + kc;
#pragma unroll
        for (int q = 0; q < 4; ++q) *(u32x4*)(d + q * 8) = *(const u32x4*)(lds + n * RS + (kc + q * 8) * 2);
    }
}
template <class RowMap>
__device__ __forceinline__ int transpose_all(const float* src, int K, int Nsrc, bf16_t* dst, RowMap rm, int u0, unsigned char* lds, int G = (int)gridDim.x, int wg = (int)blockIdx.x) {
    const int nkt = K / 256, nnt = Nsrc / 64, nu = nkt * nnt;
    int first = (wg - (u0 % G) + G) % G;
    for (int u = first; u < nu; u += G) { const int kt = u % nkt, ntile = u / nkt; transpose_tile(src, Nsrc, K, kt * 256, ntile * 64, dst, rm(ntile * 64), lds); }
    return nu;
}
struct RowId { __device__ int operator()(int n) const { return n; } };
struct RowMla { __device__ int operator()(int n) const { return n < 2112 ? 8192 + n : n - 2112; } };

__device__ __forceinline__ void phase0(KP p, unsigned char* lds) {
    unsigned char* ws = p->ws;
    const int tid = TIDX, G = gridDim.x, bid = blockIdx.x;
    {
        float* cb = (float*)(ws + WS_ROPEB_COS); float* sb = (float*)(ws + WS_ROPEB_SIN);
        float* cc = (float*)(ws + WS_ROPEC_COS); float* sc = (float*)(ws + WS_ROPEC_SIN);
        for (int i = bid * 512 + tid; i < 2048 * 64 + 2048 * 32; i += G * 512) {
            if (i < 2048 * 64) { const int t = i >> 6, pi = i & 63; const int fi = pi & 31; const float pos = (float)(pi < 32 ? (t >> 6) : (t & 63));
                const float inv = exp2f(-(float)fi * (13.287712379549449f / 32.0f)); const float a = pos * inv; cb[i] = cosf(a); sb[i] = sinf(a); }
            else { const int j = i - 2048 * 64; const int t = j >> 5, pi = j & 31; const int fi = pi & 15; const float pos = (float)(pi < 16 ? (t >> 6) : (t & 63));
                const float inv = exp2f(-(float)fi * (13.287712379549449f / 16.0f)); const float a = pos * inv; cc[j] = cosf(a); sc[j] = sinf(a); }
        }
    }
    {
        bf16_t* WL = (bf16_t*)(ws + WS_WTLORA);
        for (int i = bid * 512 + tid; i < 2 * 4096 * 32; i += G * 512) {
            const int d = i >> 17, n = (i >> 5) & 4095, k8 = (i & 31) * 8; const int isa = n >> 11, nn = n & 2047;
            u32x4 o = (u32x4){0u, 0u, 0u, 0u};
            if ((k8 >> 7) == isa) {
                const float* src = (isa ? p->in[I_A2] : p->in[I_W2]) + (size_t)d * 128 * 2048 + nn; const int kb = k8 & 127;
                float v[8];
#pragma unroll
                for (int e = 0; e < 8; ++e) v[e] = src[(size_t)(kb + e) * 2048];
                o = (u32x4){cvt_pk_bf16(v[0], v[1]), cvt_pk_bf16(v[2], v[3]), cvt_pk_bf16(v[4], v[5]), cvt_pk_bf16(v[6], v[7])};
            }
            *(u32x4*)(WL + ((size_t)d * 4096 + n) * 256 + k8) = o;
        }
    }
    {
        unsigned* qhead = (unsigned*)(ws + WS_CTL) + 4096 + 64;
        float* S = (float*)lds;
        float* RED = (float*)(lds + 81920);
        bool have_s = false;
        for (;;) {
            unsigned qa = LDS_X + 64; asm volatile("" : "+s"(qa));
            volatile LAS unsigned* qslot = (volatile LAS unsigned*)(LAS char*)(uintptr_t)qa;
            __syncthreads();
            if (TIDX == 0) *qslot = __hip_atomic_fetch_add(qhead, 1u, __ATOMIC_RELAXED, __HIP_MEMORY_SCOPE_AGENT);
            __syncthreads();
            const int u = (int)__builtin_amdgcn_readfirstlane(*qslot);
            if (u >= 192 + 3456 + 1024) break;
            if (u >= 192) {
                const int t = u - 192;
                if (t < 3456) transpose_tile(p->in[I_ABWIN], N1, 4096, (t & 15) * 256, (t >> 4) * 64, (bf16_t*)(ws + WS_WTA), (t >> 4) * 64, lds);
                else { const int t2 = t - 3456; transpose_tile(p->in[I_ABWOUT], 4096, 4096, (t2 & 15) * 256, (t2 >> 4) * 64, (bf16_t*)(ws + WS_WTOUT), (t2 >> 4) * 64, lds); }
                continue;
            }
            if (!have_s) {
                for (int i = tid; i < 5 * 4096; i += 512) { const int r = i >> 12, k = i & 4095; const float x = r == 0 ? p->in[I_CCTX][k] : p->in[I_C][(r - 1) * 4096 + k]; S[i] = silu_f(x); }
                have_s = true;
            }
            __syncthreads();
            const int layer = u / 96, c0 = (u % 96) * 128;
            const int cg = tid & 31, ks = tid >> 5;
            const float* W = p->in[I_MODW] + (size_t)layer * 4096 * 12288 + c0 + cg * 4;
            f32x4 acc[5];
#pragma unroll
            for (int r = 0; r < 5; ++r) acc[r] = (f32x4){0.f, 0.f, 0.f, 0.f};
#pragma unroll 8
            for (int kk = 0; kk < 256; ++kk) {
                const int k = ks * 256 + kk;
                const f32x4 w = *(const f32x4*)(W + (size_t)k * 12288);
#pragma unroll
                for (int r = 0; r < 5; ++r) acc[r] += w * S[r * 4096 + k];
            }
#pragma unroll
            for (int r = 0; r < 5; ++r) *(f32x4*)(RED + (ks * 5 + r) * 128 + cg * 4) = acc[r];
            __syncthreads();
            for (int o = tid; o < 640; o += 512) {
                const int r = o >> 7, c = o & 127; float sacc = 0.f;
#pragma unroll
                for (int q = 0; q < 16; ++q) sacc += RED[(q * 5 + r) * 128 + c];
                ((float*)(ws + WS_MOD))[((size_t)layer * 5 + r) * 12288 + c0 + c] = sacc + p->in[I_MODB][layer * 12288 + c0 + c];
            }
        }
        __syncthreads();
    }
}

__device__ __forceinline__ void phase_cvt1(KP p, unsigned char* lds, int part, int G, int wg) {
    unsigned char* ws = p->ws; int u0 = 0;
    if (part == 0) {
        u0 += transpose_all(p->in[I_CWIN], 4096, 10304, (bf16_t*)(ws + WS_WTC), RowMla(), u0, lds, G, wg);
        u0 += transpose_all(p->in[I_WUQ], 1536, 12288, (bf16_t*)(ws + WS_WTUQ), RowId(), u0, lds, G, wg);
        bf16_t* pad = (bf16_t*)(ws + WS_WTC) + (size_t)10304 * 4096;
        for (int i = wg * 512 + TIDX; i < 192 * 4096 / 8; i += G * 512) *(u32x4*)(pad + (size_t)i * 8) = (u32x4){0u, 0u, 0u, 0u};
    } else if (part == 1) {
        u0 += transpose_all(p->in[I_WUKV], 512, 16384, (bf16_t*)(ws + WS_WTUKV), RowId(), u0, lds, G, wg);
    } else {
        u0 += transpose_all(p->in[I_CWOUT], 8192, 4096, (bf16_t*)(ws + WS_WTCOUT), RowId(), u0, lds, G, wg);
    }
}

__device__ __forceinline__ void phase_h(KP p, int layer, const float* x0  , const float* x1  , bf16_t* h) {
    const int lane = TIDX & 63, wave = TIDX >> 6, gw = blockIdx.x * 8 + wave, nw = gridDim.x * 8;
    const float* mod = (const float*)(p->ws + WS_MOD) + (size_t)layer * 5 * 12288;
    const float* g = p->in[I_NORMG] + layer * 4096;
    for (int row = gw; row < NT; row += nw) {
        const float* x = row < NP ? x0 + (size_t)row * DM : x1 + (size_t)(row - NP) * DM;
        const int mr = row < NP ? 0 : 1 + (row - NP) / 2048;
        f32x4 v[16]; float ss = 0.f;
#pragma unroll
        for (int i = 0; i < 16; ++i) { v[i] = ((const f32x4*)x)[lane + 64 * i]; ss += v[i][0] * v[i][0] + v[i][1] * v[i][1] + v[i][2] * v[i][2] + v[i][3] * v[i][3]; }
        ss = wave_sum(ss);
        const float inv = rsqrtf(ss * (1.0f / 4096.0f) + 1e-6f);
        const float* msh = mod + (size_t)mr * 12288; const float* msc = msh + 4096;
#pragma unroll
        for (int i = 0; i < 16; ++i) {
            const int c4 = lane + 64 * i;
            const f32x4 g4 = ((const f32x4*)g)[c4], sc = ((const f32x4*)msc)[c4], sh = ((const f32x4*)msh)[c4];
            const f32x4 o = v[i] * inv * g4 * (sc + 1.0f) + sh;
            u32x2 w; w.x = cvt_pk_bf16(o[0], o[1]); w.y = cvt_pk_bf16(o[2], o[3]);
            *(u32x2*)(h + (size_t)row * DM + c4 * 4) = w;
        }
    }
}

__device__ __forceinline__ void phase_h_bf(KP p, int layer, const bf16_t* xb, bf16_t* h) {
    const int lane = TIDX & 63, wave = TIDX >> 6, gw = blockIdx.x * 8 + wave, nw = gridDim.x * 8;
    const float* mod = (const float*)(p->ws + WS_MOD) + (size_t)layer * 5 * 12288;
    const float* g = p->in[I_NORMG] + layer * 4096;
    for (int row = gw; row < NT; row += nw) {
        const u32x2* x = (const u32x2*)(xb + (size_t)row * DM);
        const int mr = row < NP ? 0 : 1 + (row - NP) / 2048;
        f32x4 v[16]; float ss = 0.f;
#pragma unroll
        for (int i = 0; i < 16; ++i) { v[i] = up4(x[lane + 64 * i]); ss += v[i][0] * v[i][0] + v[i][1] * v[i][1] + v[i][2] * v[i][2] + v[i][3] * v[i][3]; }
        ss = wave_sum(ss);
        const float inv = rsqrtf(ss * (1.0f / 4096.0f) + 1e-6f);
        const float* msh = mod + (size_t)mr * 12288; const float* msc = msh + 4096;
#pragma unroll
        for (int i = 0; i < 16; ++i) {
            const int c4 = lane + 64 * i;
            const f32x4 g4 = ((const f32x4*)g)[c4], sc = ((const f32x4*)msc)[c4], sh = ((const f32x4*)msh)[c4];
            *(u32x2*)(h + (size_t)row * DM + c4 * 4) = pk4(v[i] * inv * g4 * (sc + 1.0f) + sh);
        }
    }
}

#define EPI_LOOP_BEGIN \
    _Pragma("unroll") for (int ai = 0; ai < 2; ++ai) _Pragma("unroll") for (int m = 0; m < 4; ++m) { const int row = u.pm * 256 + ai * 128 + wr * 64 + m * 16 + fr; \
    _Pragma("unroll") for (int bj = 0; bj < 2; ++bj) _Pragma("unroll") for (int n = 0; n < 2; ++n) { const int col = u.pn * 256 + bj * 128 + wc * 32 + fq * 8 + n * 4; const f32x4 a = acc[ai][bj][m][n];
#define EPI_LOOP_END } }

struct EpiG1 {
    bf16_t* F; bf16_t* B;
    __device__ __forceinline__ void operator()(const f32x4 (&acc)[2][2][4][2], const pg8::Unit& u, int wr, int wc, int fr, int fq) const {
        if (u.pn < 26) {
            EPI_LOOP_BEGIN *(u32x2*)(F + (size_t)row * N1F + col) = pk4(a); EPI_LOOP_END
        } else {
            EPI_LOOP_BEGIN *(u32x2*)(B + (size_t)row * N1B + (col - N1F)) = pk4(a); EPI_LOOP_END
        }
    }
};
struct EpiBf16Plain {
    bf16_t* O; int ldc;
    __device__ __forceinline__ void operator()(const f32x4 (&acc)[2][2][4][2], const pg8::Unit& u, int wr, int wc, int fr, int fq) const {
        EPI_LOOP_BEGIN u32x2 w; w.x = cvt_pk_bf16(a[0], a[1]); w.y = cvt_pk_bf16(a[2], a[3]); *(u32x2*)(O + (size_t)row * ldc + col) = w; EPI_LOOP_END
    }
};
struct EpiLora {
    const float* w0; const float* a0; bf16_t* Wd; bf16_t* Ad;
    __device__ __forceinline__ void operator()(const f32x4 (&acc)[2][2][4][2], const pg8::Unit& u, int wr, int wc, int fr, int fq) const {
        if (u.pn < 8) {
            EPI_LOOP_BEGIN const int c = col & 2047; const f32x4 b0 = *(const f32x4*)(w0 + c); f32x4 o;
#pragma unroll
                for (int e = 0; e < 4; ++e) o[e] = -0.8750270622f * sigmoid_f(a[e] + b0[e]);
                *(u32x2*)(Wd + (size_t)row * AW + c) = pk4(o); EPI_LOOP_END
        } else {
            EPI_LOOP_BEGIN const int c = col & 2047; const f32x4 b0 = *(const f32x4*)(a0 + c); f32x4 o;
#pragma unroll
                for (int e = 0; e < 4; ++e) o[e] = sigmoid_f(a[e] + b0[e]);
                *(u32x2*)(Ad + (size_t)row * AW + c) = pk4(o); EPI_LOOP_END
        }
    }
};
template <bool XBF> struct EpiRes {
    const float* x0; const float* x1; const bf16_t* xb; bf16_t* out; const float* gate;
    __device__ __forceinline__ void operator()(const f32x4 (&acc)[2][2][4][2], const pg8::Unit& u, int wr, int wc, int fr, int fq) const {
        const int rbase = u.pm * 256; const float* xin = rbase < NP ? x0 + (size_t)0 : x1 - (size_t)NP * DM; const int mr = rbase < NP ? 0 : 1 + (rbase - NP) / 2048;
        const float* gr = gate + (size_t)mr * 12288;
        EPI_LOOP_BEGIN f32x4 xv; if constexpr (XBF) xv = up4(*(const u32x2*)(xb + (size_t)row * DM + col)); else xv = *(const f32x4*)(xin + (size_t)row * DM + col);
            const f32x4 gv = *(const f32x4*)(gr + col);
            *(u32x2*)(out + (size_t)row * DM + col) = pk4(xv + gv * a); EPI_LOOP_END
    }
};
struct EpiG3 {
    bf16_t* Gt; bf16_t* C;
    __device__ __forceinline__ void operator()(const f32x4 (&acc)[2][2][4][2], const pg8::Unit& u, int wr, int wc, int fr, int fq) const {
        if (u.pn < 32) {
            EPI_LOOP_BEGIN *(u32x2*)(Gt + (size_t)row * N3G + col) = pk4(a); EPI_LOOP_END
        } else {
            EPI_LOOP_BEGIN *(u32x2*)(C + (size_t)row * N3C + (col - N3G)) = pk4(a); EPI_LOOP_END
        }
    }
};
struct EpiQ {
    bf16_t* Q; const float* cosC; const float* sinC;
    __device__ __forceinline__ void operator()(const f32x4 (&acc)[2][2][4][2], const pg8::Unit& u, int wr, int wc, int fr, int fq) const {
        const bool samp = u.pm * 256 >= NP;
        EPI_LOOP_BEGIN f32x4 o = a; const int hc = col % 192;
            if (samp && hc >= 128) { const int t = (row - NP) & 2047; const int pi = (hc - 128) >> 1;
                const f32x2 cs = *(const f32x2*)(cosC + t * 32 + pi), sn = *(const f32x2*)(sinC + t * 32 + pi);
                o[0] = a[0] * cs[0] - a[1] * sn[0]; o[1] = a[0] * sn[0] + a[1] * cs[0]; o[2] = a[2] * cs[1] - a[3] * sn[1]; o[3] = a[2] * sn[1] + a[3] * cs[1]; }
            u32x2 w; w.x = cvt_pk_bf16(o[0], o[1]); w.y = cvt_pk_bf16(o[2], o[3]); *(u32x2*)(Q + (size_t)row * 12288 + col) = w; EPI_LOOP_END
    }
};

__device__ __forceinline__ void unpack8(const u32x4 w, float (&x)[8]) { x[0] = bf_lo(w.x); x[1] = bf_hi(w.x); x[2] = bf_lo(w.y); x[3] = bf_hi(w.y); x[4] = bf_lo(w.z); x[5] = bf_hi(w.z); x[6] = bf_lo(w.w); x[7] = bf_hi(w.w); }
__device__ __forceinline__ u32x4 pack8(const float (&x)[8]) { return (u32x4){cvt_pk_bf16(x[0], x[1]), cvt_pk_bf16(x[2], x[3]), cvt_pk_bf16(x[4], x[5]), cvt_pk_bf16(x[6], x[7])}; }
__device__ __forceinline__ void rope8(float (&x)[8], const float* cs, const float* sn) {
    const f32x4 c = *(const f32x4*)cs, s = *(const f32x4*)sn;
#pragma unroll
    for (int e = 0; e < 4; ++e) { const float xr = x[2 * e], xi = x[2 * e + 1]; x[2 * e] = xr * c[e] - xi * s[e]; x[2 * e + 1] = xr * s[e] + xi * c[e]; }
}
__device__ __forceinline__ void phase_prepA(KP p) {
    unsigned char* ws = p->ws;
    const int lane = TIDX & 63, wave = TIDX >> 6, gw = blockIdx.x * 8 + wave, nw = gridDim.x * 8;
    const bf16_t* projF = (const bf16_t*)(ws + WS_PROJF); bf16_t* projB = (bf16_t*)(ws + WS_PROJB);
    bf16_t* Rb = (bf16_t*)(ws + WS_R); bf16_t* Kb = (bf16_t*)(ws + WS_K); bf16_t* KKb = (bf16_t*)(p->out + OUT_Y); bf16_t* Vb = (bf16_t*)(p->out + OUT_Y + (size_t)NT * AW);
    bf16_t* lora = (bf16_t*)(ws + WS_LORA);
    bf16_t* KbP = (bf16_t*)(ws + WS_KBP); bf16_t* VbP = (bf16_t*)(ws + WS_VBP); bf16_t* KbS = (bf16_t*)(ws + WS_KBS); bf16_t* VbS = (bf16_t*)(ws + WS_VBS);
    const float* cosB = (const float*)(ws + WS_ROPEB_COS); const float* sinB = (const float*)(ws + WS_ROPEB_SIN);
    const float* mix = p->in[I_ABMIX]; const float* k_k = p->in[I_KK]; const float* qg = p->in[I_QG]; const float* kg = p->in[I_KG];
    for (int row = gw; row < NT + 1024; row += nw) {
        if (row >= NT) {
            const int cr = row - NT, b = cr >> 8, t = cr & 255; const size_t drow = (size_t)(b * 2304 + t) * 512 + lane * 8;
            { const float* s = p->in[I_CGK] + (size_t)cr * 512 + lane * 8; const f32x4 a = *(const f32x4*)s, c = *(const f32x4*)(s + 4);
              *(u32x4*)(KbS + drow) = (u32x4){cvt_pk_bf16(a[0], a[1]), cvt_pk_bf16(a[2], a[3]), cvt_pk_bf16(c[0], c[1]), cvt_pk_bf16(c[2], c[3])}; }
            { const float* s = p->in[I_CGV] + (size_t)cr * 512 + lane * 8; const f32x4 a = *(const f32x4*)s, c = *(const f32x4*)(s + 4);
              *(u32x4*)(VbS + drow) = (u32x4){cvt_pk_bf16(a[0], a[1]), cvt_pk_bf16(a[2], a[3]), cvt_pk_bf16(c[0], c[1]), cvt_pk_bf16(c[2], c[3])}; }
            continue;
        }
        const bool samp = row >= NP; int b, t, T;
        if (!samp) { b = row >> 8; t = row & 255; T = 256; } else { const int rr = row - NP; b = rr >> 11; t = rr & 2047; T = 2048; }
        const bool hp = t > 0, hn = t < T - 1;
        const u32x2* pc = (const u32x2*)(projF + (size_t)row * N1F); const u32x2* pp = pc - N1F / 4; const u32x2* pn = pc + N1F / 4;
        const f32x4 z4 = (f32x4){0.f, 0.f, 0.f, 0.f};
        const u32x4* pc8 = (const u32x4*)pc; const u32x4* pp8 = (const u32x4*)pp; const u32x4* pn8 = (const u32x4*)pn;
#pragma unroll
        for (int it = 0; it < 13; ++it) {
            const int c8 = lane + 64 * it;
            float cur[8], prv[8], nxt[8], sh[8];
            unpack8(pc8[c8], cur);
            if (hp) unpack8(pp8[c8], prv); else {
#pragma unroll
                for (int e = 0; e < 8; ++e) prv[e] = 0.f; }
            if (hn) unpack8(pn8[c8], nxt); else {
#pragma unroll
                for (int e = 0; e < 8; ++e) nxt[e] = 0.f; }
            const f32x4 m0 = ((const f32x4*)mix)[2 * c8], m1 = ((const f32x4*)mix)[2 * c8 + 1];
#pragma unroll
            for (int e = 0; e < 8; ++e) { const float mx = e < 4 ? m0[e & 3] : m1[e & 3]; sh[e] = cur[e] + mx * ((prv[e] + nxt[e]) * 0.5f - cur[e]); }
            if (it < 12) {
                const int which = it >> 2, cc = (c8 & 255) * 8; const size_t o = (size_t)row * AW + cc;
                if (which == 0) *(u32x4*)(Rb + o) = pack8(sh);
                else if (which == 2) *(u32x4*)(Vb + o) = pack8(sh);
                else { *(u32x4*)(Kb + o) = pack8(sh);
                    const f32x4 k0 = *(const f32x4*)(k_k + cc), k1 = *(const f32x4*)(k_k + cc + 4); float kk[8]; float ss = 0.f;
#pragma unroll
                    for (int e = 0; e < 8; ++e) { kk[e] = sh[e] * (e < 4 ? k0[e & 3] : k1[e & 3]); ss += kk[e] * kk[e]; }
                    ss += __shfl_xor(ss, 1); ss += __shfl_xor(ss, 2); ss += __shfl_xor(ss, 4);
                    const float inv = 1.0f / fmaxf(sqrtf(ss), 1e-12f);
#pragma unroll
                    for (int e = 0; e < 8; ++e) kk[e] *= inv;
                    *(u32x4*)(KKb + o) = pack8(kk); }
            } else {
                const int cl = lane * 8;
                if ((cl & 255) < 128) {
#pragma unroll
                    for (int e = 0; e < 8; ++e) { const float ex = __expf(2.0f * sh[e]); sh[e] = 1.0f - 2.0f * __builtin_amdgcn_rcpf(ex + 1.0f); } }
                *(u32x4*)(lora + ((size_t)(cl >> 8) * NT + row) * 256 + (cl & 255)) = pack8(sh);
            }
        }
        bf16_t* pb = projB + (size_t)row * N1B;
        {
            const int col = lane * 8, hc = col & 127; float x[8]; unpack8(*(const u32x4*)(pb + 4096 + col), x);
            float ss = 0.f;
#pragma unroll
            for (int e = 0; e < 8; ++e) ss += x[e] * x[e];
            ss = sum16(ss); const float inv = rsqrtf(ss * (1.0f / 128.0f) + 1e-6f);
            const f32x4 g0 = *(const f32x4*)(kg + hc), g1 = *(const f32x4*)(kg + hc + 4);
#pragma unroll
            for (int e = 0; e < 4; ++e) { x[e] = x[e] * inv * g0[e]; x[4 + e] = x[4 + e] * inv * g1[e]; }
            if (!samp) {
                float* o = p->out + OUT_GK + (size_t)row * 512 + col; *(f32x4*)o = (f32x4){x[0], x[1], x[2], x[3]}; *(f32x4*)(o + 4) = (f32x4){x[4], x[5], x[6], x[7]};
                *(u32x4*)(KbP + (size_t)row * 512 + col) = pack8(x);
            } else {
                rope8(x, cosB + t * 64 + (hc >> 1), sinB + t * 64 + (hc >> 1));
                *(u32x4*)(KbS + (size_t)(b * 2304 + 256 + t) * 512 + col) = pack8(x);
            }
        }
        {
            const int col = lane * 8; const u32x4 w = *(const u32x4*)(pb + 4608 + col);
            if (!samp) { float x[8]; unpack8(w, x);
                float* o = p->out + OUT_GV + (size_t)row * 512 + col; *(f32x4*)o = (f32x4){x[0], x[1], x[2], x[3]}; *(f32x4*)(o + 4) = (f32x4){x[4], x[5], x[6], x[7]};
                *(u32x4*)(VbP + (size_t)row * 512 + col) = w;
            } else *(u32x4*)(VbS + (size_t)(b * 2304 + 256 + t) * 512 + col) = w;
        }
    }
}

#define KSWZ(row, colB) ((row) * 256 + ((colB) ^ ((((row) & 7) | ((((row) >> 4) & 1) << 3)) << 4)))
#define PSWZ(row, colB) ((row) * 128 + ((colB) ^ ((((row) >> 1) & 7) << 4)))
#define SBAR() __builtin_amdgcn_sched_barrier(0)
__device__ __forceinline__ int crow(int r, int hi) { return (r & 3) + 8 * (r >> 2) + 4 * hi; }
template <class C>
__device__ __forceinline__ void partialSM(f32x16& p0, f32x16& p1, float& m_reg, float& mn, float& alpha) {
    constexpr float Cc = C::SCALE * 1.4426950408889634f;
    float pmax = p0[0];
#pragma unroll
    for (int r = 1; r < 16; ++r) pmax = fmaxf(pmax, p0[r]);
#pragma unroll
    for (int r = 0; r < 16; ++r) pmax = fmaxf(pmax, p1[r]);
    { auto rr = __builtin_amdgcn_permlane32_swap(__float_as_uint(pmax), __float_as_uint(pmax), false, false);
      pmax = fmaxf(__uint_as_float(rr[0]), __uint_as_float(rr[1])); }
    if (__builtin_expect(__all(pmax - m_reg <= 8.0f / C::SCALE), 1)) { mn = m_reg; alpha = 1.f; }
    else { mn = fmaxf(m_reg, pmax); alpha = __builtin_amdgcn_exp2f((m_reg - mn) * Cc); m_reg = mn; }
    const float mnC = -mn * Cc;
#pragma unroll
    for (int r = 0; r < 16; ++r) p0[r] = fmaf(p0[r], Cc, mnC);
#pragma unroll
    for (int r = 0; r < 16; ++r) p1[r] = fmaf(p1[r], Cc, mnC);
#pragma unroll
    for (int r = 0; r < 16; ++r) p0[r] = __builtin_amdgcn_exp2f(p0[r]);
}
__device__ __forceinline__ void finishSM(f32x16& p0, f32x16& p1, float alpha, float& l_reg, bf16x8& pa0, bf16x8& pa1, bf16x8& pa2, bf16x8& pa3) {
#pragma unroll
    for (int r = 0; r < 16; ++r) p1[r] = __builtin_amdgcn_exp2f(p1[r]);
    float ps = 0;
#pragma unroll
    for (int r = 0; r < 16; ++r) ps += p0[r];
#pragma unroll
    for (int r = 0; r < 16; ++r) ps += p1[r];
    { auto rr = __builtin_amdgcn_permlane32_swap(__float_as_uint(ps), __float_as_uint(ps), false, false);
      ps = __uint_as_float(rr[0]) + __uint_as_float(rr[1]); }
    l_reg = l_reg * alpha + ps;
#define PK4(P, BASE, OUT) do { unsigned a0 = cvt_pk_bf16(P[BASE + 0], P[BASE + 1]), a1 = cvt_pk_bf16(P[BASE + 2], P[BASE + 3]);   \
    unsigned b0 = cvt_pk_bf16(P[BASE + 4], P[BASE + 5]), b1 = cvt_pk_bf16(P[BASE + 6], P[BASE + 7]);                              \
    auto r0 = __builtin_amdgcn_permlane32_swap(a0, b0, false, false); auto r1 = __builtin_amdgcn_permlane32_swap(a1, b1, false, false); \
    u32x4 w = {r0[0], r1[0], r0[1], r1[1]}; OUT = *reinterpret_cast<bf16x8*>(&w); } while (0)
    PK4(p0, 0, pa0); PK4(p0, 8, pa1); PK4(p1, 0, pa2); PK4(p1, 8, pa3);
#undef PK4
}
template <class C>
__device__ __forceinline__ void qkt(f32x16& p0, f32x16& p1, const char* Ks, const char* Ps, const bf16x8* qr, const char* Qpe, int r32, int hi) {
    p0 = f32x16{}; p1 = f32x16{};
#pragma unroll
    for (int d0 = 0; d0 < 8; ++d0) { const int cb = (d0 * 16 + hi * 8) * 2;
        const bf16x8 b0 = *reinterpret_cast<const bf16x8*>(Ks + KSWZ(r32, cb));
        const bf16x8 b1 = *reinterpret_cast<const bf16x8*>(Ks + KSWZ(32 + r32, cb));
        bf16x8 qf; if constexpr (true) { if (d0 < C::NDR) qf = qr[d0 < C::NDR ? d0 : 0]; else qf = *reinterpret_cast<const bf16x8*>(Qpe + (d0 - C::NDR) * 1024); }
        p0 = __builtin_amdgcn_mfma_f32_32x32x16_bf16(b0, qf, p0, 0, 0, 0);
        p1 = __builtin_amdgcn_mfma_f32_32x32x16_bf16(b1, qf, p1, 0, 0, 0); }
    if constexpr (C::PE) {
#pragma unroll
        for (int d1 = 0; d1 < 4; ++d1) { const int cb = (d1 * 16 + hi * 8) * 2;
            const bf16x8 b0 = *reinterpret_cast<const bf16x8*>(Ps + PSWZ(r32, cb));
            const bf16x8 b1 = *reinterpret_cast<const bf16x8*>(Ps + PSWZ(32 + r32, cb));
            const bf16x8 qf = *reinterpret_cast<const bf16x8*>(Qpe + (8 - C::NDR + d1) * 1024);
            p0 = __builtin_amdgcn_mfma_f32_32x32x16_bf16(b0, qf, p0, 0, 0, 0);
            p1 = __builtin_amdgcn_mfma_f32_32x32x16_bf16(b1, qf, p1, 0, 0, 0); }
    }
}
#define QK_PIPE 1
template <class C> __device__ __forceinline__ void qk_pipe() {
#ifdef QK_PIPE
    if constexpr (C::PE) {
        constexpr int NV = 7, NG = 12;
        __builtin_amdgcn_sched_group_barrier(0x100, 4, 0);
#pragma unroll
        for (int g_ = 0; g_ < NG; ++g_) {
            if (g_ + 2 < NG) { if (g_ + 2 < 8) __builtin_amdgcn_sched_group_barrier(0x100, 2, 0); else __builtin_amdgcn_sched_group_barrier(0x100, 3, 0); }
            __builtin_amdgcn_sched_group_barrier(0x402, NV, 0); __builtin_amdgcn_sched_group_barrier(0x008, 2, 0); }
    } else {
        constexpr int NV = 10;
        __builtin_amdgcn_sched_group_barrier(0x100, 2, 0);
#pragma unroll
        for (int g_ = 0; g_ < 8; ++g_) { if (g_ + 1 < 8) __builtin_amdgcn_sched_group_barrier(0x100, 2, 0); __builtin_amdgcn_sched_group_barrier(0x402, NV, 0); __builtin_amdgcn_sched_group_barrier(0x008, 2, 0); }
    }
#endif
}
__device__ __forceinline__ int v_st(int k, int c) { const int kk = (k & ~0xC) | ((k & 4) << 1) | ((k & 8) >> 1); return ((kk >> 3) * 4 + (c >> 5)) * 512 + ((kk & 7) * 32 + (c & 31)) * 2; }
__device__ __forceinline__ int v_rd_base(int lane) { return ((lane & 3) << 3) | (((lane >> 2) & 3) << 6) | (((lane >> 4) & 1) << 5) | (((lane >> 5) & 1) << 8); }
constexpr int v_rd_off(int d0, int ks, int half) { return d0 * 512 + ks * 4096 + half * 2048; }
template <int OFF> __device__ __forceinline__ s16x4 tr_read(int vb) {
    s16x4 r; asm volatile("ds_read_b64_tr_b16 %0, %1 offset:%2" : "=&v"(r) : "v"(vb), "i"(OFF) : "memory"); return r;
}
template <int D0> __device__ __forceinline__ void pv_one(f32x16& od, int vb, bf16x8 pa0, bf16x8 pa1, bf16x8 pa2, bf16x8 pa3) {
    const s16x4 l0 = tr_read<v_rd_off(D0, 0, 0)>(vb), h0 = tr_read<v_rd_off(D0, 0, 1)>(vb), l1 = tr_read<v_rd_off(D0, 1, 0)>(vb), h1 = tr_read<v_rd_off(D0, 1, 1)>(vb);
    const s16x4 l2 = tr_read<v_rd_off(D0, 2, 0)>(vb), h2 = tr_read<v_rd_off(D0, 2, 1)>(vb), l3 = tr_read<v_rd_off(D0, 3, 0)>(vb), h3 = tr_read<v_rd_off(D0, 3, 1)>(vb);
    asm volatile("s_waitcnt lgkmcnt(0)" ::: "memory"); SBAR();
#define PK(L, H) (bf16x8){L[0], L[1], L[2], L[3], H[0], H[1], H[2], H[3]}
    od = __builtin_amdgcn_mfma_f32_32x32x16_bf16(pa0, PK(l0, h0), od, 0, 0, 0);
    od = __builtin_amdgcn_mfma_f32_32x32x16_bf16(pa1, PK(l1, h1), od, 0, 0, 0);
    od = __builtin_amdgcn_mfma_f32_32x32x16_bf16(pa2, PK(l2, h2), od, 0, 0, 0);
    od = __builtin_amdgcn_mfma_f32_32x32x16_bf16(pa3, PK(l3, h3), od, 0, 0, 0);
#undef PK
}
__device__ __forceinline__ void pv_d0(f32x16* o, int vb, bf16x8 pa0, bf16x8 pa1, bf16x8 pa2, bf16x8 pa3) {
    pv_one<0>(o[0], vb, pa0, pa1, pa2, pa3); pv_one<1>(o[1], vb, pa0, pa1, pa2, pa3); pv_one<2>(o[2], vb, pa0, pa1, pa2, pa3); pv_one<3>(o[3], vb, pa0, pa1, pa2, pa3);
}
template <class C>
__device__ __forceinline__ void pv_psm(f32x16* o, int vb, bf16x8 pa0, bf16x8 pa1, bf16x8 pa2, bf16x8 pa3, f32x16& p0, f32x16& p1, float& m_reg, float& mn, float& alpha) {
    constexpr float Cc = C::SCALE * 1.4426950408889634f;
#define PK(L, H) (bf16x8){L[0], L[1], L[2], L[3], H[0], H[1], H[2], H[3]}
#define PVG_READ(D0) const s16x4 l0 = tr_read<v_rd_off(D0, 0, 0)>(vb), h0 = tr_read<v_rd_off(D0, 0, 1)>(vb), l1 = tr_read<v_rd_off(D0, 1, 0)>(vb), h1 = tr_read<v_rd_off(D0, 1, 1)>(vb); \
    const s16x4 l2 = tr_read<v_rd_off(D0, 2, 0)>(vb), h2 = tr_read<v_rd_off(D0, 2, 1)>(vb), l3 = tr_read<v_rd_off(D0, 3, 0)>(vb), h3 = tr_read<v_rd_off(D0, 3, 1)>(vb);
#define PVG_MMA(D0) asm volatile("s_waitcnt lgkmcnt(0)" ::: "memory"); SBAR(); \
    o[D0] = __builtin_amdgcn_mfma_f32_32x32x16_bf16(pa0, PK(l0, h0), o[D0], 0, 0, 0); o[D0] = __builtin_amdgcn_mfma_f32_32x32x16_bf16(pa1, PK(l1, h1), o[D0], 0, 0, 0); \
    o[D0] = __builtin_amdgcn_mfma_f32_32x32x16_bf16(pa2, PK(l2, h2), o[D0], 0, 0, 0); o[D0] = __builtin_amdgcn_mfma_f32_32x32x16_bf16(pa3, PK(l3, h3), o[D0], 0, 0, 0);
    float mnC;
    {   PVG_READ(0)
        float pmax = p0[0];
#pragma unroll
        for (int r = 1; r < 16; ++r) pmax = fmaxf(pmax, p0[r]);
#pragma unroll
        for (int r = 0; r < 16; ++r) pmax = fmaxf(pmax, p1[r]);
        { auto rr = __builtin_amdgcn_permlane32_swap(__float_as_uint(pmax), __float_as_uint(pmax), false, false);
          pmax = fmaxf(__uint_as_float(rr[0]), __uint_as_float(rr[1])); }
        const bool keep = __all(pmax - m_reg <= 8.0f / C::SCALE);
        mn = keep ? m_reg : fmaxf(m_reg, pmax);
        alpha = __builtin_amdgcn_exp2f((m_reg - mn) * Cc); m_reg = mn; mnC = -mn * Cc;
        PVG_MMA(0) }
    {   PVG_READ(1)
#pragma unroll
        for (int r = 0; r < 16; ++r) p0[r] = fmaf(p0[r], Cc, mnC);
        PVG_MMA(1) }
    {   PVG_READ(2)
#pragma unroll
        for (int r = 0; r < 16; ++r) p1[r] = fmaf(p1[r], Cc, mnC);
        PVG_MMA(2) }
    {   PVG_READ(3)
#pragma unroll
        for (int r = 0; r < 16; ++r) p0[r] = __builtin_amdgcn_exp2f(p0[r]);
        PVG_MMA(3) }
    asm volatile("" : "+v"(p0), "+v"(p1));
#undef PK
#undef PVG_READ
#undef PVG_MMA
}
#ifndef MLA_NDR
#define MLA_NDR 8
#endif
#ifndef MLA_SD
#define MLA_SD 1
#endif
struct CfgGqa { static constexpr bool QNORM = true; static constexpr bool PE = false; static constexpr int ND = 8, NDR = 8, LDQ = N1B, LDK = 512, LDV = 512, LDO = DM, LDG = N1B, SDEPTH = 2; static constexpr float SCALE = 0.08838834764831845f; };
struct CfgMla { static constexpr bool QNORM = false; static constexpr bool PE = true; static constexpr int ND = 12, NDR = MLA_NDR, LDQ = 12288, LDK = 16384, LDV = 16384, LDO = 8192, LDG = 8192, SDEPTH = MLA_SD; static constexpr float SCALE = 0.07216878364870323f; };

struct AttnPre { bf16x8 q[8]; u32x4 qp[4]; bf16x8 vs0, vs1, ks0, ks1, ps; };
struct AttnNext { const bf16_t* Q; const bf16_t* K; const bf16_t* V; const bf16_t* P; bool valid; };
template <class C, bool XP = false>
__device__ __forceinline__ void attn_body(const bf16_t* __restrict__ Qb, const bf16_t* __restrict__ Kh, const bf16_t* __restrict__ Vh, const bf16_t* __restrict__ Ph,
                                          bf16_t* __restrict__ Ob, const bf16_t* __restrict__ Gb, int seq, char* lds, const float* ropeC = nullptr, const float* ropeS = nullptr, int t0 = 0, const float* qg = nullptr,
                                          AttnPre* pre = nullptr, bool have = false, AttnNext nxt = AttnNext{nullptr, nullptr, nullptr, nullptr, false}) {
    constexpr int SD = C::SDEPTH; constexpr size_t SHM_V = 64 * 128 * 2, SHM_K = 64 * 128 * 2, SHM_P = C::PE ? 64 * 64 * 2 : 0;
    int tid_ = TIDX; asm volatile("" : "+v"(tid_));
    const int tid = tid_, wid = tid >> 6, lane = tid & 63, r32 = lane & 31, hi = lane >> 5;
    char* V_lds = lds; char* K_lds = lds + 2 * SHM_V; char* P_lds = lds + 2 * SHM_V + 2 * SHM_K;
    float* wsf = (float*)(lds + 2 * SHM_V + 2 * SHM_K + 2 * SHM_P) + wid * 64; float* li_l = wsf; float* al_l = wsf + 32;
    float m_reg = -1e30f, l_reg = 0; f32x16 o[4] = {}; bf16x8 qr[C::NDR];
    const bf16_t* Qw = Qb + (long)(wid * 32 + r32) * C::LDQ + hi * 8;
    char* Qpe = (char*)(wsf - wid * 64) + 2048 + wid * ((C::ND - C::NDR) * 1024) + lane * 16;
    __syncthreads();
    const int sr = tid >> 4, sc = (tid & 15) * 8, vst0 = v_st(sr, sc), vst1 = v_st(32 + sr, sc);
    const int pr = tid >> 3, pc = (tid & 7) * 8;
    const int vb0 = (int)(uintptr_t)V_lds + v_rd_base(lane);
    struct { bf16x8 vs0, vs1, ks0, ks1, ps; } sr_[SD];
#define GAS __attribute__((address_space(1)))
    static_assert(C::LDV == C::LDK, "K and V tiles share their lane offset");
    const unsigned vo = (unsigned)((sr * C::LDV + sc) * 2), po = (unsigned)((pr * 64 + pc) * 2);
#define SLOAD(i, k0) do { const char* vb_ = (const char*)Vh + (size_t)(k0) * (C::LDV * 2); const char* kb_ = (const char*)Kh + (size_t)(k0) * (C::LDK * 2); \
    const char* pb_ = C::PE ? (const char*)Ph + (size_t)(k0) * 128 : nullptr; asm volatile("" : "+s"(vb_), "+s"(kb_), "+s"(pb_)); \
    sr_[i].vs0 = *(const GAS bf16x8*)((const GAS char*)vb_ + vo); sr_[i].vs1 = *(const GAS bf16x8*)((const GAS char*)vb_ + (size_t)32 * C::LDV * 2 + vo); \
    sr_[i].ks0 = *(const GAS bf16x8*)((const GAS char*)kb_ + vo); sr_[i].ks1 = *(const GAS bf16x8*)((const GAS char*)kb_ + (size_t)32 * C::LDK * 2 + vo); \
    if constexpr (C::PE) sr_[i].ps = *(const GAS bf16x8*)((const GAS char*)pb_ + po); } while (0)
#define SWRITE(b, i) do { *(bf16x8*)(V_lds + (b) * SHM_V + vst0) = sr_[i].vs0; *(bf16x8*)(V_lds + (b) * SHM_V + vst1) = sr_[i].vs1; const int kc = sc * 2; \
    *(bf16x8*)(K_lds + (b) * SHM_K + KSWZ(sr, kc)) = sr_[i].ks0; *(bf16x8*)(K_lds + (b) * SHM_K + KSWZ(32 + sr, kc)) = sr_[i].ks1; \
    if constexpr (C::PE) *(bf16x8*)(P_lds + (b) * SHM_P + PSWZ(pr, pc * 2)) = sr_[i].ps; } while (0)
#define SWAIT() do { if constexpr (SD == 2) { if constexpr (C::PE) asm volatile("s_waitcnt vmcnt(5)" ::: "memory"); else asm volatile("s_waitcnt vmcnt(4)" ::: "memory"); } else asm volatile("s_waitcnt vmcnt(0)" ::: "memory"); } while (0)
#define RESC(a) do { if (__any((a) < 1.f)) { if (hi == 0) al_l[r32] = (a); asm volatile("s_waitcnt lgkmcnt(0)" ::: "memory"); \
    _Pragma("unroll") for (int d = 0; d < 4; ++d) _Pragma("unroll") for (int r = 0; r < 16; ++r) o[d][r] *= al_l[crow(r, hi)]; } } while (0)
    f32x16 pA0, pA1, pB0, pB1; float mnA, mnB, alA, alB; bf16x8 pa0, pa1, pa2, pa3; const int NTl = seq / 64;
    if (__builtin_amdgcn_readfirstlane(wid) >= 4) __builtin_amdgcn_s_setprio(1);
    constexpr int SE = 0, SO = SD - 1;
    constexpr int NPK = (C::ND - C::NDR) > 0 ? (C::ND - C::NDR) : 1; u32x4 qp[NPK];
    if (XP && have) {
        if constexpr (XP) {
#pragma unroll
            for (int d0 = 0; d0 < C::NDR; ++d0) qr[d0] = pre->q[d0];
#pragma unroll
            for (int d1 = 0; d1 < C::ND - C::NDR; ++d1) qp[d1] = pre->qp[d1];
            sr_[SE].vs0 = pre->vs0; sr_[SE].vs1 = pre->vs1; sr_[SE].ks0 = pre->ks0; sr_[SE].ks1 = pre->ks1; sr_[SE].ps = pre->ps;
        }
    } else {
#pragma unroll
        for (int d0 = 0; d0 < C::NDR; ++d0) qr[d0] = *reinterpret_cast<const bf16x8*>(Qw + d0 * 16);
        if constexpr (C::PE) {
#pragma unroll
            for (int d1 = 0; d1 < C::ND - C::NDR; ++d1) qp[d1] = *reinterpret_cast<const u32x4*>(Qw + (C::NDR + d1) * 16);
        }
        SLOAD(SE, 0); if constexpr (SD == 2) SLOAD(SO, 64);
    }
    if constexpr (C::QNORM) {
        float ss = 0.f;
#pragma unroll
        for (int d0 = 0; d0 < 8; ++d0) { float x[8]; unpack8(*reinterpret_cast<const u32x4*>(&qr[d0]), x);
#pragma unroll
            for (int e = 0; e < 8; ++e) ss += x[e] * x[e]; }
        { auto rr = __builtin_amdgcn_permlane32_swap(__float_as_uint(ss), __float_as_uint(ss), false, false); ss = __uint_as_float(rr[0]) + __uint_as_float(rr[1]); }
        const float inv = rsqrtf(ss * (1.0f / 128.0f) + 1e-6f);
#pragma unroll
        for (int d0 = 0; d0 < 8; ++d0) { float x[8]; unpack8(*reinterpret_cast<const u32x4*>(&qr[d0]), x); const int dim = d0 * 16 + hi * 8;
            const f32x4 g0 = *(const f32x4*)(qg + dim), g1 = *(const f32x4*)(qg + dim + 4);
#pragma unroll
            for (int e = 0; e < 4; ++e) { x[e] = x[e] * inv * g0[e]; x[4 + e] = x[4 + e] * inv * g1[e]; }
            if (ropeC != nullptr) { const int to = (t0 + wid * 32 + r32) * 64 + (dim >> 1); rope8(x, ropeC + to, ropeS + to); }
            const u32x4 w = pack8(x); qr[d0] = *reinterpret_cast<const bf16x8*>(&w); }
    }
    if constexpr (C::PE) {
#pragma unroll
        for (int d1 = 0; d1 < C::ND - C::NDR; ++d1) {
            u32x4 f = qp[d1];
            if (C::NDR + d1 >= 8 && ropeC != nullptr) {
                const int pe = C::NDR + d1 - 8; const int to = (t0 + wid * 32 + r32) * 32 + pe * 8 + hi * 4;
                float x[8]; unpack8(f, x); rope8(x, ropeC + to, ropeS + to); f = pack8(x); }
            *reinterpret_cast<u32x4*>(Qpe + d1 * 1024) = f; }
    }
    if constexpr (SD == 2) { if constexpr (C::PE) asm volatile("s_waitcnt vmcnt(5)" ::: "memory"); else asm volatile("s_waitcnt vmcnt(4)" ::: "memory"); } else asm volatile("s_waitcnt vmcnt(0)" ::: "memory");
    SWRITE(0, SE);
    if constexpr (SD == 1) SLOAD(SO, 64); else { if (2 < NTl) SLOAD(SE, 2 * 64); }
    __syncthreads();
    qkt<C>(pA0, pA1, K_lds, P_lds, qr, Qpe, r32, hi); partialSM<C>(pA0, pA1, m_reg, mnA, alA);
    SWAIT(); SWRITE(1, SO); if constexpr (SD == 1) { if (2 < NTl) SLOAD(SO, 2 * 64); } __syncthreads();
    for (int j = 1; j + 1 < NTl; j += 2) {
        SBAR(); qkt<C>(pB0, pB1, K_lds + SHM_K, P_lds + SHM_P, qr, Qpe, r32, hi);
        finishSM(pA0, pA1, alA, l_reg, pa0, pa1, pa2, pa3); qk_pipe<C>(); SBAR();
        if constexpr (SD == 2) SLOAD(SO, (j + SD) * 64); SBAR();
        pv_psm<C>(o, vb0, pa0, pa1, pa2, pa3, pB0, pB1, m_reg, mnB, alB);
        __syncthreads(); SWAIT(); SWRITE(0, SE); if constexpr (SD == 1) SLOAD(SE, (j + 2) * 64);
        RESC(alB); __syncthreads();
        SBAR(); qkt<C>(pA0, pA1, K_lds, P_lds, qr, Qpe, r32, hi);
        finishSM(pB0, pB1, alB, l_reg, pa0, pa1, pa2, pa3); qk_pipe<C>(); SBAR();
        if constexpr (SD == 2) { if (j + 3 < NTl) SLOAD(SE, (j + 1 + SD) * 64); } SBAR();
        pv_psm<C>(o, vb0 + (int)SHM_V, pa0, pa1, pa2, pa3, pA0, pA1, m_reg, mnA, alA);
        __syncthreads(); SWAIT(); SWRITE(1, SO); if constexpr (SD == 1) { if (j + 3 < NTl) SLOAD(SO, (j + 3) * 64); }
        RESC(alA); __syncthreads();
    }
    SBAR(); qkt<C>(pB0, pB1, K_lds + SHM_K, P_lds + SHM_P, qr, Qpe, r32, hi);
    finishSM(pA0, pA1, alA, l_reg, pa0, pa1, pa2, pa3); SBAR();
    const int widu = __builtin_amdgcn_readfirstlane(wid);
    const char* Gw = (const char*)(Gb + (long)(widu * 32) * C::LDG); char* Ow = (char*)(Ob + (long)(widu * 32) * C::LDO);
    asm volatile("" : "+s"(Gw));
    u32x4 gq[8];
#pragma unroll
    for (int i = 0; i < 8; ++i) { const int ch = i * 64 + lane; gq[i] = *(const GAS u32x4*)((const GAS char*)Gw + (unsigned)((ch >> 4) * C::LDG * 2 + (ch & 15) * 16)); }
    SBAR();
    pv_psm<C>(o, vb0, pa0, pa1, pa2, pa3, pB0, pB1, m_reg, mnB, alB);
    __syncthreads(); RESC(alB);
    finishSM(pB0, pB1, alB, l_reg, pa0, pa1, pa2, pa3); SBAR();
    pv_d0(o, vb0 + (int)SHM_V, pa0, pa1, pa2, pa3);
    if constexpr (XP) {
        static_assert(!XP || (SD == 1 && C::PE && C::NDR == 8 && C::ND == 12), "cross-unit prefetch is written for the MLA configuration");
        {
            int t2 = tid; asm volatile("" : "+v"(t2));
            const int w2 = t2 >> 6, l2 = t2 & 63, sr2 = t2 >> 4, sc2 = (t2 & 15) * 8, pr2 = t2 >> 3, pc2 = (t2 & 7) * 8;
            const bf16_t* nQw = nxt.Q + (long)(w2 * 32 + (l2 & 31)) * C::LDQ + (l2 >> 5) * 8;
#pragma unroll
            for (int d0 = 0; d0 < C::NDR; ++d0) pre->q[d0] = *reinterpret_cast<const bf16x8*>(nQw + d0 * 16);
#pragma unroll
            for (int d1 = 0; d1 < C::ND - C::NDR; ++d1) pre->qp[d1] = *reinterpret_cast<const u32x4*>(nQw + (C::NDR + d1) * 16);
            pre->vs0 = *reinterpret_cast<const bf16x8*>(&nxt.V[(long)sr2 * C::LDV + sc2]); pre->vs1 = *reinterpret_cast<const bf16x8*>(&nxt.V[(long)(32 + sr2) * C::LDV + sc2]);
            pre->ks0 = *reinterpret_cast<const bf16x8*>(&nxt.K[(long)sr2 * C::LDK + sc2]); pre->ks1 = *reinterpret_cast<const bf16x8*>(&nxt.K[(long)(32 + sr2) * C::LDK + sc2]);
            pre->ps = *reinterpret_cast<const bf16x8*>(&nxt.P[(long)pr2 * 64 + pc2]);
        }
    }
    if (hi == 0) li_l[r32] = l_reg; asm volatile("s_waitcnt lgkmcnt(0)" ::: "memory");
    float rli[16];
#pragma unroll
    for (int r = 0; r < 16; ++r) rli[r] = __builtin_amdgcn_rcpf(li_l[crow(r, hi)]);
    __builtin_amdgcn_s_setprio(0);
    __syncthreads();
    int te = tid; asm volatile("" : "+v"(te));
    const int lane_e = te & 63, r32e = te & 31, hie = (te >> 5) & 1;
    char* Ost = lds + (te >> 6) * 8192;
#pragma unroll
    for (int r = 0; r < 16; ++r)
#pragma unroll
        for (int d0 = 0; d0 < 4; ++d0) *(bf16_t*)(Ost + crow(r, hie) * 256 + (d0 * 32 + r32e) * 2) = (bf16_t)(cvt_pk_bf16(o[d0][r] * rli[r], 0.f) & 0xffffu);
    asm volatile("s_waitcnt lgkmcnt(0)" ::: "memory");
#pragma unroll
    for (int i = 0; i < 8; ++i) { const int ch = i * 64 + lane_e; const int row = ch >> 4, c8 = ch & 15;
        float ov[8], gvv[8]; unpack8(*(const u32x4*)(Ost + row * 256 + c8 * 16), ov); unpack8(gq[i], gvv);
#pragma unroll
        for (int e = 0; e < 8; ++e) ov[e] *= silu_f(gvv[e]);
        *(u32x4*)(Ow + (unsigned)(row * C::LDO * 2 + c8 * 16)) = pack8(ov); if constexpr (XP) SBAR(); }
#undef SLOAD
#undef GAS
#undef SWRITE
#undef SWAIT
#undef RESC
}

constexpr int SLOT_BYTES = 18688;
#define LFENCE() asm volatile("s_waitcnt lgkmcnt(0)" ::: "memory")
#ifdef USE_LF2
#define LF2() __builtin_amdgcn_sched_barrier(0)
#else
#define LF2() do {} while (0)
#endif
__device__ __forceinline__ float ldf(const float* base, unsigned boff) { return *(const float*)((const char*)base + boff); }
__device__ __forceinline__ void stf(float* base, unsigned boff, float v) { *(float*)((char*)base + boff) = v; }
struct Chain { const bf16_t* Rb; const bf16_t* KKb; const bf16_t* Vb; const bf16_t* Wd; const bf16_t* Ad; const bf16_t* Kb; bf16_t* Yd; float k_a; int row0, T, h, d; };
__device__ __forceinline__ unsigned chain_eoff(const Chain& c, int step, int col) { const int row = c.row0 + (c.d ? c.T - 1 - step : step); return ((unsigned)row * (unsigned)AW + (unsigned)col) * 4u; }

struct ScanOps { float w[16], ka[16], b[16], k[16], r[16], v[16]; };
struct ScanStage { u32x4 st[6][2]; };
__device__ __forceinline__ void scanA_issue(const Chain& c, int chunk, int lane_, ScanStage& g) {
    int lane = lane_; asm volatile("" : "+v"(lane));
    const bf16_t* arr[6] = {c.Wd, c.KKb, c.Ad, c.Kb, c.Rb, c.Vb};
#pragma unroll
    for (int k2 = 0; k2 < 2; ++k2) { const int idx = lane + 64 * k2, tau = idx >> 3, q = idx & 7; const int step = chunk * 16 + tau;
        const int row = c.row0 + (c.d ? c.T - 1 - step : step); const unsigned boff = ((unsigned)row * (unsigned)AW + (unsigned)(c.h * 64 + q * 8)) * 2u;
#pragma unroll
        for (int a = 0; a < 6; ++a) g.st[a][k2] = *(const u32x4*)((const char*)arr[a] + boff); }
}
__device__ __forceinline__ void scanA_unpack(const ScanStage& g, int lane_, char* slot, ScanOps& o) {
    int lane = lane_; asm volatile("" : "+v"(lane));
#pragma unroll
    for (int k2 = 0; k2 < 2; ++k2) { const int idx = lane + 64 * k2;
#pragma unroll
        for (int a = 0; a < 6; ++a) *(u32x4*)(slot + a * 2048 + idx * 16) = g.st[a][k2]; }
    asm volatile("s_waitcnt lgkmcnt(0)" ::: "memory");
#pragma unroll
    for (int t = 0; t < 16; ++t) { const char* e = slot + t * 128 + lane * 2;
        o.w[t] = bf2f(*(const bf16_t*)(e)); o.ka[t] = bf2f(*(const bf16_t*)(e + 2048)); o.b[t] = bf2f(*(const bf16_t*)(e + 4096));
        o.k[t] = bf2f(*(const bf16_t*)(e + 6144)); o.r[t] = bf2f(*(const bf16_t*)(e + 8192)); o.v[t] = bf2f(*(const bf16_t*)(e + 10240)); }
    asm volatile("s_waitcnt lgkmcnt(0)" ::: "memory");
}
__device__ __forceinline__ void scanA(const Chain& c, int chunk, const ScanOps& o, int lane_, char* slot) {
    int lane = lane_; asm volatile("" : "+v"(lane));
    float bt[16], kq[16]; float gL;
    float vv[16];
#pragma unroll
    for (int t = 0; t < 16; ++t) vv[t] = o.v[t];
    {
        float kt[16], rt[16]; float g = 1.0f;
        float cu = 0.f;
#pragma unroll
        for (int t = 0; t < 16; ++t) { const float gp = g; cu += o.w[t]; g = __builtin_amdgcn_exp2f(cu); const float ig = __builtin_amdgcn_exp2f(-cu);
            const float av = o.b[t], bb = o.ka[t] * av, kd = o.k[t] * (1.0f + (av - 1.0f) * c.k_a);
            kt[t] = o.ka[t] * gp; rt[t] = o.r[t] * g; bt[t] = bb * ig; kq[t] = kd * ig; }
        gL = g;
#pragma unroll
        for (int t = 0; t < 16; ++t) {
            const int o0 = t * 128 + ((lane * 2) ^ ((t & 7) << 4)), o1 = (16 + t) * 128 + ((lane * 2) ^ ((t & 7) << 4));
            *(bf16_t*)(slot + o0) = (bf16_t)(cvt_pk_bf16(bt[t], 0.f) & 0xffffu); *(bf16_t*)(slot + o1) = (bf16_t)(cvt_pk_bf16(kq[t], 0.f) & 0xffffu);
            *(bf16_t*)(slot + 8192 + o0) = (bf16_t)(cvt_pk_bf16(kt[t], 0.f) & 0xffffu); *(bf16_t*)(slot + 8192 + o1) = (bf16_t)(cvt_pk_bf16(rt[t], 0.f) & 0xffffu);
        }
#pragma unroll
        for (int q = 0; q < 2; ++q) {
            *(u32x4*)(slot + 12544 + lane * 64 + 16 * q) = (u32x4){cvt_pk_bf16(kt[8 * q], kt[8 * q + 1]), cvt_pk_bf16(kt[8 * q + 2], kt[8 * q + 3]), cvt_pk_bf16(kt[8 * q + 4], kt[8 * q + 5]), cvt_pk_bf16(kt[8 * q + 6], kt[8 * q + 7])};
            *(u32x4*)(slot + 12544 + lane * 64 + 32 + 16 * q) = (u32x4){cvt_pk_bf16(rt[8 * q], rt[8 * q + 1]), cvt_pk_bf16(rt[8 * q + 2], rt[8 * q + 3]), cvt_pk_bf16(rt[8 * q + 4], rt[8 * q + 5]), cvt_pk_bf16(rt[8 * q + 6], rt[8 * q + 7])};
        }

        *(float*)(slot + 12288 + lane * 4) = gL;
    }
    LFENCE();
    const int m = lane & 31, hi = lane >> 5;
    {
        f32x16 C = {};
#pragma unroll
        for (int ks = 0; ks < 4; ++ks) { const int o = m * 128 + (((2 * ks + hi) ^ (m & 7)) << 4);
            const bf16x8 a = *(const bf16x8*)(slot + o), b = *(const bf16x8*)(slot + 8192 + o);
            C = __builtin_amdgcn_mfma_f32_32x32x16_bf16(a, b, C, 0, 0, 0); }
        LFENCE();
#pragma unroll
        for (int r = 0; r < 16; ++r) *(float*)(slot + (crow(r, hi) * 32 + m) * 4) = C[r];
    }
    LFENCE();
    const float* G = (const float*)slot; float* Tm = (float*)(slot + 8192); float* Wm = (float*)(slot + 6144);
    char* B1T = slot + 9216; char* B2T = slot + 11264;
    {
        const int tcol = lane & 15, sq = lane >> 4;
        float Tc[16];
#pragma unroll
        for (int s = 0; s < 16; ++s) Tc[s] = (s == tcol) ? 1.0f : 0.0f;
#pragma unroll
        for (int s = 14; s >= 0; --s) {
            float a = 0.f;
#pragma unroll
            for (int q = (s + 1) / 4; q < 4; ++q) { const f32x4 gr = *(const f32x4*)(G + s * 32 + 4 * q);
#pragma unroll
                for (int e = 0; e < 4; ++e) if (4 * q + e > s) a += gr[e] * Tc[4 * q + e]; }
            if (s < tcol) Tc[s] = -a;
        }
        if (lane < 16) {
#pragma unroll
            for (int s = 0; s < 16; ++s) Tm[s * 16 + tcol] = Tc[s];
            const u32x4 z4 = (u32x4){0u, 0u, 0u, 0u};
            *(u32x4*)(B1T + tcol * 64) = (u32x4){cvt_pk_bf16(Tc[0], Tc[1]), cvt_pk_bf16(Tc[2], Tc[3]), cvt_pk_bf16(Tc[4], Tc[5]), cvt_pk_bf16(Tc[6], Tc[7])};
            *(u32x4*)(B1T + tcol * 64 + 16) = (u32x4){cvt_pk_bf16(Tc[8], Tc[9]), cvt_pk_bf16(Tc[10], Tc[11]), cvt_pk_bf16(Tc[12], Tc[13]), cvt_pk_bf16(Tc[14], Tc[15])};
            *(u32x4*)(B1T + tcol * 64 + 32) = z4; *(u32x4*)(B1T + tcol * 64 + 48) = z4;
            const unsigned one = (tcol & 1) ? 0x3F800000u : 0x00003F80u; const int wi = tcol >> 1;
            *(u32x4*)(B1T + (16 + tcol) * 64 + 32) = (u32x4){wi == 0 ? one : 0u, wi == 1 ? one : 0u, wi == 2 ? one : 0u, wi == 3 ? one : 0u};
            *(u32x4*)(B1T + (16 + tcol) * 64 + 48) = (u32x4){wi == 4 ? one : 0u, wi == 5 ? one : 0u, wi == 6 ? one : 0u, wi == 7 ? one : 0u};
        }
        float Wv[4];
#pragma unroll
        for (int si = 0; si < 4; ++si) { const int s = 4 * sq + si; float a = 0.f;
#pragma unroll
            for (int q = 0; q < 4; ++q) { const f32x4 gr = *(const f32x4*)(G + (16 + s) * 32 + 4 * q);
#pragma unroll
                for (int e = 0; e < 4; ++e) a += ((4 * q + e > s) ? gr[e] : 0.f) * Tc[4 * q + e]; }
            Wv[si] = a; Wm[s * 16 + tcol] = a; }
        *(u32x2*)(B2T + tcol * 32 + 8 * sq) = (u32x2){cvt_pk_bf16(Wv[0], Wv[1]), cvt_pk_bf16(Wv[2], Wv[3])};
        LFENCE();
        float nb[16];
#pragma unroll
        for (int u = 0; u < 16; ++u) { const float x = G[u * 32 + 16 + tcol]; nb[u] = (u <= tcol) ? x : 0.f; }
        float Zv[4], Nv[4];
#pragma unroll
        for (int si = 0; si < 4; ++si) { const int s = 4 * sq + si; const float nk = G[(16 + s) * 32 + 16 + tcol]; float a = (s <= tcol) ? nk : 0.f; float tn = 0.f;
#pragma unroll
            for (int q = 0; q < 4; ++q) { const f32x4 wr = *(const f32x4*)(Wm + s * 16 + 4 * q); const f32x4 tr = *(const f32x4*)(Tm + s * 16 + 4 * q);
#pragma unroll
                for (int e = 0; e < 4; ++e) { a -= wr[e] * nb[4 * q + e]; tn += tr[e] * nb[4 * q + e]; } }
            Zv[si] = a; Nv[si] = -tn; }
        *(u32x2*)(B2T + (16 + tcol) * 32 + 8 * sq) = (u32x2){cvt_pk_bf16(Zv[0], Zv[1]), cvt_pk_bf16(Zv[2], Zv[3])};
        *(u32x2*)(B1T + (16 + tcol) * 64 + 8 * sq) = (u32x2){cvt_pk_bf16(Nv[0], Nv[1]), cvt_pk_bf16(Nv[2], Nv[3])};
    }
    LFENCE();
    {
        f32x16 C0 = {}, C1 = {};
#pragma unroll
        for (int ks = 0; ks < 2; ++ks) { const bf16x8 b = *(const bf16x8*)(B1T + m * 64 + (16 * ks + 8 * hi) * 2);
            C0 = __builtin_amdgcn_mfma_f32_32x32x16_bf16(*(const bf16x8*)(slot + 12544 + m * 64 + (16 * ks + 8 * hi) * 2), b, C0, 0, 0, 0);
            C1 = __builtin_amdgcn_mfma_f32_32x32x16_bf16(*(const bf16x8*)(slot + 12544 + (32 + m) * 64 + (16 * ks + 8 * hi) * 2), b, C1, 0, 0, 0); }
        LFENCE();
        const int tile = m >> 4, t = m & 15;
#pragma unroll
        for (int half = 0; half < 2; ++half) { const int gq = 2 * half + hi;
            *(u32x4*)(slot + ((tile * 2 + 0) * 64 + t + 16 * gq) * 16) = (u32x4){cvt_pk_bf16(C0[4 * half], C0[4 * half + 1]), cvt_pk_bf16(C0[4 * half + 2], C0[4 * half + 3]),
                                                                             cvt_pk_bf16(C0[4 * half + 8], C0[4 * half + 9]), cvt_pk_bf16(C0[4 * half + 10], C0[4 * half + 11])};
            *(u32x4*)(slot + ((tile * 2 + 1) * 64 + t + 16 * gq) * 16) = (u32x4){cvt_pk_bf16(C1[4 * half], C1[4 * half + 1]), cvt_pk_bf16(C1[4 * half + 2], C1[4 * half + 3]),
                                                                             cvt_pk_bf16(C1[4 * half + 8], C1[4 * half + 9]), cvt_pk_bf16(C1[4 * half + 10], C1[4 * half + 11])}; }
    }
#pragma unroll
    for (int q = 0; q < 2; ++q)
        *(u32x4*)(slot + 16640 + lane * 32 + 16 * q) = (u32x4){cvt_pk_bf16(vv[8 * q], vv[8 * q + 1]), cvt_pk_bf16(vv[8 * q + 2], vv[8 * q + 3]), cvt_pk_bf16(vv[8 * q + 4], vv[8 * q + 5]), cvt_pk_bf16(vv[8 * q + 6], vv[8 * q + 7])};
    LFENCE();
    {
        const bf16x8 b = *(const bf16x8*)(B2T + m * 32 + 8 * hi * 2);
        const f32x16 z16 = {};
        const f32x16 C0 = __builtin_amdgcn_mfma_f32_32x32x16_bf16(*(const bf16x8*)(slot + 16640 + m * 32 + 8 * hi * 2), b, z16, 0, 0, 0);
        const f32x16 C1 = __builtin_amdgcn_mfma_f32_32x32x16_bf16(*(const bf16x8*)(slot + 16640 + (32 + m) * 32 + 8 * hi * 2), b, z16, 0, 0, 0);
        LFENCE();
        char* dst = slot + (m < 16 ? 8192 : 12544) + (m & 15) * 4;
#pragma unroll
        for (int r = 0; r < 16; ++r) { *(float*)(dst + crow(r, hi) * 64) = C0[r]; *(float*)(dst + (32 + crow(r, hi)) * 64) = C1[r]; }
    }
#pragma unroll
    for (int g4 = 0; g4 < 4; ++g4) {
        u32x4 w; w.x = cvt_pk_bf16(kq[4 * g4] * gL, kq[4 * g4 + 1] * gL); w.y = cvt_pk_bf16(kq[4 * g4 + 2] * gL, kq[4 * g4 + 3] * gL);
        w.z = cvt_pk_bf16(-bt[4 * g4] * gL, -bt[4 * g4 + 1] * gL); w.w = cvt_pk_bf16(-bt[4 * g4 + 2] * gL, -bt[4 * g4 + 3] * gL);
        *(u32x4*)(slot + 4096 + ((lane >> 4) * 64 + (lane & 15) + 16 * g4) * 16) = w;
    }
}

__device__ __forceinline__ void scanB(const Chain& c, int chunk, int lane_, int sl, const char* slot, f32x4 (&acc)[4]) {
    int lane = lane_; asm volatile("" : "+v"(lane));
    const int n = lane & 15, g = lane >> 4; const int col = c.h * 64 + 16 * sl + n;
    unsigned offs[4]; const int estride = c.d ? -AW * 4 : AW * 4; const unsigned e0 = chain_eoff(c, chunk * 16 + 4 * g, col);
#pragma unroll
    for (int e = 0; e < 4; ++e) offs[e] = e0 + (unsigned)(e * estride);
    const u32x2 vq2 = *(const u32x2*)(slot + 16640 + (16 * sl + n) * 32 + 8 * g);

    bf16x8 bfr[2];
#pragma unroll
    for (int s = 0; s < 2; ++s) { u32x4 w; w.x = cvt_pk_bf16(acc[2 * s][0], acc[2 * s][1]); w.y = cvt_pk_bf16(acc[2 * s][2], acc[2 * s][3]);
        w.z = cvt_pk_bf16(acc[2 * s + 1][0], acc[2 * s + 1][1]); w.w = cvt_pk_bf16(acc[2 * s + 1][2], acc[2 * s + 1][3]); bfr[s] = *reinterpret_cast<bf16x8*>(&w); }
    f32x4 aU = *(const f32x4*)(slot + 8192 + (16 * sl + n) * 64 + 16 * g);
    f32x4 aY = *(const f32x4*)(slot + 12544 + (16 * sl + n) * 64 + 16 * g);
#pragma unroll
    for (int s = 0; s < 2; ++s) {
        aU = __builtin_amdgcn_mfma_f32_16x16x32_bf16(*(const bf16x8*)(slot + ((0 * 2 + s) * 64 + lane) * 16), bfr[s], aU, 0, 0, 0);
        aY = __builtin_amdgcn_mfma_f32_16x16x32_bf16(*(const bf16x8*)(slot + ((1 * 2 + s) * 64 + lane) * 16), bfr[s], aY, 0, 0, 0);
    }
#pragma unroll
    for (int e = 0; e < 4; ++e) *(bf16_t*)((char*)c.Yd + (offs[e] >> 1)) = (bf16_t)(cvt_pk_bf16(aY[e], 0.f) & 0xffffu);
    bf16x8 b2; { u32x4 w; w.x = vq2.x; w.y = vq2.y; w.z = cvt_pk_bf16(aU[0], aU[1]); w.w = cvt_pk_bf16(aU[2], aU[3]); b2 = *reinterpret_cast<bf16x8*>(&w); }
#pragma unroll
    for (int tl = 0; tl < 4; ++tl) { const f32x4 gm = *(const f32x4*)(slot + 12288 + (16 * tl + 4 * g) * 4);
        acc[tl] = __builtin_amdgcn_mfma_f32_16x16x32_bf16(*(const bf16x8*)(slot + 4096 + (tl * 64 + lane) * 16), b2, acc[tl] * gm, 0, 0, 0); }
}

__device__ __forceinline__ void scan_pair(KP p, bool samp, int q, char* lds) {
    int tid_ = TIDX; asm volatile("" : "+v"(tid_));
    const int lane = tid_ & 63, wave = __builtin_amdgcn_readfirstlane(tid_ >> 6), grp = wave >> 2, sl = wave & 3;
    unsigned char* ws = p->ws;
    const int ci = 2 * q + grp, b = ci >> 6, h = (ci >> 1) & 31, d = ci & 1;
    Chain c; c.Rb = (const bf16_t*)(ws + WS_R); c.KKb = (const bf16_t*)(p->out + OUT_Y); c.Vb = (const bf16_t*)(p->out + OUT_Y + (size_t)NT * AW);
    c.Wd = (const bf16_t*)(ws + WS_WD + (size_t)d * 2 * SZA); c.Ad = (const bf16_t*)(ws + WS_WD + (size_t)d * 2 * SZA + SZA); c.Kb = (const bf16_t*)(ws + WS_K); c.k_a = p->in[I_KA][h * 64 + lane];
    c.Yd = (bf16_t*)(ws + WS_YA + (size_t)d * SZA); c.T = samp ? 2048 : 256; c.row0 = samp ? NP + b * 2048 : b * 256; c.h = h; c.d = d;
    const int n = lane & 15, g = lane >> 4;
    f32x4 acc[4];
    if (samp) { const float* s0 = p->in[I_STATE] + ((size_t)((b * 2 + d) * 32 + h)) * 4096 + (16 * sl + n) * 64 + 4 * g;
#pragma unroll
        for (int tl = 0; tl < 4; ++tl) acc[tl] = *(const f32x4*)(s0 + 16 * tl); }
    else {
#pragma unroll
        for (int tl = 0; tl < 4; ++tl) acc[tl] = (f32x4){0.f, 0.f, 0.f, 0.f}; }
    char* slots = lds + grp * 4 * SLOT_BYTES;
    const int NR = c.T / 64;
    ScanStage stg; scanA_issue(c, sl, lane, stg);
    for (int R = 0; R < NR; ++R) {
        { ScanOps ops; scanA_unpack(stg, lane, slots + sl * SLOT_BYTES, ops);
          if (R + 1 < NR) scanA_issue(c, 4 * (R + 1) + sl, lane, stg);
          scanA(c, 4 * R + sl, ops, lane, slots + sl * SLOT_BYTES); }
        asm volatile("s_waitcnt lgkmcnt(0)" ::: "memory"); __builtin_amdgcn_s_barrier(); asm volatile("" ::: "memory");
#pragma unroll
        for (int cc = 0; cc < 4; ++cc) scanB(c, 4 * R + cc, lane, sl, slots + cc * SLOT_BYTES, acc);
        asm volatile("s_waitcnt lgkmcnt(0)" ::: "memory"); __builtin_amdgcn_s_barrier(); asm volatile("" ::: "memory");
    }
    if (!samp) { float* so = p->out + OUT_STATE + ((size_t)((b * 2 + d) * 32 + h)) * 4096 + (16 * sl + n) * 64 + 4 * g;
#pragma unroll
        for (int tl = 0; tl < 4; ++tl) *(f32x4*)(so + 16 * tl) = acc[tl]; }
}

__device__ __forceinline__ void phase_scan_attn(KP p, char* lds) {
    unsigned char* ws = p->ws;
    unsigned* qhead = (unsigned*)(ws + WS_CTL) + 4096;
    bf16_t* projB = (bf16_t*)(ws + WS_PROJB); bf16_t* mixed = (bf16_t*)(ws + WS_MIXED);
#ifdef STATIC_Q
    for (int item = blockIdx.x; item < 1408; item += gridDim.x) {
        __syncthreads();
#else
    for (;;) {
        unsigned qa = LDS_X + 64; asm volatile("" : "+s"(qa));
        volatile LAS unsigned* qslot = (volatile LAS unsigned*)(LAS char*)(uintptr_t)qa;
        __syncthreads();
        if (TIDX == 0) *qslot = __hip_atomic_fetch_add(qhead, 1u, __ATOMIC_RELAXED, __HIP_MEMORY_SCOPE_AGENT);
        __syncthreads();
        const int item = (int)__builtin_amdgcn_readfirstlane(*qslot);
        if (item >= 1408) break;
#endif
#ifndef Q_NO_SCAN
        if (item < 128) scan_pair(p, true, item, lds); else
#endif
#ifndef Q_NO_ATTN
        if (item < 640) { const int su = item - 128;
            const int b = su >> 7, h = (su >> 3) & 15, qb = su & 7; const size_t row0 = (size_t)NP + b * 2048 + qb * 256; const size_t k0 = ((size_t)b * 2304) * 512 + (h >> 2) * 128;
            attn_body<CfgGqa>(projB + row0 * N1B + 2048 + h * 128, (const bf16_t*)(ws + WS_KBS) + k0, (const bf16_t*)(ws + WS_VBS) + k0, nullptr,
                              mixed + row0 * DM + 2048 + h * 128, projB + row0 * N1B + 5120 + h * 128, 2304, lds, (const float*)(ws + WS_ROPEB_COS), (const float*)(ws + WS_ROPEB_SIN), qb * 256, p->in[I_QG]); }
        else
#endif
#ifndef Q_NO_SCAN
        if (item < 1152) scan_pair(p, false, item - 640, lds); else
#endif
#ifndef Q_NO_ATTN
        { const int pu = item - 1152;
            const int b = pu >> 4, h = pu & 15; const size_t row0 = (size_t)b * 256; const size_t k0 = row0 * 512 + (h >> 2) * 128;
            attn_body<CfgGqa>(projB + row0 * N1B + 2048 + h * 128, (const bf16_t*)(ws + WS_KBP) + k0, (const bf16_t*)(ws + WS_VBP) + k0, nullptr,
                              mixed + row0 * DM + 2048 + h * 128, projB + row0 * N1B + 5120 + h * 128, 256, lds, nullptr, nullptr, 0, p->in[I_QG]); }
#else
        {}
#endif
    }
}

__device__ __forceinline__ void phase_mix(KP p) {
    unsigned char* ws = p->ws;
    const int lane = TIDX & 63, wave = TIDX >> 6, gw = blockIdx.x * 8 + wave, nw = gridDim.x * 8;
    const bf16_t* Y0 = (const bf16_t*)(ws + WS_YA); const bf16_t* Y1 = (const bf16_t*)(ws + WS_YA + SZA);
    const bf16_t* Rb = (const bf16_t*)(ws + WS_R); const bf16_t* Vb = (const bf16_t*)(p->out + OUT_Y + (size_t)NT * AW);
    const bf16_t* A0 = (const bf16_t*)(ws + WS_WD + SZA); const bf16_t* A1 = (const bf16_t*)(ws + WS_WD + 3 * SZA); const bf16_t* Kb = (const bf16_t*)(ws + WS_K); const float* k_a = p->in[I_KA];
    const bf16_t* projB = (const bf16_t*)(ws + WS_PROJB); bf16_t* mixed = (bf16_t*)(ws + WS_MIXED);
    const float* lnw = p->in[I_LNW]; const float* lnb = p->in[I_LNB]; const float* rk = p->in[I_RK];
    for (int row = gw; row < NT; row += nw) {
#pragma unroll
      for (int hh = 0; hh < 2; ++hh) {
        u32x4 qy0[4], qy1[4], qr[4], qk[4], qa0[4], qa1[4], qv[4], qg[4];
#pragma unroll
        for (int it = 2 * hh; it < 2 * hh + 2; ++it) { const int col = (lane + 64 * it) * 8; const size_t o = (size_t)row * AW + col;
            qy0[it] = *(const u32x4*)(Y0 + o); qy1[it] = *(const u32x4*)(Y1 + o); qr[it] = *(const u32x4*)(Rb + o); qk[it] = *(const u32x4*)(Kb + o);
            qa0[it] = *(const u32x4*)(A0 + o); qa1[it] = *(const u32x4*)(A1 + o); qv[it] = *(const u32x4*)(Vb + o); qg[it] = *(const u32x4*)(projB + (size_t)row * N1B + col); }
#pragma unroll
        for (int it = 2 * hh; it < 2 * hh + 2; ++it) { const int col = (lane + 64 * it) * 8;
            float y[8], t1[8], t2[8];
            unpack8(qy0[it], y); unpack8(qy1[it], t1);
            float sm = 0.f;
#pragma unroll
            for (int e = 0; e < 8; ++e) { y[e] += t1[e]; sm += y[e]; }
            sm += __shfl_xor(sm, 1); sm += __shfl_xor(sm, 2); sm += __shfl_xor(sm, 4);
            const float mean = sm * (1.0f / 64.0f); float vs = 0.f;
#pragma unroll
            for (int e = 0; e < 8; ++e) { y[e] -= mean; vs += y[e] * y[e]; }
            vs += __shfl_xor(vs, 1); vs += __shfl_xor(vs, 2); vs += __shfl_xor(vs, 4);
            const float rs = rsqrtf(vs * (1.0f / 64.0f) + 64e-5f);
            float rr[8], kk8[8]; unpack8(qr[it], rr); unpack8(qk[it], kk8); unpack8(qa0[it], t1); unpack8(qa1[it], t2);
            const f32x4 ka0 = *(const f32x4*)(k_a + col), ka1 = *(const f32x4*)(k_a + col + 4), rk0 = *(const f32x4*)(rk + col), rk1 = *(const f32x4*)(rk + col + 4);
            float bs = 0.f;
#pragma unroll
            for (int e = 0; e < 8; ++e) { const float kav = e < 4 ? ka0[e & 3] : ka1[e & 3], rkv = e < 4 ? rk0[e & 3] : rk1[e & 3];
                bs += rr[e] * kk8[e] * ((t1[e] + t2[e] - 2.0f) * kav + 2.0f) * rkv; }
            bs += __shfl_xor(bs, 1); bs += __shfl_xor(bs, 2); bs += __shfl_xor(bs, 4);
            float vv8[8], gg[8], ov[8]; unpack8(qv[it], vv8); unpack8(qg[it], gg);
            const f32x4 lw0 = *(const f32x4*)(lnw + col), lw1 = *(const f32x4*)(lnw + col + 4), lb0 = *(const f32x4*)(lnb + col), lb1 = *(const f32x4*)(lnb + col + 4);
#pragma unroll
            for (int e = 0; e < 8; ++e) { const float lw = e < 4 ? lw0[e & 3] : lw1[e & 3], lb = e < 4 ? lb0[e & 3] : lb1[e & 3];
                ov[e] = (y[e] * rs * lw + lb + vv8[e] * bs) * silu_f(gg[e]); }
            *(u32x4*)(mixed + (size_t)row * DM + col) = pack8(ov);
        }
        asm volatile("" ::: "memory");
      }
    }
}

__device__ __forceinline__ void phase_prepC(KP p) {
    unsigned char* ws = p->ws;
    const int lane = TIDX & 63, wave = TIDX >> 6, gw = blockIdx.x * 8 + wave, nw = gridDim.x * 8;
    const bf16_t* projC = (const bf16_t*)(ws + WS_PROJC); bf16_t* qn = (bf16_t*)(ws + WS_QN); bf16_t* ckv = (bf16_t*)(ws + WS_CKV); bf16_t* kpe = (bf16_t*)(ws + WS_KPE);
    const float* cosC = (const float*)(ws + WS_ROPEC_COS); const float* sinC = (const float*)(ws + WS_ROPEC_SIN);
    const float* qag = p->in[I_QAG]; const float* kvag = p->in[I_KVAG];
    for (int row = gw; row < NT + 1024; row += nw) {
        if (row >= NT) {
            const int cr = row - NT, b = cr >> 8, t = cr & 255; const size_t krow = (size_t)NP + b * 2304 + t;
            { const float* s = p->in[I_CCKV] + (size_t)cr * 512 + lane * 8; const f32x4 a = *(const f32x4*)s, c = *(const f32x4*)(s + 4);
              *(u32x4*)(ckv + krow * 512 + lane * 8) = (u32x4){cvt_pk_bf16(a[0], a[1]), cvt_pk_bf16(a[2], a[3]), cvt_pk_bf16(c[0], c[1]), cvt_pk_bf16(c[2], c[3])}; }
            if (lane < 32) { const f32x2 a = *(const f32x2*)(p->in[I_CKPE] + (size_t)cr * 64 + lane * 2); *(unsigned*)(kpe + krow * 64 + lane * 2) = cvt_pk_bf16(a[0], a[1]); }
            continue;
        }
        const bool samp = row >= NP; int b = 0, t = 0; if (samp) { const int rr = row - NP; b = rr >> 11; t = rr & 2047; }
        const size_t krow = samp ? (size_t)NP + b * 2304 + 256 + t : (size_t)row;
        const u32x2* pc = (const u32x2*)(projC + (size_t)row * N3C);
        {
            f32x4 v[6]; float ss = 0.f;
#pragma unroll
            for (int i = 0; i < 6; ++i) { v[i] = up4(pc[lane + 64 * i]); ss += (v[i][0] * v[i][0] + v[i][1] * v[i][1]) + (v[i][2] * v[i][2] + v[i][3] * v[i][3]); }
            ss = wave_sum(ss); const float inv = rsqrtf(ss * (1.0f / 1536.0f) + 1e-6f);
#pragma unroll
            for (int i = 0; i < 6; ++i) { const int c4 = lane + 64 * i; const f32x4 o = v[i] * inv * ((const f32x4*)qag)[c4];
                u32x2 w; w.x = cvt_pk_bf16(o[0], o[1]); w.y = cvt_pk_bf16(o[2], o[3]); *(u32x2*)(qn + (size_t)row * 1536 + c4 * 4) = w; }
        }
        {
            f32x4 v[2]; float ss = 0.f;
#pragma unroll
            for (int i = 0; i < 2; ++i) { v[i] = up4(pc[384 + lane + 64 * i]); ss += (v[i][0] * v[i][0] + v[i][1] * v[i][1]) + (v[i][2] * v[i][2] + v[i][3] * v[i][3]); }
            ss = wave_sum(ss); const float inv = rsqrtf(ss * (1.0f / 512.0f) + 1e-6f);
#pragma unroll
            for (int i = 0; i < 2; ++i) { const int c4 = lane + 64 * i; const f32x4 o = v[i] * inv * ((const f32x4*)kvag)[c4];
                u32x2 w; w.x = cvt_pk_bf16(o[0], o[1]); w.y = cvt_pk_bf16(o[2], o[3]); *(u32x2*)(ckv + krow * 512 + c4 * 4) = w;
                if (!samp) *(f32x4*)(p->out + OUT_CKV + (size_t)row * 512 + c4 * 4) = o; }
        }
        if (lane < 32) {
            const unsigned xw = *(const unsigned*)(projC + (size_t)row * N3C + 2048 + lane * 2); const f32x2 x = (f32x2){bf_lo(xw), bf_hi(xw)}; f32x2 o = x;
            if (samp) { const float c = cosC[t * 32 + lane], s = sinC[t * 32 + lane]; o[0] = x[0] * c - x[1] * s; o[1] = x[0] * s + x[1] * c; }
            else *(f32x2*)(p->out + OUT_KPE + (size_t)row * 64 + lane * 2) = x;
            *(unsigned*)(kpe + krow * 64 + lane * 2) = cvt_pk_bf16(o[0], o[1]);
        }
    }
}

__device__ __forceinline__ void phase_mla_attn(KP p, char* lds) {
    unsigned char* ws = p->ws; const int G = gridDim.x, bid = blockIdx.x;
    const bf16_t* q = (const bf16_t*)(ws + WS_Q); const bf16_t* kv = (const bf16_t*)(ws + WS_KV); const bf16_t* kpe = (const bf16_t*)(ws + WS_KPE);
    bf16_t* og = (bf16_t*)(ws + WS_OG); const bf16_t* gate = (const bf16_t*)(ws + WS_GATEB);
    const int vcu = (G % 8 == 0) ? (bid % 8) * (G / 8) + bid / 8 : bid;
    const int nS = vcu < 2048 ? (2048 - vcu + G - 1) / G : 0, nP = vcu < 1024 ? (1024 - vcu + G - 1) / G : 0;
    AttnPre pre; bool have = false;
    for (int i = 0; i < nS + nP; ++i) {
        const bf16_t *Qb, *Kb, *Vb, *Pb, *Gb; bf16_t* Ob; int seq, t0; const float *rc, *rs;
        AttnNext nx; nx.valid = (i + 1 < nS + nP);
        {   const int j = i;
            if (j < nS) { const int su = vcu + j * G; const int b = su >> 9, h = (su >> 3) & 63, qb = su & 7; const size_t row0 = (size_t)NP + b * 2048 + qb * 256, kr0 = (size_t)NP + b * 2304;
                Qb = q + row0 * 12288 + h * 192; Kb = kv + kr0 * 16384 + h * 256; Vb = Kb + 128; Pb = kpe + kr0 * 64; Ob = og + row0 * 8192 + h * 128; Gb = gate + row0 * 8192 + h * 128;
                seq = 2304; t0 = qb * 256; rc = (const float*)(ws + WS_ROPEC_COS); rs = (const float*)(ws + WS_ROPEC_SIN); }
            else { const int pu = vcu + (j - nS) * G; const int b = pu >> 6, h = pu & 63; const size_t row0 = (size_t)b * 256;
                Qb = q + row0 * 12288 + h * 192; Kb = kv + row0 * 16384 + h * 256; Vb = Kb + 128; Pb = kpe + row0 * 64; Ob = og + row0 * 8192 + h * 128; Gb = gate + row0 * 8192 + h * 128;
                seq = 256; t0 = 0; rc = nullptr; rs = nullptr; } }
        {   const int j = nx.valid ? i + 1 : i;
            if (j < nS) { const int su = vcu + j * G; const int b = su >> 9, h = (su >> 3) & 63, qb = su & 7; const size_t row0 = (size_t)NP + b * 2048 + qb * 256, kr0 = (size_t)NP + b * 2304;
                nx.Q = q + row0 * 12288 + h * 192; nx.K = kv + kr0 * 16384 + h * 256; nx.V = nx.K + 128; nx.P = kpe + kr0 * 64; }
            else { const int pu = vcu + (j - nS) * G; const int b = pu >> 6, h = pu & 63; const size_t row0 = (size_t)b * 256;
                nx.Q = q + row0 * 12288 + h * 192; nx.K = kv + row0 * 16384 + h * 256; nx.V = nx.K + 128; nx.P = kpe + row0 * 64; } }
        attn_body<CfgMla, true>(Qb, Kb, Vb, Pb, Ob, Gb, seq, lds, rc, rs, t0, nullptr, &pre, have, nx);
        have = nx.valid;
    }
}

__device__ __forceinline__ void phase_final(KP p) {
    const int lane = TIDX & 63, wave = TIDX >> 6, gw = blockIdx.x * 8 + wave, nw = gridDim.x * 8;
    const float* g = p->in[I_FINALG]; const bf16_t* x2 = (const bf16_t*)(p->ws + WS_Q);
    for (int row = gw; row < NT; row += nw) {
        const u32x2* x = (const u32x2*)(x2 + (size_t)row * DM); float* y = p->out + OUT_Y + (size_t)row * DM;
        f32x4 v[16]; float ss = 0.f;
#pragma unroll
        for (int i = 0; i < 16; ++i) { v[i] = up4(x[lane + 64 * i]); ss += v[i][0] * v[i][0] + v[i][1] * v[i][1] + v[i][2] * v[i][2] + v[i][3] * v[i][3]; }
        ss = wave_sum(ss);
        const float inv = rsqrtf(ss * (1.0f / 4096.0f) + 1e-6f);
#pragma unroll
        for (int i = 0; i < 16; ++i) { const int c4 = lane + 64 * i; ((f32x4*)y)[c4] = v[i] * inv * ((const f32x4*)g)[c4]; }
    }
}

__global__ void __launch_bounds__(512, 2) fwd(Params pv) {
    extern __shared__ __attribute__((aligned(16))) unsigned char lds[];
    LAS unsigned char* ldsl = (LAS unsigned char*)lds;
    volatile LAS unsigned* xbw = (volatile LAS unsigned*)(ldsl + LDS_X);
    if (threadIdx.x < 4) xbw[threadIdx.x] = 0u;
    if ((threadIdx.x & 63) == 0) *(volatile LAS unsigned*)(LAS char*)(uintptr_t)(TID_TAB_OFF + 4u * hw_wave_slot()) = threadIdx.x >> 6;
    __syncthreads();
    XcdBarrier bar; bar.bar = (unsigned*)(pv.ws + WS_CTL); bar.x = 0; bar.st = xbw;
    if (!MK_PER_PHASE) bar = xcd_barrier_post((unsigned*)(pv.ws + WS_CTL), xbw);
    const int lo = pv.ph_lo, hi = pv.ph_hi;
#ifndef PH_MASK
#define PH_MASK 0x7fff
#endif
#define IN(k) (((PH_MASK >> (k)) & 1) && lo <= (k) && (k) < hi)
#define SEAM(k) do { if (!MK_PER_PHASE && IN(k) && IN((k) + 1)) xcd_barrier(bar); } while (0)
#define PH_BEGIN KP p = get_params(); unsigned char* ws = p->ws; const int G = gridDim.x, bid = blockIdx.x; (void)ws; (void)G; (void)bid;

    if (IN(0)) { PH_BEGIN phase0(p, lds); } SEAM(0);
    if (IN(1)) { PH_BEGIN phase_h(p, 0, p->in[I_XP], p->in[I_XS], (bf16_t*)(ws + WS_H0)); } SEAM(1);
    if (IN(2)) { PH_BEGIN pg8::Gemm g{(const bf16_t*)(ws + WS_H0), (const bf16_t*)(ws + WS_WTA), NT, N1, DM}; pg8::StaticOrder S; S.init(NT, N1, G, bid);
        EpiG1 E{(bf16_t*)(ws + WS_PROJF), (bf16_t*)(ws + WS_PROJB)}; pg8::gemm_phase(ldsl, g, S, E);
        { const int extra = ((NT / 256) * (N1 / 256)) % G; if (bid >= extra) { phase_cvt1(p, lds, 0, G - extra, bid - extra); phase_cvt1(p, lds, 1, G - extra, bid - extra); } } } SEAM(2);
    if (IN(3)) { PH_BEGIN phase_prepA(p); } SEAM(3);
    if (IN(4)) { PH_BEGIN
#pragma unroll
        for (int d = 0; d < 2; ++d) {
            pg8::Gemm g{(const bf16_t*)(ws + WS_LORA) + (size_t)d * NT * 256, (const bf16_t*)(ws + WS_WTLORA) + (size_t)d * 4096 * 256, NT, 4096, 256}; pg8::StaticOrder S; S.init(NT, 4096, G, bid);
            EpiLora E{p->in[I_W0] + d * 2048, p->in[I_A0] + d * 2048, (bf16_t*)(ws + WS_WD + (size_t)d * 2 * SZA), (bf16_t*)(ws + WS_WD + (size_t)d * 2 * SZA + SZA)}; pg8::gemm_phase(ldsl, g, S, E);
        } } SEAM(4);
    if (IN(5)) { PH_BEGIN phase_scan_attn(p, (char*)lds); } SEAM(5);
    if (IN(6)) { PH_BEGIN phase_mix(p); } SEAM(6);
    if (IN(7)) { PH_BEGIN pg8::Gemm g{(const bf16_t*)(ws + WS_MIXED), (const bf16_t*)(ws + WS_WTOUT), NT, DM, DM}; pg8::StaticOrder S; S.init(NT, DM, G, bid);
        EpiRes<false> E{p->in[I_XP], p->in[I_XS], nullptr, (bf16_t*)(p->out + OUT_Y), (const float*)(ws + WS_MOD) + 8192}; pg8::gemm_phase(ldsl, g, S, E);
        } SEAM(7);
    if (IN(8)) { PH_BEGIN phase_h_bf(p, 1, (const bf16_t*)(p->out + OUT_Y), (bf16_t*)(ws + WS_H1)); } SEAM(8);
    if (IN(9)) { PH_BEGIN pg8::Gemm g{(const bf16_t*)(ws + WS_H1), (const bf16_t*)(ws + WS_WTC), NT, N3, DM}; pg8::StaticOrder S; S.init(NT, N3, G, bid);
        EpiG3 E{(bf16_t*)(ws + WS_GATEB), (bf16_t*)(ws + WS_PROJC)}; pg8::gemm_phase(ldsl, g, S, E);
        { const int extra = ((NT / 256) * (N3 / 256)) % G; if (extra != 0 && bid >= extra) phase_cvt1(p, lds, 2, G - extra, bid - extra); else if (extra == 0) phase_cvt1(p, lds, 2, G, bid); } } SEAM(9);
    if (IN(10)) { PH_BEGIN phase_prepC(p); } SEAM(10);
    if (IN(11)) { PH_BEGIN
        { pg8::Gemm g{(const bf16_t*)(ws + WS_QN), (const bf16_t*)(ws + WS_WTUQ), NT, 12288, 1536}; pg8::StaticOrder S; S.init(NT, 12288, G, bid);
          EpiBf16Plain E{(bf16_t*)(ws + WS_Q), 12288}; pg8::gemm_phase(ldsl, g, S, E); }
        { pg8::Gemm g{(const bf16_t*)(ws + WS_CKV), (const bf16_t*)(ws + WS_WTUKV), NKV, 16384, 512}; pg8::StaticOrder S; S.init(NKV, 16384, G, bid);
          EpiBf16Plain E{(bf16_t*)(ws + WS_KV), 16384}; pg8::gemm_phase(ldsl, g, S, E); }
    } SEAM(11);
    if (IN(12)) { PH_BEGIN phase_mla_attn(p, (char*)lds); } SEAM(12);
    if (IN(13)) { PH_BEGIN pg8::Gemm g{(const bf16_t*)(ws + WS_OG), (const bf16_t*)(ws + WS_WTCOUT), NT, DM, 8192}; pg8::StaticOrder S; S.init(NT, DM, G, bid);
        EpiRes<true> E{nullptr, nullptr, (const bf16_t*)(p->out + OUT_Y), (bf16_t*)(ws + WS_Q), (const float*)(ws + WS_MOD) + 5 * 12288 + 8192}; pg8::gemm_phase(ldsl, g, S, E); } SEAM(13);
    if (IN(14)) { PH_BEGIN phase_final(p); }
#undef IN
#undef SEAM
#undef PH_BEGIN
}

extern "C" void kernel_launch(void* const* d_in, const int* in_sizes, int n_in, void* d_out, int out_size, void* d_ws, size_t ws_size, hipStream_t stream) {
    static int grid = 0;
    if (grid == 0) {
        if (n_in != 33 || out_size != (int)OUT_TOTAL || ws_size < WS_NEED) { grid = -1; return; }
        int dev = 0, cus = 0;
        if (hipGetDevice(&dev) != hipSuccess || hipDeviceGetAttribute(&cus, hipDeviceAttributeMultiprocessorCount, dev) != hipSuccess) { grid = -1; return; }
        if (hipFuncSetAttribute((const void*)fwd, hipFuncAttributeMaxDynamicSharedMemorySize, LDS_BYTES) != hipSuccess) { grid = -1; return; }
        int per_cu = 0;
        if (hipOccupancyMaxActiveBlocksPerMultiprocessor(&per_cu, (const void*)fwd, 512, LDS_BYTES) != hipSuccess || per_cu < 1) { (void)hipGetLastError(); }
        grid = cus;
    }
    if (grid < 0) return;
    (void)hipMemsetAsync((char*)d_ws + WS_CTL, 0, 65536, stream);
    Params p{};
    for (int i = 0; i < 33; ++i) p.in[i] = (const float*)d_in[i];
    p.out = (float*)d_out; p.ws = (unsigned char*)d_ws;
#if MK_PER_PHASE
#ifndef PROBE_REP
#define PROBE_REP 0
#endif
    for (int k = 0; k < NPH; ++k) { p.ph_lo = k; p.ph_hi = k + 1; const int nrep = ((PROBE_REP >> k) & 1) ? 2 : 1;
        for (int r = 0; r < nrep; ++r) hipLaunchKernelGGL(fwd, dim3(grid), dim3(512), LDS_BYTES, stream, p); }
#else
    p.ph_lo = 0; p.ph_hi = NPH; hipLaunchKernelGGL(fwd, dim3(grid), dim3(512), LDS_BYTES, stream, p);
#endif
}
#ifdef TEST_ATTN
__global__ void __launch_bounds__(512, 2) t_attn(const bf16_t* Q, const bf16_t* K, const bf16_t* V, const bf16_t* P, bf16_t* O, const bf16_t* Gt, int seq) {
    extern __shared__ __attribute__((aligned(16))) unsigned char lds2[];
    attn_body<TEST_ATTN>(Q + (size_t)blockIdx.x * 256 * TEST_ATTN::LDQ, K, V, P, O + (size_t)blockIdx.x * 256 * TEST_ATTN::LDO, Gt + (size_t)blockIdx.x * 256 * TEST_ATTN::LDG, seq, (char*)lds2);
}
#endif
```

```cpp
#include <hip/hip_runtime.h>
#include <stdint.h>

#ifndef MK_PER_PHASE
#define MK_PER_PHASE 0
#endif

#define LAS __attribute__((address_space(3)))

#define TID_TAB_OFF (8 * 18688 + 128)
__device__ __forceinline__ int lane_id() { unsigned x; asm volatile("v_mbcnt_lo_u32_b32 %0, -1, 0\n\tv_mbcnt_hi_u32_b32 %0, -1, %0" : "=v"(x)); return (int)x; }
__device__ __forceinline__ unsigned hw_wave_slot() { return (unsigned)__builtin_amdgcn_s_getreg((5 << 11) | 4) & 63u; }
__device__ __forceinline__ int get_tid() {
    const unsigned w = *(const volatile LAS unsigned*)(LAS char*)(uintptr_t)(TID_TAB_OFF + 4u * hw_wave_slot());
    return (int)__builtin_amdgcn_readfirstlane(w) * 64 + lane_id();
}
#define TIDX get_tid()
typedef unsigned short bf16_t;
typedef short bf16x8 __attribute__((ext_vector_type(8)));
typedef short s16x4 __attribute__((ext_vector_type(4)));
typedef float f32x4 __attribute__((ext_vector_type(4)));
typedef float f32x2 __attribute__((ext_vector_type(2)));
typedef float f32x16 __attribute__((ext_vector_type(16)));
typedef unsigned u32x4 __attribute__((ext_vector_type(4)));
typedef unsigned u32x2 __attribute__((ext_vector_type(2)));

#define XB_TMO      128
#define XB_XCNT(j)  (256  + 64 * (j))
#define XB_XSUB(j)  (1280 + 64 * (j))
#define XB_XGEN(j)  (2304 + 64 * (j))
#define XB_TOP      3328
#define XB_TOPGEN   3392
#define XCD_BAR_WORDS 3456
#define XB_SPIN_CAP (1u << 22)

__device__ __forceinline__ unsigned xb_ld(unsigned* p)              { return __hip_atomic_load(p, __ATOMIC_RELAXED, __HIP_MEMORY_SCOPE_AGENT); }
__device__ __forceinline__ unsigned xb_add(unsigned* p, unsigned v) { return __hip_atomic_fetch_add(p, v, __ATOMIC_RELAXED, __HIP_MEMORY_SCOPE_AGENT); }
__device__ __forceinline__ unsigned xb_xcc_id() { return (unsigned)__builtin_amdgcn_s_getreg((3 << 11) | 20) & 0xFu; }
#define XB_SPIN(cond, bar) do { unsigned _sp = 0; while (cond) { __builtin_amdgcn_s_sleep(1); \
    if ((++_sp & 255u) == 0u) { if (xb_ld(&(bar)[XB_TMO])) break; if (_sp > XB_SPIN_CAP) { atomicAdd(&(bar)[XB_TMO], 1u); break; } } } } while (0)

struct XcdBarrier { unsigned* bar; unsigned x; volatile LAS unsigned* st; };

__device__ __forceinline__ XcdBarrier xcd_barrier_post(unsigned* bar, volatile LAS unsigned* st) {
    XcdBarrier b; b.bar = bar; b.x = xb_xcc_id(); b.st = st;
    if (TIDX == 0) (void)xb_add(&bar[XB_XCNT(b.x)], 1u);
    return b;
}
__device__ __forceinline__ void xcd_barrier_complete(unsigned* bar, unsigned x, unsigned& nloc, unsigned& nx) {
    const unsigned G = gridDim.x * gridDim.y * gridDim.z;
    unsigned sum, cnt, mine, sp = 0u;
    for (;;) {
        sum = 0u; cnt = 0u; mine = 0u;
#pragma unroll
        for (unsigned j = 0; j < 16; ++j) { const unsigned c = xb_ld(&bar[XB_XCNT(j)]); sum += c; cnt += (c > 0u) ? 1u : 0u; mine = (j == x) ? c : mine; }
        if (sum == G) break;
        __builtin_amdgcn_s_sleep(1);
        if ((++sp & 255u) == 0u) { if (xb_ld(&bar[XB_TMO])) break; if (sp > XB_SPIN_CAP) { atomicAdd(&bar[XB_TMO], 1u); break; } }
    }
    nloc = mine > 0u ? mine : 1u; nx = cnt > 0u ? cnt : 1u;
}
__device__ __forceinline__ void xcd_barrier(const XcdBarrier& b) {
    asm volatile("s_waitcnt vmcnt(0)" ::: "memory");
    __syncthreads();
    if (TIDX == 0) {
        unsigned* bar = b.bar;
        __builtin_amdgcn_s_waitcnt(0);
        unsigned nloc = b.st[0], nx = b.st[1];
        if (nloc == 0u) { xcd_barrier_complete(bar, b.x, nloc, nx); b.st[0] = nloc; b.st[1] = nx; }
        const unsigned old = xb_add(&bar[XB_XSUB(b.x)], 1u);
        const unsigned gen = old / nloc;
        if (old + 1u == (gen + 1u) * nloc) {
            __builtin_amdgcn_fence(__ATOMIC_RELEASE, "agent");
            asm volatile("s_waitcnt vmcnt(0)" ::: "memory");
            const unsigned og = xb_add(&bar[XB_TOP], 1u);
            const unsigned tg = og / nx;
            if (og + 1u == (tg + 1u) * nx) xb_add(&bar[XB_TOPGEN], 1u);
            else XB_SPIN(xb_ld(&bar[XB_TOPGEN]) == tg, bar);
            __builtin_amdgcn_fence(__ATOMIC_ACQUIRE, "agent");
            xb_add(&bar[XB_XGEN(b.x)], 1u);
            asm volatile("s_waitcnt vmcnt(0)" ::: "memory");
        } else {
            XB_SPIN(xb_ld(&bar[XB_XGEN(b.x)]) == gen, bar);
            __builtin_amdgcn_fence(__ATOMIC_ACQUIRE, "agent");
            asm volatile("s_waitcnt vmcnt(0)" ::: "memory");
        }
    }
    __syncthreads();
}

typedef __bf16 bf16v2 __attribute__((ext_vector_type(2)));
__device__ __forceinline__ unsigned cvt_pk_bf16(float lo, float hi) { f32x2 v = {lo, hi}; bf16v2 b = __builtin_convertvector(v, bf16v2); return __builtin_bit_cast(unsigned, b); }
__device__ __forceinline__ float bf_lo(unsigned w) { return __uint_as_float(w << 16); }
__device__ __forceinline__ float bf_hi(unsigned w) { return __uint_as_float(w & 0xffff0000u); }
__device__ __forceinline__ float bf2f(bf16_t b) { return __uint_as_float(((unsigned)b) << 16); }
__device__ __forceinline__ float ldh(const bf16_t* base, unsigned boff) { return bf2f(*(const bf16_t*)((const char*)base + boff)); }
__device__ __forceinline__ u32x2 pk4(const f32x4 v) { return (u32x2){cvt_pk_bf16(v[0], v[1]), cvt_pk_bf16(v[2], v[3])}; }
__device__ __forceinline__ f32x4 up4(const u32x2 w) { return (f32x4){bf_lo(w.x), bf_hi(w.x), bf_lo(w.y), bf_hi(w.y)}; }
__device__ __forceinline__ float sigmoid_f(float x) { return __builtin_amdgcn_rcpf(1.0f + __expf(-x)); }
__device__ __forceinline__ float silu_f(float x) { return x * __builtin_amdgcn_rcpf(1.0f + __expf(-x)); }
__device__ __forceinline__ float wave_sum(float v) {
#pragma unroll
    for (int o = 32; o >= 1; o >>= 1) v += __shfl_xor(v, o);
    return v;
}
__device__ __forceinline__ float sum16(float v) {
#pragma unroll
    for (int o = 8; o >= 1; o >>= 1) v += __shfl_xor(v, o);
    return v;
}

namespace pg8 {
constexpr int BM = 256, BK = 64, HALF = 128, HTB = HALF * BK * 2, STAGE_BYTES = 8 * HTB, NXCD = 8, WGM = 8;
__host__ __device__ __forceinline__ int lds_byte(int r, int c) { const int st = (r >> 4) * 2 + (c >> 5), rr = r & 15, cc = c & 31, ob = rr * 64 + cc * 2; return st * 1024 + (ob ^ (((ob >> 9) & 1) << 5)); }
__host__ __device__ __forceinline__ void stage_rc(int b, int& R, int& C) { const int st = b / 1024, sb = b % 1024, swz = sb ^ (((sb >> 9) & 1) << 5); R = (st >> 1) * 16 + swz / 64; C = (st & 1) * 32 + (swz % 64) / 2; }
__host__ __device__ __forceinline__ int perm32(int rho) { const int n = rho >> 4, i = rho & 15; return 8 * (i >> 2) + 4 * n + (i & 3); }
struct Unit { int pm, pn; };
struct Gemm { const bf16_t* A; const bf16_t* Bt; int M, N, K; };
struct StaticOrder {
    int nM, nN, nwg, G, c;
    __host__ __device__ void init(int M, int N, int G_, int c_) { nM = M / BM; nN = N / BM; nwg = nM * nN; G = G_; c = c_; }
    __host__ __device__ bool next(int i, Unit& u) const {
        const long L = (long)i * G + c; if (L >= nwg) return false;
        int wgid = (int)L; { const int q = nwg / NXCD, r = nwg % NXCD, xcd = wgid % NXCD, off = wgid / NXCD; wgid = (xcd < r ? xcd * (q + 1) : r * (q + 1) + (xcd - r) * q) + off; }
        const int nig = WGM * nN, gid = wgid / nig, fm = gid * WGM, gsz = (nM - fm) < WGM ? (nM - fm) : WGM;
        u.pm = fm + ((wgid % nig) % gsz); u.pn = (wgid % nig) / gsz; return true;
    }
    __device__ __forceinline__ void a_ready(const Unit&) const {}
    __device__ __forceinline__ void done(const Unit&) const {}
};
template <class Epi, class Sched>
__device__ __forceinline__ void gemm_phase(LAS unsigned char* lds, const Gemm g, const Sched& S, const Epi& E) {
    const int tid = TIDX, wid = __builtin_amdgcn_readfirstlane(tid >> 6), lane = tid & 63, wr = wid >> 2, wc = wid & 3, fr = lane & 15, fq = lane >> 4;
    const int K = g.K, nt = K / BK;
    unsigned voffA[2], voffB[2];
#pragma unroll
    for (int i = 0; i < 2; ++i) { int R, C; stage_rc(tid * 16 + i * 8192, R, C); const int Rb = (R & ~31) + perm32(R & 31);
        voffA[i] = (unsigned)(R * K + C) * 2u; voffB[i] = (unsigned)(Rb * K + C) * 2u; }
    const size_t kstep = (size_t)(BK * 2);
    const size_t hstep = (size_t)HALF * K * 2;
    const size_t tstep = 2 * hstep;
    const unsigned ldsw = (unsigned)wid * 1024u;
    const int aoff = lds_byte(wr * 64 + fr, fq * 8), boff = lds_byte(wc * 32 + fr, fq * 8);
#define PG8_SA(b, h) (((b) * 2 + (h)) * HTB)
#define PG8_SB(b, h) ((4 + (b) * 2 + (h)) * HTB)
#define PG8_STAGE(bufoff, gbase, voff) do { _Pragma("unroll") for (int _i = 0; _i < 2; ++_i) \
        __builtin_amdgcn_global_load_lds((const unsigned*)((const char*)(gbase) + (voff)[_i]), (LAS unsigned*)(lds + (bufoff) + ldsw + _i * 8192), 16, 0, 0); } while (0)
#define PG8_LDA(dst, b, h) do { _Pragma("unroll") for (int m = 0; m < 4; ++m) _Pragma("unroll") for (int k = 0; k < 2; ++k) dst[m][k] = *(const LAS bf16x8*)(lds + PG8_SA(b, h) + aoff + m * 2048 + k * 1024); } while (0)
#define PG8_LDB(dst, b, h) do { _Pragma("unroll") for (int n = 0; n < 2; ++n) _Pragma("unroll") for (int k = 0; k < 2; ++k) dst[n][k] = *(const LAS bf16x8*)(lds + PG8_SB(b, h) + boff + n * 2048 + k * 1024); } while (0)
#define PG8_MMA(ai, bj, At, Bt) do { __builtin_amdgcn_s_setprio(1); _Pragma("unroll") for (int m = 0; m < 4; ++m) _Pragma("unroll") for (int n = 0; n < 2; ++n) _Pragma("unroll") for (int k = 0; k < 2; ++k) \
        acc[ai][bj][m][n] = __builtin_amdgcn_mfma_f32_16x16x32_bf16(Bt[n][k], At[m][k], acc[ai][bj][m][n], 0, 0, 0); __builtin_amdgcn_s_setprio(0); } while (0)
#define PG8_WAIT_V(n) asm volatile("s_waitcnt vmcnt(" #n ")" ::: "memory")
#define PG8_WAIT_L(n) asm volatile("s_waitcnt lgkmcnt(" #n ")" ::: "memory")
#define PG8_BAR __builtin_amdgcn_s_barrier()
#define PG8_SCHED __builtin_amdgcn_sched_barrier(0)
    Unit cur, nxt; int ui = 0;
    if (!S.next(0, cur)) return;
    f32x4 acc[2][2][4][2];
#pragma unroll
    for (int a = 0; a < 2; ++a)
#pragma unroll
        for (int b = 0; b < 2; ++b)
#pragma unroll
            for (int m = 0; m < 4; ++m)
#pragma unroll
                for (int n = 0; n < 2; ++n) acc[a][b][m][n] = (f32x4){0.f, 0.f, 0.f, 0.f};
    bf16x8 At[4][2], B0[2][2], B1[2][2];
    const char* cA = (const char*)g.A + (size_t)cur.pm * tstep; const char* cB = (const char*)g.Bt + (size_t)cur.pn * tstep;
    S.a_ready(cur);
    PG8_STAGE(PG8_SB(0, 0), cB, voffB); PG8_STAGE(PG8_SA(0, 0), cA, voffA); PG8_STAGE(PG8_SB(0, 1), cB + hstep, voffB); PG8_STAGE(PG8_SA(0, 1), cA + hstep, voffA);
    if (wr == 1) PG8_BAR;
    PG8_WAIT_V(4); PG8_BAR;
    PG8_STAGE(PG8_SB(1, 0), cB + kstep, voffB); PG8_STAGE(PG8_SA(1, 0), cA + kstep, voffA); PG8_STAGE(PG8_SB(1, 1), cB + hstep + kstep, voffB);
    PG8_WAIT_V(6); PG8_BAR;
    for (;;) {
        const bool has_next = S.next(ui + 1, nxt);
        const char* nA = has_next ? (const char*)g.A + (size_t)nxt.pm * tstep : cA; const char* nB = has_next ? (const char*)g.Bt + (size_t)nxt.pn * tstep : cB;
        for (int t = 0; t < nt; t += 2) {
            const bool last = (t == nt - 2);
            const char* a1 = cA + (size_t)(t + 1) * kstep;
            const char* a2 = last ? nA : cA + (size_t)(t + 2) * kstep; const char* b2 = last ? nB : cB + (size_t)(t + 2) * kstep;
            const char* a3 = a2 + kstep; const char* b3 = b2 + kstep;
            if (last && has_next) S.a_ready(nxt);
            PG8_LDB(B0, 0, 0); PG8_SCHED; PG8_LDA(At, 0, 0); PG8_STAGE(PG8_SA(1, 1), a1 + hstep, voffA);
            PG8_WAIT_L(8); PG8_BAR; PG8_WAIT_L(0); PG8_MMA(0, 0, At, B0); PG8_BAR; PG8_SCHED;
            PG8_LDB(B1, 0, 1); PG8_STAGE(PG8_SB(0, 0), b2, voffB);
            PG8_BAR; PG8_WAIT_L(0); PG8_MMA(0, 1, At, B1); PG8_BAR;
            PG8_LDA(At, 0, 1); PG8_STAGE(PG8_SA(0, 0), a2, voffA);
            PG8_BAR; PG8_WAIT_L(0); PG8_MMA(1, 0, At, B0); PG8_BAR; PG8_SCHED;
            PG8_STAGE(PG8_SB(0, 1), b2 + hstep, voffB);
            PG8_WAIT_V(6); PG8_BAR; PG8_MMA(1, 1, At, B1); PG8_BAR;
            PG8_LDB(B0, 1, 0); PG8_SCHED; PG8_LDA(At, 1, 0); PG8_STAGE(PG8_SA(0, 1), a2 + hstep, voffA);
            PG8_WAIT_L(8); PG8_BAR; PG8_WAIT_L(0); PG8_MMA(0, 0, At, B0); PG8_BAR; PG8_SCHED;
            PG8_LDB(B1, 1, 1); PG8_STAGE(PG8_SB(1, 0), b3, voffB);
            PG8_BAR; PG8_WAIT_L(0); PG8_MMA(0, 1, At, B1); PG8_BAR;
            PG8_LDA(At, 1, 1); PG8_STAGE(PG8_SA(1, 0), a3, voffA);
            PG8_BAR; PG8_WAIT_L(0); PG8_MMA(1, 0, At, B0); PG8_BAR; PG8_SCHED;
            PG8_STAGE(PG8_SB(1, 1), b3 + hstep, voffB);
            PG8_WAIT_V(6); PG8_BAR; PG8_MMA(1, 1, At, B1); PG8_BAR;
        }
        E(acc, cur, wr, wc, fr, fq); S.done(cur);
        if (!has_next) break;
#pragma unroll
        for (int a = 0; a < 2; ++a)
#pragma unroll
            for (int b = 0; b < 2; ++b)
#pragma unroll
                for (int m = 0; m < 4; ++m)
#pragma unroll
                    for (int n = 0; n < 2; ++n) acc[a][b][m][n] = (f32x4){0.f, 0.f, 0.f, 0.f};
        cur = nxt; cA = nA; cB = nB; ++ui;
    }
    PG8_WAIT_V(0);
    if (wr == 0) PG8_BAR;
    PG8_BAR;
#undef PG8_SA
#undef PG8_SB
#undef PG8_STAGE
#undef PG8_LDA
#undef PG8_LDB
#undef PG8_MMA
#undef PG8_WAIT_V
#undef PG8_WAIT_L
#undef PG8_BAR
#undef PG8_SCHED
}
}

constexpr int DM = 4096, NP = 4096, NS = 8192, NT = 12288, AW = 2048;
constexpr int N1 = 13824, N1F = 6656, N1B = 7168;
constexpr int N3 = 10496, N3G = 8192, N3C = 2304;
constexpr int NKV = 13312;
constexpr size_t SZA = (size_t)NT * AW * 4;

constexpr size_t WS_CTL = 0;
constexpr size_t WS_MOD = 65536;
constexpr size_t WS_ROPEB_COS = 589824, WS_ROPEB_SIN = WS_ROPEB_COS + 524288;
constexpr size_t WS_ROPEC_COS = WS_ROPEB_SIN + 524288, WS_ROPEC_SIN = WS_ROPEC_COS + 262144;
constexpr size_t WS_R0 = 2228224;
constexpr size_t WS_PROJF = WS_R0;
constexpr size_t WS_YA = WS_R0;
constexpr size_t WS_MIXED = WS_R0 + 2 * SZA;
constexpr size_t WS_R1 = WS_R0 + (size_t)NT * N1F * 4;
constexpr size_t WS_PROJB = WS_R1;
constexpr size_t WS_R2 = WS_R1 + (size_t)NT * N1B * 2;
constexpr size_t WS_WTA = WS_R2;
constexpr size_t WS_H0 = WS_R2 + (size_t)N1 * DM * 2;
constexpr size_t WS_R = WS_R2;
constexpr size_t WS_K = WS_R2 + SZA;
constexpr size_t WS_R4 = WS_R2 + (size_t)N1 * DM * 2 + (size_t)NT * DM * 2;
constexpr size_t WS_WD = WS_R4;
constexpr size_t WS_R5 = WS_R4 + 4 * SZA;
constexpr size_t WS_LORA = WS_R5;
constexpr size_t WS_KBP = WS_LORA + (size_t)NT * 512 * 2;
constexpr size_t WS_VBP = WS_KBP + (size_t)NP * 512 * 2;
constexpr size_t WS_KBS = WS_VBP + (size_t)NP * 512 * 2;
constexpr size_t WS_VBS = WS_KBS + (size_t)9216 * 512 * 2;
constexpr size_t WS_R6 = WS_VBS + (size_t)9216 * 512 * 2;
constexpr size_t WS_WTOUT = WS_R6;
constexpr size_t WS_WTLORA = WS_WTOUT + (size_t)DM * DM * 2;
constexpr size_t WS_END0 = WS_WTLORA + (size_t)2 * 4096 * 256 * 2;
constexpr size_t WS_Q = WS_R0;
constexpr size_t WS_CKV = WS_Q + (size_t)NT * 12288 * 2;
constexpr size_t WS_KPE = WS_CKV + (size_t)NKV * 512 * 2;
constexpr size_t WS_H1 = WS_R1;
constexpr size_t WS_OG = WS_H1;
constexpr size_t WS_PROJC = WS_H1 + (size_t)NT * DM * 2;
constexpr size_t WS_GATEB = WS_PROJC + (size_t)NT * N3C * 4;
constexpr size_t WS_QN = WS_GATEB + (size_t)NT * 8192 * 2;
constexpr size_t WS_KV = WS_QN + (size_t)NT * 1536 * 2;
constexpr size_t WS_L1END = WS_KV + (size_t)NKV * 16384 * 2;
constexpr size_t WS_WTC = WS_L1END > WS_END0 ? WS_L1END : WS_END0;
constexpr size_t WS_WTUQ = WS_WTC + (size_t)N3 * DM * 2;
constexpr size_t WS_WTUKV = WS_WTUQ + (size_t)12288 * 1536 * 2;
constexpr size_t WS_WTCOUT = WS_WTUKV + (size_t)16384 * 512 * 2;
constexpr size_t WS_END1 = WS_WTCOUT + (size_t)DM * 8192 * 2;
static_assert(WS_KPE + (size_t)NKV * 64 * 2 <= WS_R1, "q, ckv, kpe must fit in R0");
constexpr size_t WS_NEED = WS_END0 > WS_END1 ? WS_END0 : WS_END1;
static_assert((size_t)NT * (DM * 2 + N3C * 4) >= (size_t)NT * 8192 * 2, "og must fit over h1 + projC");
static_assert(WS_R2 + 2 * SZA <= WS_R4, "r,k must fit in R2");

constexpr size_t OUT_Y = 0, OUT_STATE = 50331648, OUT_GK = 54525952, OUT_GV = 56623104, OUT_CKV = 58720256, OUT_KPE = 60817408, OUT_TOTAL = 61079552;

constexpr int LDS_X = 8 * 18688;
constexpr int LDS_BYTES = LDS_X + 512;
static_assert(TID_TAB_OFF == LDS_X + 128, "tid table behind the barrier / queue words");
constexpr int NPH = 15;

struct Params { const float* in[33]; float* out; unsigned char* ws; int ph_lo, ph_hi; };
typedef const __attribute__((address_space(4))) Params* KP;
__device__ __forceinline__ KP get_params() { unsigned long long a = (unsigned long long)__builtin_amdgcn_kernarg_segment_ptr(); asm volatile("" : "+s"(a)); return (KP)a; }

enum { I_XP = 0, I_XS, I_C, I_STATE, I_CGK, I_CGV, I_CCKV, I_CKPE, I_CCTX, I_MODW, I_MODB, I_NORMG, I_ABWIN, I_ABMIX, I_W0, I_W2, I_A0, I_A2, I_KK, I_KA, I_RK, I_LNW, I_LNB,
       I_QG, I_KG, I_ABWOUT, I_CWIN, I_QAG, I_KVAG, I_WUQ, I_WUKV, I_CWOUT, I_FINALG };

__device__ __forceinline__ void transpose_tile(const float* __restrict__ src, int ldn, int K, int k0, int n0, bf16_t* __restrict__ dst, int drow0, unsigned char* lds) {
    const int t = TIDX;
    constexpr int RS = 528;
    __syncthreads();
    {
        const int nq = t & 15, kr = t >> 4;
#pragma unroll
        for (int it = 0; it < 4; ++it) {
            const int k = 2 * kr + 64 * it;
            const f32x4 a = *(const f32x4*)(src + (size_t)(k0 + k) * ldn + n0 + nq * 4);
            const f32x4 b = *(const f32x4*)(src + (size_t)(k0 + k + 1) * ldn + n0 + nq * 4);
#pragma unroll
            for (int e = 0; e < 4; ++e) *(unsigned*)(lds + (nq * 4 + e) * RS + k * 2) = cvt_pk_bf16(a[e], b[e]);
        }
    }
    __syncthreads();
    {
        const int n = t >> 3, kc = (t & 7) * 32;
        bf16_t* d = dst + (size_t)(drow0 + n) * K + k0 + kc;
#pragma unroll
        for (int q = 0; q < 4; ++q) *(u32x4*)(d + q * 8) = *(const u32x4*)(lds + n * RS + (kc + q * 8) * 2);
    }
}
template <class RowMap>
__device__ __forceinline__ int transpose_all(const float* src, int K, int Nsrc, bf16_t* dst, RowMap rm, int u0, unsigned char* lds, int G = (int)gridDim.x, int wg = (int)blockIdx.x) {
    const int nkt = K / 256, nnt = Nsrc / 64, nu = nkt * nnt;
    int first = (wg - (u0 % G) + G) % G;
    for (int u = first; u < nu; u += G) { const int kt = u % nkt, ntile = u / nkt; transpose_tile(src, Nsrc, K, kt * 256, ntile * 64, dst, rm(ntile * 64), lds); }
    return nu;
}
struct RowId { __device__ int operator()(int n) const { return n; } };
struct RowMla { __device__ int operator()(int n) const { return n < 2112 ? 8192 + n : n - 2112; } };

__device__ __forceinline__ void phase0(KP p, unsigned char* lds) {
    unsigned char* ws = p->ws;
    const int tid = TIDX, G = gridDim.x, bid = blockIdx.x;
    {
        float* cb = (float*)(ws + WS_ROPEB_COS); float* sb = (float*)(ws + WS_ROPEB_SIN);
        float* cc = (float*)(ws + WS_ROPEC_COS); float* sc = (float*)(ws + WS_ROPEC_SIN);
        for (int i = bid * 512 + tid; i < 2048 * 64 + 2048 * 32; i += G * 512) {
            if (i < 2048 * 64) { const int t = i >> 6, pi = i & 63; const int fi = pi & 31; const float pos = (float)(pi < 32 ? (t >> 6) : (t & 63));
                const float inv = exp2f(-(float)fi * (13.287712379549449f / 32.0f)); const float a = pos * inv; cb[i] = cosf(a); sb[i] = sinf(a); }
            else { const int j = i - 2048 * 64; const int t = j >> 5, pi = j & 31; const int fi = pi & 15; const float pos = (float)(pi < 16 ? (t >> 6) : (t & 63));
                const float inv = exp2f(-(float)fi * (13.287712379549449f / 16.0f)); const float a = pos * inv; cc[j] = cosf(a); sc[j] = sinf(a); }
        }
    }
    {
        bf16_t* WL = (bf16_t*)(ws + WS_WTLORA);
        for (int i = bid * 512 + tid; i < 2 * 4096 * 32; i += G * 512) {
            const int d = i >> 17, n = (i >> 5) & 4095, k8 = (i & 31) * 8; const int isa = n >> 11, nn = n & 2047;
            u32x4 o = (u32x4){0u, 0u, 0u, 0u};
            if ((k8 >> 7) == isa) {
                const float* src = (isa ? p->in[I_A2] : p->in[I_W2]) + (size_t)d * 128 * 2048 + nn; const int kb = k8 & 127;
                float v[8];
#pragma unroll
                for (int e = 0; e < 8; ++e) v[e] = src[(size_t)(kb + e) * 2048];
                o = (u32x4){cvt_pk_bf16(v[0], v[1]), cvt_pk_bf16(v[2], v[3]), cvt_pk_bf16(v[4], v[5]), cvt_pk_bf16(v[6], v[7])};
            }
            *(u32x4*)(WL + ((size_t)d * 4096 + n) * 256 + k8) = o;
        }
    }
    {
        unsigned* qhead = (unsigned*)(ws + WS_CTL) + 4096 + 64;
        float* S = (float*)lds;
        float* RED = (float*)(lds + 81920);
        bool have_s = false;
        for (;;) {
            unsigned qa = LDS_X + 64; asm volatile("" : "+s"(qa));
            volatile LAS unsigned* qslot = (volatile LAS unsigned*)(LAS char*)(uintptr_t)qa;
            __syncthreads();
            if (TIDX == 0) *qslot = __hip_atomic_fetch_add(qhead, 1u, __ATOMIC_RELAXED, __HIP_MEMORY_SCOPE_AGENT);
            __syncthreads();
            const int u = (int)__builtin_amdgcn_readfirstlane(*qslot);
            if (u >= 192 + 3456 + 1024) break;
            if (u >= 192) {
                const int t = u - 192;
                if (t < 3456) transpose_tile(p->in[I_ABWIN], N1, 4096, (t & 15) * 256, (t >> 4) * 64, (bf16_t*)(ws + WS_WTA), (t >> 4) * 64, lds);
                else { const int t2 = t - 3456; transpose_tile(p->in[I_ABWOUT], 4096, 4096, (t2 & 15) * 256, (t2 >> 4) * 64, (bf16_t*)(ws + WS_WTOUT), (t2 >> 4) * 64, lds); }
                continue;
            }
            if (!have_s) {
                for (int i = tid; i < 5 * 4096; i += 512) { const int r = i >> 12, k = i & 4095; const float x = r == 0 ? p->in[I_CCTX][k] : p->in[I_C][(r - 1) * 4096 + k]; S[i] = silu_f(x); }
                have_s = true;
            }
            __syncthreads();
            const int layer = u / 96, c0 = (u % 96) * 128;
            const int cg = tid & 31, ks = tid >> 5;
            const float* W = p->in[I_MODW] + (size_t)layer * 4096 * 12288 + c0 + cg * 4;
            f32x4 acc[5];
#pragma unroll
            for (int r = 0; r < 5; ++r) acc[r] = (f32x4){0.f, 0.f, 0.f, 0.f};
#pragma unroll 8
            for (int kk = 0; kk < 256; ++kk) {
                const int k = ks * 256 + kk;
                const f32x4 w = *(const f32x4*)(W + (size_t)k * 12288);
#pragma unroll
                for (int r = 0; r < 5; ++r) acc[r] += w * S[r * 4096 + k];
            }
#pragma unroll
            for (int r = 0; r < 5; ++r) *(f32x4*)(RED + (ks * 5 + r) * 128 + cg * 4) = acc[r];
            __syncthreads();
            for (int o = tid; o < 640; o += 512) {
                const int r = o >> 7, c = o & 127; float sacc = 0.f;
#pragma unroll
                for (int q = 0; q < 16; ++q) sacc += RED[(q * 5 + r) * 128 + c];
                ((float*)(ws + WS_MOD))[((size_t)layer * 5 + r) * 12288 + c0 + c] = sacc + p->in[I_MODB][layer * 12288 + c0 + c];
            }
        }
        __syncthreads();
    }
}

__device__ __forceinline__ void phase_cvt1(KP p, unsigned char* lds, int part, int G, int wg) {
    unsigned char* ws = p->ws; int u0 = 0;
    if (part == 0) {
        u0 += transpose_all(p->in[I_CWIN], 4096, 10304, (bf16_t*)(ws + WS_WTC), RowMla(), u0, lds, G, wg);
        u0 += transpose_all(p->in[I_WUQ], 1536, 12288, (bf16_t*)(ws + WS_WTUQ), RowId(), u0, lds, G, wg);
        bf16_t* pad = (bf16_t*)(ws + WS_WTC) + (size_t)10304 * 4096;
        for (int i = wg * 512 + TIDX; i < 192 * 4096 / 8; i += G * 512) *(u32x4*)(pad + (size_t)i * 8) = (u32x4){0u, 0u, 0u, 0u};
    } else if (part == 1) {
        u0 += transpose_all(p->in[I_WUKV], 512, 16384, (bf16_t*)(ws + WS_WTUKV), RowId(), u0, lds, G, wg);
    } else {
        u0 += transpose_all(p->in[I_CWOUT], 8192, 4096, (bf16_t*)(ws + WS_WTCOUT), RowId(), u0, lds, G, wg);
    }
}

__device__ __forceinline__ void phase_h(KP p, int layer, const float* x0  , const float* x1  , bf16_t* h) {
    const int lane = TIDX & 63, wave = TIDX >> 6, gw = blockIdx.x * 8 + wave, nw = gridDim.x * 8;
    const float* mod = (const float*)(p->ws + WS_MOD) + (size_t)layer * 5 * 12288;
    const float* g = p->in[I_NORMG] + layer * 4096;
    for (int row = gw; row < NT; row += nw) {
        const float* x = row < NP ? x0 + (size_t)row * DM : x1 + (size_t)(row - NP) * DM;
        const int mr = row < NP ? 0 : 1 + (row - NP) / 2048;
        f32x4 v[16]; float ss = 0.f;
#pragma unroll
        for (int i = 0; i < 16; ++i) { v[i] = ((const f32x4*)x)[lane + 64 * i]; ss += v[i][0] * v[i][0] + v[i][1] * v[i][1] + v[i][2] * v[i][2] + v[i][3] * v[i][3]; }
        ss = wave_sum(ss);
        const float inv = rsqrtf(ss * (1.0f / 4096.0f) + 1e-6f);
        const float* msh = mod + (size_t)mr * 12288; const float* msc = msh + 4096;
#pragma unroll
        for (int i = 0; i < 16; ++i) {
            const int c4 = lane + 64 * i;
            const f32x4 g4 = ((const f32x4*)g)[c4], sc = ((const f32x4*)msc)[c4], sh = ((const f32x4*)msh)[c4];
            const f32x4 o = v[i] * inv * g4 * (sc + 1.0f) + sh;
            u32x2 w; w.x = cvt_pk_bf16(o[0], o[1]); w.y = cvt_pk_bf16(o[2], o[3]);
            *(u32x2*)(h + (size_t)row * DM + c4 * 4) = w;
        }
    }
}

__device__ __forceinline__ void phase_h_bf(KP p, int layer, const bf16_t* xb, bf16_t* h) {
    const int lane = TIDX & 63, wave = TIDX >> 6, gw = blockIdx.x * 8 + wave, nw = gridDim.x * 8;
    const float* mod = (const float*)(p->ws + WS_MOD) + (size_t)layer * 5 * 12288;
    const float* g = p->in[I_NORMG] + layer * 4096;
    for (int row = gw; row < NT; row += nw) {
        const u32x2* x = (const u32x2*)(xb + (size_t)row * DM);
        const int mr = row < NP ? 0 : 1 + (row - NP) / 2048;
        f32x4 v[16]; float ss = 0.f;
#pragma unroll
        for (int i = 0; i < 16; ++i) { v[i] = up4(x[lane + 64 * i]); ss += v[i][0] * v[i][0] + v[i][1] * v[i][1] + v[i][2] * v[i][2] + v[i][3] * v[i][3]; }
        ss = wave_sum(ss);
        const float inv = rsqrtf(ss * (1.0f / 4096.0f) + 1e-6f);
        const float* msh = mod + (size_t)mr * 12288; const float* msc = msh + 4096;
#pragma unroll
        for (int i = 0; i < 16; ++i) {
            const int c4 = lane + 64 * i;
            const f32x4 g4 = ((const f32x4*)g)[c4], sc = ((const f32x4*)msc)[c4], sh = ((const f32x4*)msh)[c4];
            *(u32x2*)(h + (size_t)row * DM + c4 * 4) = pk4(v[i] * inv * g4 * (sc + 1.0f) + sh);
        }
    }
}

#define EPI_LOOP_BEGIN \
    _Pragma("unroll") for (int ai = 0; ai < 2; ++ai) _Pragma("unroll") for (int m = 0; m < 4; ++m) { const int row = u.pm * 256 + ai * 128 + wr * 64 + m * 16 + fr; \
    _Pragma("unroll") for (int bj = 0; bj < 2; ++bj) _Pragma("unroll") for (int n = 0; n < 2; ++n) { const int col = u.pn * 256 + bj * 128 + wc * 32 + fq * 8 + n * 4; const f32x4 a = acc[ai][bj][m][n];
#define EPI_LOOP_END } }

struct EpiG1 {
    bf16_t* F; bf16_t* B;
    __device__ __forceinline__ void operator()(const f32x4 (&acc)[2][2][4][2], const pg8::Unit& u, int wr, int wc, int fr, int fq) const {
        if (u.pn < 26) {
            EPI_LOOP_BEGIN *(u32x2*)(F + (size_t)row * N1F + col) = pk4(a); EPI_LOOP_END
        } else {
            EPI_LOOP_BEGIN *(u32x2*)(B + (size_t)row * N1B + (col - N1F)) = pk4(a); EPI_LOOP_END
        }
    }
};
struct EpiBf16Plain {
    bf16_t* O; int ldc;
    __device__ __forceinline__ void operator()(const f32x4 (&acc)[2][2][4][2], const pg8::Unit& u, int wr, int wc, int fr, int fq) const {
        EPI_LOOP_BEGIN u32x2 w; w.x = cvt_pk_bf16(a[0], a[1]); w.y = cvt_pk_bf16(a[2], a[3]); *(u32x2*)(O + (size_t)row * ldc + col) = w; EPI_LOOP_END
    }
};
struct EpiLora {
    const float* w0; const float* a0; bf16_t* Wd; bf16_t* Ad;
    __device__ __forceinline__ void operator()(const f32x4 (&acc)[2][2][4][2], const pg8::Unit& u, int wr, int wc, int fr, int fq) const {
        if (u.pn < 8) {
            EPI_LOOP_BEGIN const int c = col & 2047; const f32x4 b0 = *(const f32x4*)(w0 + c); f32x4 o;
#pragma unroll
                for (int e = 0; e < 4; ++e) o[e] = -0.8750270622f * sigmoid_f(a[e] + b0[e]);
                *(u32x2*)(Wd + (size_t)row * AW + c) = pk4(o); EPI_LOOP_END
        } else {
            EPI_LOOP_BEGIN const int c = col & 2047; const f32x4 b0 = *(const f32x4*)(a0 + c); f32x4 o;
#pragma unroll
                for (int e = 0; e < 4; ++e) o[e] = sigmoid_f(a[e] + b0[e]);
                *(u32x2*)(Ad + (size_t)row * AW + c) = pk4(o); EPI_LOOP_END
        }
    }
};
template <bool XBF> struct EpiRes {
    const float* x0; const float* x1; const bf16_t* xb; bf16_t* out; const float* gate;
    __device__ __forceinline__ void operator()(const f32x4 (&acc)[2][2][4][2], const pg8::Unit& u, int wr, int wc, int fr, int fq) const {
        const int rbase = u.pm * 256; const float* xin = rbase < NP ? x0 + (size_t)0 : x1 - (size_t)NP * DM; const int mr = rbase < NP ? 0 : 1 + (rbase - NP) / 2048;
        const float* gr = gate + (size_t)mr * 12288;
        EPI_LOOP_BEGIN f32x4 xv; if constexpr (XBF) xv = up4(*(const u32x2*)(xb + (size_t)row * DM + col)); else xv = *(const f32x4*)(xin + (size_t)row * DM + col);
            const f32x4 gv = *(const f32x4*)(gr + col);
            *(u32x2*)(out + (size_t)row * DM + col) = pk4(xv + gv * a); EPI_LOOP_END
    }
};
struct EpiG3 {
    bf16_t* Gt; bf16_t* C;
    __device__ __forceinline__ void operator()(const f32x4 (&acc)[2][2][4][2], const pg8::Unit& u, int wr, int wc, int fr, int fq) const {
        if (u.pn < 32) {
            EPI_LOOP_BEGIN *(u32x2*)(Gt + (size_t)row * N3G + col) = pk4(a); EPI_LOOP_END
        } else {
            EPI_LOOP_BEGIN *(u32x2*)(C + (size_t)row * N3C + (col - N3G)) = pk4(a); EPI_LOOP_END
        }
    }
};
struct EpiQ {
    bf16_t* Q; const float* cosC; const float* sinC;
    __device__ __forceinline__ void operator()(const f32x4 (&acc)[2][2][4][2], const pg8::Unit& u, int wr, int wc, int fr, int fq) const {
        const bool samp = u.pm * 256 >= NP;
        EPI_LOOP_BEGIN f32x4 o = a; const int hc = col % 192;
            if (samp && hc >= 128) { const int t = (row - NP) & 2047; const int pi = (hc - 128) >> 1;
                const f32x2 cs = *(const f32x2*)(cosC + t * 32 + pi), sn = *(const f32x2*)(sinC + t * 32 + pi);
                o[0] = a[0] * cs[0] - a[1] * sn[0]; o[1] = a[0] * sn[0] + a[1] * cs[0]; o[2] = a[2] * cs[1] - a[3] * sn[1]; o[3] = a[2] * sn[1] + a[3] * cs[1]; }
            u32x2 w; w.x = cvt_pk_bf16(o[0], o[1]); w.y = cvt_pk_bf16(o[2], o[3]); *(u32x2*)(Q + (size_t)row * 12288 + col) = w; EPI_LOOP_END
    }
};

__device__ __forceinline__ void unpack8(const u32x4 w, float (&x)[8]) { x[0] = bf_lo(w.x); x[1] = bf_hi(w.x); x[2] = bf_lo(w.y); x[3] = bf_hi(w.y); x[4] = bf_lo(w.z); x[5] = bf_hi(w.z); x[6] = bf_lo(w.w); x[7] = bf_hi(w.w); }
__device__ __forceinline__ u32x4 pack8(const float (&x)[8]) { return (u32x4){cvt_pk_bf16(x[0], x[1]), cvt_pk_bf16(x[2], x[3]), cvt_pk_bf16(x[4], x[5]), cvt_pk_bf16(x[6], x[7])}; }
__device__ __forceinline__ void rope8(float (&x)[8], const float* cs, const float* sn) {
    const f32x4 c = *(const f32x4*)cs, s = *(const f32x4*)sn;
#pragma unroll
    for (int e = 0; e < 4; ++e) { const float xr = x[2 * e], xi = x[2 * e + 1]; x[2 * e] = xr * c[e] - xi * s[e]; x[2 * e + 1] = xr * s[e] + xi * c[e]; }
}
__device__ __forceinline__ void phase_prepA(KP p) {
    unsigned char* ws = p->ws;
    const int lane = TIDX & 63, wave = TIDX >> 6, gw = blockIdx.x * 8 + wave, nw = gridDim.x * 8;
    const bf16_t* projF = (const bf16_t*)(ws + WS_PROJF); bf16_t* projB = (bf16_t*)(ws + WS_PROJB);
    bf16_t* Rb = (bf16_t*)(ws + WS_R); bf16_t* Kb = (bf16_t*)(ws + WS_K); bf16_t* KKb = (bf16_t*)(p->out + OUT_Y); bf16_t* Vb = (bf16_t*)(p->out + OUT_Y + (size_t)NT * AW);
    bf16_t* lora = (bf16_t*)(ws + WS_LORA);
    bf16_t* KbP = (bf16_t*)(ws + WS_KBP); bf16_t* VbP = (bf16_t*)(ws + WS_VBP); bf16_t* KbS = (bf16_t*)(ws + WS_KBS); bf16_t* VbS = (bf16_t*)(ws + WS_VBS);
    const float* cosB = (const float*)(ws + WS_ROPEB_COS); const float* sinB = (const float*)(ws + WS_ROPEB_SIN);
    const float* mix = p->in[I_ABMIX]; const float* k_k = p->in[I_KK]; const float* qg = p->in[I_QG]; const float* kg = p->in[I_KG];
    for (int row = gw; row < NT + 1024; row += nw) {
        if (row >= NT) {
            const int cr = row - NT, b = cr >> 8, t = cr & 255; const size_t drow = (size_t)(b * 2304 + t) * 512 + lane * 8;
            { const float* s = p->in[I_CGK] + (size_t)cr * 512 + lane * 8; const f32x4 a = *(const f32x4*)s, c = *(const f32x4*)(s + 4);
              *(u32x4*)(KbS + drow) = (u32x4){cvt_pk_bf16(a[0], a[1]), cvt_pk_bf16(a[2], a[3]), cvt_pk_bf16(c[0], c[1]), cvt_pk_bf16(c[2], c[3])}; }
            { const float* s = p->in[I_CGV] + (size_t)cr * 512 + lane * 8; const f32x4 a = *(const f32x4*)s, c = *(const f32x4*)(s + 4);
              *(u32x4*)(VbS + drow) = (u32x4){cvt_pk_bf16(a[0], a[1]), cvt_pk_bf16(a[2], a[3]), cvt_pk_bf16(c[0], c[1]), cvt_pk_bf16(c[2], c[3])}; }
            continue;
        }
        const bool samp = row >= NP; int b, t, T;
        if (!samp) { b = row >> 8; t = row & 255; T = 256; } else { const int rr = row - NP; b = rr >> 11; t = rr & 2047; T = 2048; }
        const bool hp = t > 0, hn = t < T - 1;
        const u32x2* pc = (const u32x2*)(projF + (size_t)row * N1F); const u32x2* pp = pc - N1F / 4; const u32x2* pn = pc + N1F / 4;
        const f32x4 z4 = (f32x4){0.f, 0.f, 0.f, 0.f};
        const u32x4* pc8 = (const u32x4*)pc; const u32x4* pp8 = (const u32x4*)pp; const u32x4* pn8 = (const u32x4*)pn;
#pragma unroll
        for (int it = 0; it < 13; ++it) {
            const int c8 = lane + 64 * it;
            float cur[8], prv[8], nxt[8], sh[8];
            unpack8(pc8[c8], cur);
            if (hp) unpack8(pp8[c8], prv); else {
#pragma unroll
                for (int e = 0; e < 8; ++e) prv[e] = 0.f; }
            if (hn) unpack8(pn8[c8], nxt); else {
#pragma unroll
                for (int e = 0; e < 8; ++e) nxt[e] = 0.f; }
            const f32x4 m0 = ((const f32x4*)mix)[2 * c8], m1 = ((const f32x4*)mix)[2 * c8 + 1];
#pragma unroll
            for (int e = 0; e < 8; ++e) { const float mx = e < 4 ? m0[e & 3] : m1[e & 3]; sh[e] = cur[e] + mx * ((prv[e] + nxt[e]) * 0.5f - cur[e]); }
            if (it < 12) {
                const int which = it >> 2, cc = (c8 & 255) * 8; const size_t o = (size_t)row * AW + cc;
                if (which == 0) *(u32x4*)(Rb + o) = pack8(sh);
                else if (which == 2) *(u32x4*)(Vb + o) = pack8(sh);
                else { *(u32x4*)(Kb + o) = pack8(sh);
                    const f32x4 k0 = *(const f32x4*)(k_k + cc), k1 = *(const f32x4*)(k_k + cc + 4); float kk[8]; float ss = 0.f;
#pragma unroll
                    for (int e = 0; e < 8; ++e) { kk[e] = sh[e] * (e < 4 ? k0[e & 3] : k1[e & 3]); ss += kk[e] * kk[e]; }
                    ss += __shfl_xor(ss, 1); ss += __shfl_xor(ss, 2); ss += __shfl_xor(ss, 4);
                    const float inv = 1.0f / fmaxf(sqrtf(ss), 1e-12f);
#pragma unroll
                    for (int e = 0; e < 8; ++e) kk[e] *= inv;
                    *(u32x4*)(KKb + o) = pack8(kk); }
            } else {
                const int cl = lane * 8;
                if ((cl & 255) < 128) {
#pragma unroll
                    for (int e = 0; e < 8; ++e) { const float ex = __expf(2.0f * sh[e]); sh[e] = 1.0f - 2.0f * __builtin_amdgcn_rcpf(ex + 1.0f); } }
                *(u32x4*)(lora + ((size_t)(cl >> 8) * NT + row) * 256 + (cl & 255)) = pack8(sh);
            }
        }
        bf16_t* pb = projB + (size_t)row * N1B;
        {
            const int col = lane * 8, hc = col & 127; float x[8]; unpack8(*(const u32x4*)(pb + 4096 + col), x);
            float ss = 0.f;
#pragma unroll
            for (int e = 0; e < 8; ++e) ss += x[e] * x[e];
            ss = sum16(ss); const float inv = rsqrtf(ss * (1.0f / 128.0f) + 1e-6f);
            const f32x4 g0 = *(const f32x4*)(kg + hc), g1 = *(const f32x4*)(kg + hc + 4);
#pragma unroll
            for (int e = 0; e < 4; ++e) { x[e] = x[e] * inv * g0[e]; x[4 + e] = x[4 + e] * inv * g1[e]; }
            if (!samp) {
                float* o = p->out + OUT_GK + (size_t)row * 512 + col; *(f32x4*)o = (f32x4){x[0], x[1], x[2], x[3]}; *(f32x4*)(o + 4) = (f32x4){x[4], x[5], x[6], x[7]};
                *(u32x4*)(KbP + (size_t)row * 512 + col) = pack8(x);
            } else {
                rope8(x, cosB + t * 64 + (hc >> 1), sinB + t * 64 + (hc >> 1));
                *(u32x4*)(KbS + (size_t)(b * 2304 + 256 + t) * 512 + col) = pack8(x);
            }
        }
        {
            const int col = lane * 8; const u32x4 w = *(const u32x4*)(pb + 4608 + col);
            if (!samp) { float x[8]; unpack8(w, x);
                float* o = p->out + OUT_GV + (size_t)row * 512 + col; *(f32x4*)o = (f32x4){x[0], x[1], x[2], x[3]}; *(f32x4*)(o + 4) = (f32x4){x[4], x[5], x[6], x[7]};
                *(u32x4*)(VbP + (size_t)row * 512 + col) = w;
            } else *(u32x4*)(VbS + (size_t)(b * 2304 + 256 + t) * 512 + col) = w;
        }
    }
}

#define KSWZ(row, colB) ((row) * 256 + ((colB) ^ ((((row) & 7) | ((((row) >> 4) & 1) << 3)) << 4)))
#define PSWZ(row, colB) ((row) * 128 + ((colB) ^ ((((row) >> 1) & 7) << 4)))
#define SBAR() __builtin_amdgcn_sched_barrier(0)
__device__ __forceinline__ int crow(int r, int hi) { return (r & 3) + 8 * (r >> 2) + 4 * hi; }
template <class C>
__device__ __forceinline__ void partialSM(f32x16& p0, f32x16& p1, float& m_reg, float& mn, float& alpha) {
    constexpr float Cc = C::SCALE * 1.4426950408889634f;
    float pmax = p0[0];
#pragma unroll
    for (int r = 1; r < 16; ++r) pmax = fmaxf(pmax, p0[r]);
#pragma unroll
    for (int r = 0; r < 16; ++r) pmax = fmaxf(pmax, p1[r]);
    { auto rr = __builtin_amdgcn_permlane32_swap(__float_as_uint(pmax), __float_as_uint(pmax), false, false);
      pmax = fmaxf(__uint_as_float(rr[0]), __uint_as_float(rr[1])); }
    if (__builtin_expect(__all(pmax - m_reg <= 8.0f / C::SCALE), 1)) { mn = m_reg; alpha = 1.f; }
    else { mn = fmaxf(m_reg, pmax); alpha = __builtin_amdgcn_exp2f((m_reg - mn) * Cc); m_reg = mn; }
    const float mnC = -mn * Cc;
#pragma unroll
    for (int r = 0; r < 16; ++r) p0[r] = fmaf(p0[r], Cc, mnC);
#pragma unroll
    for (int r = 0; r < 16; ++r) p1[r] = fmaf(p1[r], Cc, mnC);
#pragma unroll
    for (int r = 0; r < 16; ++r) p0[r] = __builtin_amdgcn_exp2f(p0[r]);
}
__device__ __forceinline__ void finishSM(f32x16& p0, f32x16& p1, float alpha, float& l_reg, bf16x8& pa0, bf16x8& pa1, bf16x8& pa2, bf16x8& pa3) {
#pragma unroll
    for (int r = 0; r < 16; ++r) p1[r] = __builtin_amdgcn_exp2f(p1[r]);
    float ps = 0;
#pragma unroll
    for (int r = 0; r < 16; ++r) ps += p0[r];
#pragma unroll
    for (int r = 0; r < 16; ++r) ps += p1[r];
    { auto rr = __builtin_amdgcn_permlane32_swap(__float_as_uint(ps), __float_as_uint(ps), false, false);
      ps = __uint_as_float(rr[0]) + __uint_as_float(rr[1]); }
    l_reg = l_reg * alpha + ps;
#define PK4(P, BASE, OUT) do { unsigned a0 = cvt_pk_bf16(P[BASE + 0], P[BASE + 1]), a1 = cvt_pk_bf16(P[BASE + 2], P[BASE + 3]);   \
    unsigned b0 = cvt_pk_bf16(P[BASE + 4], P[BASE + 5]), b1 = cvt_pk_bf16(P[BASE + 6], P[BASE + 7]);                              \
    auto r0 = __builtin_amdgcn_permlane32_swap(a0, b0, false, false); auto r1 = __builtin_amdgcn_permlane32_swap(a1, b1, false, false); \
    u32x4 w = {r0[0], r1[0], r0[1], r1[1]}; OUT = *reinterpret_cast<bf16x8*>(&w); } while (0)
    PK4(p0, 0, pa0); PK4(p0, 8, pa1); PK4(p1, 0, pa2); PK4(p1, 8, pa3);
#undef PK4
}
template <class C>
__device__ __forceinline__ void qkt(f32x16& p0, f32x16& p1, const char* Ks, const char* Ps, const bf16x8* qr, const char* Qpe, int r32, int hi) {
    p0 = f32x16{}; p1 = f32x16{};
#pragma unroll
    for (int d0 = 0; d0 < 8; ++d0) { const int cb = (d0 * 16 + hi * 8) * 2;
        const bf16x8 b0 = *reinterpret_cast<const bf16x8*>(Ks + KSWZ(r32, cb));
        const bf16x8 b1 = *reinterpret_cast<const bf16x8*>(Ks + KSWZ(32 + r32, cb));
        bf16x8 qf; if constexpr (true) { if (d0 < C::NDR) qf = qr[d0 < C::NDR ? d0 : 0]; else qf = *reinterpret_cast<const bf16x8*>(Qpe + (d0 - C::NDR) * 1024); }
        p0 = __builtin_amdgcn_mfma_f32_32x32x16_bf16(b0, qf, p0, 0, 0, 0);
        p1 = __builtin_amdgcn_mfma_f32_32x32x16_bf16(b1, qf, p1, 0, 0, 0); }
    if constexpr (C::PE) {
#pragma unroll
        for (int d1 = 0; d1 < 4; ++d1) { const int cb = (d1 * 16 + hi * 8) * 2;
            const bf16x8 b0 = *reinterpret_cast<const bf16x8*>(Ps + PSWZ(r32, cb));
            const bf16x8 b1 = *reinterpret_cast<const bf16x8*>(Ps + PSWZ(32 + r32, cb));
            const bf16x8 qf = *reinterpret_cast<const bf16x8*>(Qpe + (8 - C::NDR + d1) * 1024);
            p0 = __builtin_amdgcn_mfma_f32_32x32x16_bf16(b0, qf, p0, 0, 0, 0);
            p1 = __builtin_amdgcn_mfma_f32_32x32x16_bf16(b1, qf, p1, 0, 0, 0); }
    }
}
#define QK_PIPE 1
template <class C> __device__ __forceinline__ void qk_pipe() {
#ifdef QK_PIPE
    if constexpr (C::PE) {
        constexpr int NV = 7, NG = 12;
        __builtin_amdgcn_sched_group_barrier(0x100, 2, 0);
#pragma unroll
        for (int g_ = 0; g_ < NG; ++g_) {
            if (g_ + 1 < NG) { if (g_ + 1 < 8) __builtin_amdgcn_sched_group_barrier(0x100, 2, 0); else __builtin_amdgcn_sched_group_barrier(0x100, 3, 0); }
            __builtin_amdgcn_sched_group_barrier(0x402, NV, 0); __builtin_amdgcn_sched_group_barrier(0x008, 2, 0); }
    } else {
        constexpr int NV = 10;
        __builtin_amdgcn_sched_group_barrier(0x100, 4, 0);
#pragma unroll
        for (int g_ = 0; g_ < 8; ++g_) { if (g_ + 2 < 8) __builtin_amdgcn_sched_group_barrier(0x100, 2, 0); __builtin_amdgcn_sched_group_barrier(0x402, NV, 0); __builtin_amdgcn_sched_group_barrier(0x008, 2, 0); }
    }
#endif
}
__device__ __forceinline__ int v_st(int k, int c) { const int kk = (k & ~0xC) | ((k & 4) << 1) | ((k & 8) >> 1); return ((kk >> 3) * 4 + (c >> 5)) * 512 + ((kk & 7) * 32 + (c & 31)) * 2; }
__device__ __forceinline__ int v_rd_base(int lane) { return ((lane & 3) << 3) | (((lane >> 2) & 3) << 6) | (((lane >> 4) & 1) << 5) | (((lane >> 5) & 1) << 8); }
constexpr int v_rd_off(int d0, int ks, int half) { return d0 * 512 + ks * 4096 + half * 2048; }
template <int OFF> __device__ __forceinline__ s16x4 tr_read(int vb) {
    s16x4 r; asm volatile("ds_read_b64_tr_b16 %0, %1 offset:%2" : "=&v"(r) : "v"(vb), "i"(OFF) : "memory"); return r;
}
template <int D0> __device__ __forceinline__ void pv_one(f32x16& od, int vb, bf16x8 pa0, bf16x8 pa1, bf16x8 pa2, bf16x8 pa3) {
    const s16x4 l0 = tr_read<v_rd_off(D0, 0, 0)>(vb), h0 = tr_read<v_rd_off(D0, 0, 1)>(vb), l1 = tr_read<v_rd_off(D0, 1, 0)>(vb), h1 = tr_read<v_rd_off(D0, 1, 1)>(vb);
    const s16x4 l2 = tr_read<v_rd_off(D0, 2, 0)>(vb), h2 = tr_read<v_rd_off(D0, 2, 1)>(vb), l3 = tr_read<v_rd_off(D0, 3, 0)>(vb), h3 = tr_read<v_rd_off(D0, 3, 1)>(vb);
    asm volatile("s_waitcnt lgkmcnt(0)" ::: "memory"); SBAR();
#define PK(L, H) (bf16x8){L[0], L[1], L[2], L[3], H[0], H[1], H[2], H[3]}
    od = __builtin_amdgcn_mfma_f32_32x32x16_bf16(pa0, PK(l0, h0), od, 0, 0, 0);
    od = __builtin_amdgcn_mfma_f32_32x32x16_bf16(pa1, PK(l1, h1), od, 0, 0, 0);
    od = __builtin_amdgcn_mfma_f32_32x32x16_bf16(pa2, PK(l2, h2), od, 0, 0, 0);
    od = __builtin_amdgcn_mfma_f32_32x32x16_bf16(pa3, PK(l3, h3), od, 0, 0, 0);
#undef PK
}
__device__ __forceinline__ void pv_d0(f32x16* o, int vb, bf16x8 pa0, bf16x8 pa1, bf16x8 pa2, bf16x8 pa3) {
    pv_one<0>(o[0], vb, pa0, pa1, pa2, pa3); pv_one<1>(o[1], vb, pa0, pa1, pa2, pa3); pv_one<2>(o[2], vb, pa0, pa1, pa2, pa3); pv_one<3>(o[3], vb, pa0, pa1, pa2, pa3);
}
template <class C>
__device__ __forceinline__ void pv_psm(f32x16* o, int vb, bf16x8 pa0, bf16x8 pa1, bf16x8 pa2, bf16x8 pa3, f32x16& p0, f32x16& p1, float& m_reg, float& mn, float& alpha) {
    constexpr float Cc = C::SCALE * 1.4426950408889634f;
#define PK(L, H) (bf16x8){L[0], L[1], L[2], L[3], H[0], H[1], H[2], H[3]}
#define PVG_READ(D0) const s16x4 l0 = tr_read<v_rd_off(D0, 0, 0)>(vb), h0 = tr_read<v_rd_off(D0, 0, 1)>(vb), l1 = tr_read<v_rd_off(D0, 1, 0)>(vb), h1 = tr_read<v_rd_off(D0, 1, 1)>(vb); \
    const s16x4 l2 = tr_read<v_rd_off(D0, 2, 0)>(vb), h2 = tr_read<v_rd_off(D0, 2, 1)>(vb), l3 = tr_read<v_rd_off(D0, 3, 0)>(vb), h3 = tr_read<v_rd_off(D0, 3, 1)>(vb);
#define PVG_MMA(D0) asm volatile("s_waitcnt lgkmcnt(0)" ::: "memory"); SBAR(); \
    o[D0] = __builtin_amdgcn_mfma_f32_32x32x16_bf16(pa0, PK(l0, h0), o[D0], 0, 0, 0); o[D0] = __builtin_amdgcn_mfma_f32_32x32x16_bf16(pa1, PK(l1, h1), o[D0], 0, 0, 0); \
    o[D0] = __builtin_amdgcn_mfma_f32_32x32x16_bf16(pa2, PK(l2, h2), o[D0], 0, 0, 0); o[D0] = __builtin_amdgcn_mfma_f32_32x32x16_bf16(pa3, PK(l3, h3), o[D0], 0, 0, 0);
    float mnC;
    {   PVG_READ(0)
        float pmax = p0[0];
#pragma unroll
        for (int r = 1; r < 16; ++r) pmax = fmaxf(pmax, p0[r]);
#pragma unroll
        for (int r = 0; r < 16; ++r) pmax = fmaxf(pmax, p1[r]);
        { auto rr = __builtin_amdgcn_permlane32_swap(__float_as_uint(pmax), __float_as_uint(pmax), false, false);
          pmax = fmaxf(__uint_as_float(rr[0]), __uint_as_float(rr[1])); }
        const bool keep = __all(pmax - m_reg <= 8.0f / C::SCALE);
        mn = keep ? m_reg : fmaxf(m_reg, pmax);
        alpha = __builtin_amdgcn_exp2f((m_reg - mn) * Cc); m_reg = mn; mnC = -mn * Cc;
        PVG_MMA(0) }
    {   PVG_READ(1)
#pragma unroll
        for (int r = 0; r < 16; ++r) p0[r] = fmaf(p0[r], Cc, mnC);
        PVG_MMA(1) }
    {   PVG_READ(2)
#pragma unroll
        for (int r = 0; r < 16; ++r) p1[r] = fmaf(p1[r], Cc, mnC);
        PVG_MMA(2) }
    {   PVG_READ(3)
#pragma unroll
        for (int r = 0; r < 16; ++r) p0[r] = __builtin_amdgcn_exp2f(p0[r]);
        PVG_MMA(3) }
    asm volatile("" : "+v"(p0), "+v"(p1));
#undef PK
#undef PVG_READ
#undef PVG_MMA
}
#ifndef MLA_NDR
#define MLA_NDR 8
#endif
#ifndef MLA_SD
#define MLA_SD 1
#endif
struct CfgGqa { static constexpr bool QNORM = true; static constexpr bool PE = false; static constexpr int ND = 8, NDR = 8, LDQ = N1B, LDK = 512, LDV = 512, LDO = DM, LDG = N1B, SDEPTH = 2; static constexpr float SCALE = 0.08838834764831845f; };
struct CfgMla { static constexpr bool QNORM = false; static constexpr bool PE = true; static constexpr int ND = 12, NDR = MLA_NDR, LDQ = 12288, LDK = 16384, LDV = 16384, LDO = 8192, LDG = 8192, SDEPTH = MLA_SD; static constexpr float SCALE = 0.07216878364870323f; };

struct AttnPre { bf16x8 q[8]; u32x4 qp[4]; bf16x8 vs0, vs1, ks0, ks1, ps; };
struct AttnNext { const bf16_t* Q; const bf16_t* K; const bf16_t* V; const bf16_t* P; bool valid; };
template <class C, bool XP = false>
__device__ __forceinline__ void attn_body(const bf16_t* __restrict__ Qb, const bf16_t* __restrict__ Kh, const bf16_t* __restrict__ Vh, const bf16_t* __restrict__ Ph,
                                          bf16_t* __restrict__ Ob, const bf16_t* __restrict__ Gb, int seq, char* lds, const float* ropeC = nullptr, const float* ropeS = nullptr, int t0 = 0, const float* qg = nullptr,
                                          AttnPre* pre = nullptr, bool have = false, AttnNext nxt = AttnNext{nullptr, nullptr, nullptr, nullptr, false}) {
    constexpr int SD = C::SDEPTH; constexpr size_t SHM_V = 64 * 128 * 2, SHM_K = 64 * 128 * 2, SHM_P = C::PE ? 64 * 64 * 2 : 0;
    int tid_ = TIDX; asm volatile("" : "+v"(tid_));
    const int tid = tid_, wid = tid >> 6, lane = tid & 63, r32 = lane & 31, hi = lane >> 5;
    char* V_lds = lds; char* K_lds = lds + 2 * SHM_V; char* P_lds = lds + 2 * SHM_V + 2 * SHM_K;
    float* wsf = (float*)(lds + 2 * SHM_V + 2 * SHM_K + 2 * SHM_P) + wid * 64; float* li_l = wsf; float* al_l = wsf + 32;
    float m_reg = -1e30f, l_reg = 0; f32x16 o[4] = {}; bf16x8 qr[C::NDR];
    const bf16_t* Qw = Qb + (long)(wid * 32 + r32) * C::LDQ + hi * 8;
    char* Qpe = (char*)(wsf - wid * 64) + 2048 + wid * ((C::ND - C::NDR) * 1024) + lane * 16;
    __syncthreads();
    const int sr = tid >> 4, sc = (tid & 15) * 8, vst0 = v_st(sr, sc), vst1 = v_st(32 + sr, sc);
    const int pr = tid >> 3, pc = (tid & 7) * 8;
    const int vb0 = (int)(uintptr_t)V_lds + v_rd_base(lane);
    struct { bf16x8 vs0, vs1, ks0, ks1, ps; } sr_[SD];
#define GAS __attribute__((address_space(1)))
    static_assert(C::LDV == C::LDK, "K and V tiles share their lane offset");
    const unsigned vo = (unsigned)((sr * C::LDV + sc) * 2), po = (unsigned)((pr * 64 + pc) * 2);
#define SLOAD(i, k0) do { const char* vb_ = (const char*)Vh + (size_t)(k0) * (C::LDV * 2); const char* kb_ = (const char*)Kh + (size_t)(k0) * (C::LDK * 2); \
    const char* pb_ = C::PE ? (const char*)Ph + (size_t)(k0) * 128 : nullptr; asm volatile("" : "+s"(vb_), "+s"(kb_), "+s"(pb_)); \
    sr_[i].vs0 = *(const GAS bf16x8*)((const GAS char*)vb_ + vo); sr_[i].vs1 = *(const GAS bf16x8*)((const GAS char*)vb_ + (size_t)32 * C::LDV * 2 + vo); \
    sr_[i].ks0 = *(const GAS bf16x8*)((const GAS char*)kb_ + vo); sr_[i].ks1 = *(const GAS bf16x8*)((const GAS char*)kb_ + (size_t)32 * C::LDK * 2 + vo); \
    if constexpr (C::PE) sr_[i].ps = *(const GAS bf16x8*)((const GAS char*)pb_ + po); } while (0)
#define SWRITE(b, i) do { *(bf16x8*)(V_lds + (b) * SHM_V + vst0) = sr_[i].vs0; *(bf16x8*)(V_lds + (b) * SHM_V + vst1) = sr_[i].vs1; const int kc = sc * 2; \
    *(bf16x8*)(K_lds + (b) * SHM_K + KSWZ(sr, kc)) = sr_[i].ks0; *(bf16x8*)(K_lds + (b) * SHM_K + KSWZ(32 + sr, kc)) = sr_[i].ks1; \
    if constexpr (C::PE) *(bf16x8*)(P_lds + (b) * SHM_P + PSWZ(pr, pc * 2)) = sr_[i].ps; } while (0)
#define SWAIT() do { if constexpr (SD == 2) { if constexpr (C::PE) asm volatile("s_waitcnt vmcnt(5)" ::: "memory"); else asm volatile("s_waitcnt vmcnt(4)" ::: "memory"); } else asm volatile("s_waitcnt vmcnt(0)" ::: "memory"); } while (0)
#define RESC(a) do { if (__any((a) < 1.f)) { if (hi == 0) al_l[r32] = (a); asm volatile("s_waitcnt lgkmcnt(0)" ::: "memory"); \
    _Pragma("unroll") for (int d = 0; d < 4; ++d) _Pragma("unroll") for (int r = 0; r < 16; ++r) o[d][r] *= al_l[crow(r, hi)]; } } while (0)
    f32x16 pA0, pA1, pB0, pB1; float mnA, mnB, alA, alB; bf16x8 pa0, pa1, pa2, pa3; const int NTl = seq / 64;
    if (__builtin_amdgcn_readfirstlane(wid) >= 4) __builtin_amdgcn_s_setprio(1);
    constexpr int SE = 0, SO = SD - 1;
    constexpr int NPK = (C::ND - C::NDR) > 0 ? (C::ND - C::NDR) : 1; u32x4 qp[NPK];
    if (XP && have) {
        if constexpr (XP) {
#pragma unroll
            for (int d0 = 0; d0 < C::NDR; ++d0) qr[d0] = pre->q[d0];
#pragma unroll
            for (int d1 = 0; d1 < C::ND - C::NDR; ++d1) qp[d1] = pre->qp[d1];
            sr_[SE].vs0 = pre->vs0; sr_[SE].vs1 = pre->vs1; sr_[SE].ks0 = pre->ks0; sr_[SE].ks1 = pre->ks1; sr_[SE].ps = pre->ps;
        }
    } else {
#pragma unroll
        for (int d0 = 0; d0 < C::NDR; ++d0) qr[d0] = *reinterpret_cast<const bf16x8*>(Qw + d0 * 16);
        if constexpr (C::PE) {
#pragma unroll
            for (int d1 = 0; d1 < C::ND - C::NDR; ++d1) qp[d1] = *reinterpret_cast<const u32x4*>(Qw + (C::NDR + d1) * 16);
        }
        SLOAD(SE, 0); if constexpr (SD == 2) SLOAD(SO, 64);
    }
    if constexpr (C::QNORM) {
        float ss = 0.f;
#pragma unroll
        for (int d0 = 0; d0 < 8; ++d0) { float x[8]; unpack8(*reinterpret_cast<const u32x4*>(&qr[d0]), x);
#pragma unroll
            for (int e = 0; e < 8; ++e) ss += x[e] * x[e]; }
        { auto rr = __builtin_amdgcn_permlane32_swap(__float_as_uint(ss), __float_as_uint(ss), false, false); ss = __uint_as_float(rr[0]) + __uint_as_float(rr[1]); }
        const float inv = rsqrtf(ss * (1.0f / 128.0f) + 1e-6f);
#pragma unroll
        for (int d0 = 0; d0 < 8; ++d0) { float x[8]; unpack8(*reinterpret_cast<const u32x4*>(&qr[d0]), x); const int dim = d0 * 16 + hi * 8;
            const f32x4 g0 = *(const f32x4*)(qg + dim), g1 = *(const f32x4*)(qg + dim + 4);
#pragma unroll
            for (int e = 0; e < 4; ++e) { x[e] = x[e] * inv * g0[e]; x[4 + e] = x[4 + e] * inv * g1[e]; }
            if (ropeC != nullptr) { const int to = (t0 + wid * 32 + r32) * 64 + (dim >> 1); rope8(x, ropeC + to, ropeS + to); }
            const u32x4 w = pack8(x); qr[d0] = *reinterpret_cast<const bf16x8*>(&w); }
    }
    if constexpr (C::PE) {
#pragma unroll
        for (int d1 = 0; d1 < C::ND - C::NDR; ++d1) {
            u32x4 f = qp[d1];
            if (C::NDR + d1 >= 8 && ropeC != nullptr) {
                const int pe = C::NDR + d1 - 8; const int to = (t0 + wid * 32 + r32) * 32 + pe * 8 + hi * 4;
                float x[8]; unpack8(f, x); rope8(x, ropeC + to, ropeS + to); f = pack8(x); }
            *reinterpret_cast<u32x4*>(Qpe + d1 * 1024) = f; }
    }
    if constexpr (SD == 2) { if constexpr (C::PE) asm volatile("s_waitcnt vmcnt(5)" ::: "memory"); else asm volatile("s_waitcnt vmcnt(4)" ::: "memory"); } else asm volatile("s_waitcnt vmcnt(0)" ::: "memory");
    SWRITE(0, SE);
    if constexpr (SD == 1) SLOAD(SO, 64); else { if (2 < NTl) SLOAD(SE, 2 * 64); }
    __syncthreads();
    qkt<C>(pA0, pA1, K_lds, P_lds, qr, Qpe, r32, hi); partialSM<C>(pA0, pA1, m_reg, mnA, alA);
    SWAIT(); SWRITE(1, SO); if constexpr (SD == 1) { if (2 < NTl) SLOAD(SO, 2 * 64); } __syncthreads();
    for (int j = 1; j + 1 < NTl; j += 2) {
        SBAR(); qkt<C>(pB0, pB1, K_lds + SHM_K, P_lds + SHM_P, qr, Qpe, r32, hi);
        finishSM(pA0, pA1, alA, l_reg, pa0, pa1, pa2, pa3); qk_pipe<C>(); SBAR();
        if constexpr (SD == 2) SLOAD(SO, (j + SD) * 64); SBAR();
        pv_psm<C>(o, vb0, pa0, pa1, pa2, pa3, pB0, pB1, m_reg, mnB, alB);
        __syncthreads(); SWAIT(); SWRITE(0, SE); if constexpr (SD == 1) SLOAD(SE, (j + 2) * 64);
        RESC(alB); __syncthreads();
        SBAR(); qkt<C>(pA0, pA1, K_lds, P_lds, qr, Qpe, r32, hi);
        finishSM(pB0, pB1, alB, l_reg, pa0, pa1, pa2, pa3); qk_pipe<C>(); SBAR();
        if constexpr (SD == 2) { if (j + 3 < NTl) SLOAD(SE, (j + 1 + SD) * 64); } SBAR();
        pv_psm<C>(o, vb0 + (int)SHM_V, pa0, pa1, pa2, pa3, pA0, pA1, m_reg, mnA, alA);
        __syncthreads(); SWAIT(); SWRITE(1, SO); if constexpr (SD == 1) { if (j + 3 < NTl) SLOAD(SO, (j + 3) * 64); }
        RESC(alA); __syncthreads();
    }
    SBAR(); qkt<C>(pB0, pB1, K_lds + SHM_K, P_lds + SHM_P, qr, Qpe, r32, hi);
    finishSM(pA0, pA1, alA, l_reg, pa0, pa1, pa2, pa3); SBAR();
    const int widu = __builtin_amdgcn_readfirstlane(wid);
    const char* Gw = (const char*)(Gb + (long)(widu * 32) * C::LDG); char* Ow = (char*)(Ob + (long)(widu * 32) * C::LDO);
    asm volatile("" : "+s"(Gw));
    u32x4 gq[8];
#pragma unroll
    for (int i = 0; i < 8; ++i) { const int ch = i * 64 + lane; gq[i] = *(const GAS u32x4*)((const GAS char*)Gw + (unsigned)((ch >> 4) * C::LDG * 2 + (ch & 15) * 16)); }
    SBAR();
    pv_psm<C>(o, vb0, pa0, pa1, pa2, pa3, pB0, pB1, m_reg, mnB, alB);
    __syncthreads(); RESC(alB);
    finishSM(pB0, pB1, alB, l_reg, pa0, pa1, pa2, pa3); SBAR();
    pv_d0(o, vb0 + (int)SHM_V, pa0, pa1, pa2, pa3);
    if constexpr (XP) {
        static_assert(!XP || (SD == 1 && C::PE && C::NDR == 8 && C::ND == 12), "cross-unit prefetch is written for the MLA configuration");
        {
            int t2 = tid; asm volatile("" : "+v"(t2));
            const int w2 = t2 >> 6, l2 = t2 & 63, sr2 = t2 >> 4, sc2 = (t2 & 15) * 8, pr2 = t2 >> 3, pc2 = (t2 & 7) * 8;
            const bf16_t* nQw = nxt.Q + (long)(w2 * 32 + (l2 & 31)) * C::LDQ + (l2 >> 5) * 8;
#pragma unroll
            for (int d0 = 0; d0 < C::NDR; ++d0) pre->q[d0] = *reinterpret_cast<const bf16x8*>(nQw + d0 * 16);
#pragma unroll
            for (int d1 = 0; d1 < C::ND - C::NDR; ++d1) pre->qp[d1] = *reinterpret_cast<const u32x4*>(nQw + (C::NDR + d1) * 16);
            pre->vs0 = *reinterpret_cast<const bf16x8*>(&nxt.V[(long)sr2 * C::LDV + sc2]); pre->vs1 = *reinterpret_cast<const bf16x8*>(&nxt.V[(long)(32 + sr2) * C::LDV + sc2]);
            pre->ks0 = *reinterpret_cast<const bf16x8*>(&nxt.K[(long)sr2 * C::LDK + sc2]); pre->ks1 = *reinterpret_cast<const bf16x8*>(&nxt.K[(long)(32 + sr2) * C::LDK + sc2]);
            pre->ps = *reinterpret_cast<const bf16x8*>(&nxt.P[(long)pr2 * 64 + pc2]);
        }
    }
    if (hi == 0) li_l[r32] = l_reg; asm volatile("s_waitcnt lgkmcnt(0)" ::: "memory");
    float rli[16];
#pragma unroll
    for (int r = 0; r < 16; ++r) rli[r] = __builtin_amdgcn_rcpf(li_l[crow(r, hi)]);
    __builtin_amdgcn_s_setprio(0);
    __syncthreads();
    int te = tid; asm volatile("" : "+v"(te));
    const int lane_e = te & 63, r32e = te & 31, hie = (te >> 5) & 1;
    char* Ost = lds + (te >> 6) * 8192;
#pragma unroll
    for (int r = 0; r < 16; ++r)
#pragma unroll
        for (int d0 = 0; d0 < 4; ++d0) *(bf16_t*)(Ost + crow(r, hie) * 256 + (d0 * 32 + r32e) * 2) = (bf16_t)(cvt_pk_bf16(o[d0][r] * rli[r], 0.f) & 0xffffu);
    asm volatile("s_waitcnt lgkmcnt(0)" ::: "memory");
#pragma unroll
    for (int i = 0; i < 8; ++i) { const int ch = i * 64 + lane_e; const int row = ch >> 4, c8 = ch & 15;
        float ov[8], gvv[8]; unpack8(*(const u32x4*)(Ost + row * 256 + c8 * 16), ov); unpack8(gq[i], gvv);
#pragma unroll
        for (int e = 0; e < 8; ++e) ov[e] *= silu_f(gvv[e]);
        *(u32x4*)(Ow + (unsigned)(row * C::LDO * 2 + c8 * 16)) = pack8(ov); if constexpr (XP) SBAR(); }
#undef SLOAD
#undef GAS
#undef SWRITE
#undef SWAIT
#undef RESC
}

constexpr int SLOT_BYTES = 18688;
#define LFENCE() asm volatile("s_waitcnt lgkmcnt(0)" ::: "memory")
#ifdef USE_LF2
#define LF2() __builtin_amdgcn_sched_barrier(0)
#else
#define LF2() do {} while (0)
#endif
__device__ __forceinline__ float ldf(const float* base, unsigned boff) { return *(const float*)((const char*)base + boff); }
__device__ __forceinline__ void stf(float* base, unsigned boff, float v) { *(float*)((char*)base + boff) = v; }
struct Chain { const bf16_t* Rb; const bf16_t* KKb; const bf16_t* Vb; const bf16_t* Wd; const bf16_t* Ad; const bf16_t* Kb; bf16_t* Yd; float k_a; int row0, T, h, d; };
__device__ __forceinline__ unsigned chain_eoff(const Chain& c, int step, int col) { const int row = c.row0 + (c.d ? c.T - 1 - step : step); return ((unsigned)row * (unsigned)AW + (unsigned)col) * 4u; }

struct ScanOps { float w[16], ka[16], b[16], k[16], r[16], v[16]; };
struct ScanStage { u32x4 st[6][2]; };
__device__ __forceinline__ void scanA_issue(const Chain& c, int chunk, int lane_, ScanStage& g) {
    int lane = lane_; asm volatile("" : "+v"(lane));
    const bf16_t* arr[6] = {c.Wd, c.KKb, c.Ad, c.Kb, c.Rb, c.Vb};
#pragma unroll
    for (int k2 = 0; k2 < 2; ++k2) { const int idx = lane + 64 * k2, tau = idx >> 3, q = idx & 7; const int step = chunk * 16 + tau;
        const int row = c.row0 + (c.d ? c.T - 1 - step : step); const unsigned boff = ((unsigned)row * (unsigned)AW + (unsigned)(c.h * 64 + q * 8)) * 2u;
#pragma unroll
        for (int a = 0; a < 6; ++a) g.st[a][k2] = *(const u32x4*)((const char*)arr[a] + boff); }
}
__device__ __forceinline__ void scanA_unpack(const ScanStage& g, int lane_, char* slot, ScanOps& o) {
    int lane = lane_; asm volatile("" : "+v"(lane));
#pragma unroll
    for (int k2 = 0; k2 < 2; ++k2) { const int idx = lane + 64 * k2;
#pragma unroll
        for (int a = 0; a < 6; ++a) *(u32x4*)(slot + a * 2048 + idx * 16) = g.st[a][k2]; }
    asm volatile("s_waitcnt lgkmcnt(0)" ::: "memory");
#pragma unroll
    for (int t = 0; t < 16; ++t) { const char* e = slot + t * 128 + lane * 2;
        o.w[t] = bf2f(*(const bf16_t*)(e)); o.ka[t] = bf2f(*(const bf16_t*)(e + 2048)); o.b[t] = bf2f(*(const bf16_t*)(e + 4096));
        o.k[t] = bf2f(*(const bf16_t*)(e + 6144)); o.r[t] = bf2f(*(const bf16_t*)(e + 8192)); o.v[t] = bf2f(*(const bf16_t*)(e + 10240)); }
    asm volatile("s_waitcnt lgkmcnt(0)" ::: "memory");
}
__device__ __forceinline__ void scanA(const Chain& c, int chunk, const ScanOps& o, int lane_, char* slot) {
    int lane = lane_; asm volatile("" : "+v"(lane));
    float bt[16], kq[16]; float gL;
    float vv[16];
#pragma unroll
    for (int t = 0; t < 16; ++t) vv[t] = o.v[t];
    {
        float kt[16], rt[16]; float g = 1.0f;
        float cu = 0.f;
#pragma unroll
        for (int t = 0; t < 16; ++t) { const float gp = g; cu += o.w[t]; g = __builtin_amdgcn_exp2f(cu); const float ig = __builtin_amdgcn_exp2f(-cu);
            const float av = o.b[t], bb = o.ka[t] * av, kd = o.k[t] * (1.0f + (av - 1.0f) * c.k_a);
            kt[t] = o.ka[t] * gp; rt[t] = o.r[t] * g; bt[t] = bb * ig; kq[t] = kd * ig; }
        gL = g;
#pragma unroll
        for (int t = 0; t < 16; ++t) {
            const int o0 = t * 128 + ((lane * 2) ^ ((t & 7) << 4)), o1 = (16 + t) * 128 + ((lane * 2) ^ ((t & 7) << 4));
            *(bf16_t*)(slot + o0) = (bf16_t)(cvt_pk_bf16(bt[t], 0.f) & 0xffffu); *(bf16_t*)(slot + o1) = (bf16_t)(cvt_pk_bf16(kq[t], 0.f) & 0xffffu);
            *(bf16_t*)(slot + 8192 + o0) = (bf16_t)(cvt_pk_bf16(kt[t], 0.f) & 0xffffu); *(bf16_t*)(slot + 8192 + o1) = (bf16_t)(cvt_pk_bf16(rt[t], 0.f) & 0xffffu);
        }
#pragma unroll
        for (int q = 0; q < 2; ++q) {
            *(u32x4*)(slot + 12544 + lane * 64 + 16 * q) = (u32x4){cvt_pk_bf16(kt[8 * q], kt[8 * q + 1]), cvt_pk_bf16(kt[8 * q + 2], kt[8 * q + 3]), cvt_pk_bf16(kt[8 * q + 4], kt[8 * q + 5]), cvt_pk_bf16(kt[8 * q + 6], kt[8 * q + 7])};
            *(u32x4*)(slot + 12544 + lane * 64 + 32 + 16 * q) = (u32x4){cvt_pk_bf16(rt[8 * q], rt[8 * q + 1]), cvt_pk_bf16(rt[8 * q + 2], rt[8 * q + 3]), cvt_pk_bf16(rt[8 * q + 4], rt[8 * q + 5]), cvt_pk_bf16(rt[8 * q + 6], rt[8 * q + 7])};
        }

        *(float*)(slot + 12288 + lane * 4) = gL;
    }
    LFENCE();
    const int m = lane & 31, hi = lane >> 5;
    {
        f32x16 C = {};
#pragma unroll
        for (int ks = 0; ks < 4; ++ks) { const int o = m * 128 + (((2 * ks + hi) ^ (m & 7)) << 4);
            const bf16x8 a = *(const bf16x8*)(slot + o), b = *(const bf16x8*)(slot + 8192 + o);
            C = __builtin_amdgcn_mfma_f32_32x32x16_bf16(a, b, C, 0, 0, 0); }
        LFENCE();
#pragma unroll
        for (int r = 0; r < 16; ++r) *(float*)(slot + (crow(r, hi) * 32 + m) * 4) = C[r];
    }
    LFENCE();
    const float* G = (const float*)slot; float* Tm = (float*)(slot + 8192); float* Wm = (float*)(slot + 6144);
    char* B1T = slot + 9216; char* B2T = slot + 11264;
    {
        const int tcol = lane & 15, sq = lane >> 4;
        float Tc[16];
#pragma unroll
        for (int s = 0; s < 16; ++s) Tc[s] = (s == tcol) ? 1.0f : 0.0f;
#pragma unroll
        for (int s = 14; s >= 0; --s) {
            float a = 0.f;
#pragma unroll
            for (int q = (s + 1) / 4; q < 4; ++q) { const f32x4 gr = *(const f32x4*)(G + s * 32 + 4 * q);
#pragma unroll
                for (int e = 0; e < 4; ++e) if (4 * q + e > s) a += gr[e] * Tc[4 * q + e]; }
            if (s < tcol) Tc[s] = -a;
        }
        if (lane < 16) {
#pragma unroll
            for (int s = 0; s < 16; ++s) Tm[s * 16 + tcol] = Tc[s];
            const u32x4 z4 = (u32x4){0u, 0u, 0u, 0u};
            *(u32x4*)(B1T + tcol * 64) = (u32x4){cvt_pk_bf16(Tc[0], Tc[1]), cvt_pk_bf16(Tc[2], Tc[3]), cvt_pk_bf16(Tc[4], Tc[5]), cvt_pk_bf16(Tc[6], Tc[7])};
            *(u32x4*)(B1T + tcol * 64 + 16) = (u32x4){cvt_pk_bf16(Tc[8], Tc[9]), cvt_pk_bf16(Tc[10], Tc[11]), cvt_pk_bf16(Tc[12], Tc[13]), cvt_pk_bf16(Tc[14], Tc[15])};
            *(u32x4*)(B1T + tcol * 64 + 32) = z4; *(u32x4*)(B1T + tcol * 64 + 48) = z4;
            const unsigned one = (tcol & 1) ? 0x3F800000u : 0x00003F80u; const int wi = tcol >> 1;
            *(u32x4*)(B1T + (16 + tcol) * 64 + 32) = (u32x4){wi == 0 ? one : 0u, wi == 1 ? one : 0u, wi == 2 ? one : 0u, wi == 3 ? one : 0u};
            *(u32x4*)(B1T + (16 + tcol) * 64 + 48) = (u32x4){wi == 4 ? one : 0u, wi == 5 ? one : 0u, wi == 6 ? one : 0u, wi == 7 ? one : 0u};
        }
        float Wv[4];
#pragma unroll
        for (int si = 0; si < 4; ++si) { const int s = 4 * sq + si; float a = 0.f;
#pragma unroll
            for (int q = 0; q < 4; ++q) { const f32x4 gr = *(const f32x4*)(G + (16 + s) * 32 + 4 * q);
#pragma unroll
                for (int e = 0; e < 4; ++e) a += ((4 * q + e > s) ? gr[e] : 0.f) * Tc[4 * q + e]; }
            Wv[si] = a; Wm[s * 16 + tcol] = a; }
        *(u32x2*)(B2T + tcol * 32 + 8 * sq) = (u32x2){cvt_pk_bf16(Wv[0], Wv[1]), cvt_pk_bf16(Wv[2], Wv[3])};
        LFENCE();
        float nb[16];
#pragma unroll
        for (int u = 0; u < 16; ++u) { const float x = G[u * 32 + 16 + tcol]; nb[u] = (u <= tcol) ? x : 0.f; }
        float Zv[4], Nv[4];
#pragma unroll
        for (int si = 0; si < 4; ++si) { const int s = 4 * sq + si; const float nk = G[(16 + s) * 32 + 16 + tcol]; float a = (s <= tcol) ? nk : 0.f; float tn = 0.f;
#pragma unroll
            for (int q = 0; q < 4; ++q) { const f32x4 wr = *(const f32x4*)(Wm + s * 16 + 4 * q); const f32x4 tr = *(const f32x4*)(Tm + s * 16 + 4 * q);
#pragma unroll
                for (int e = 0; e < 4; ++e) { a -= wr[e] * nb[4 * q + e]; tn += tr[e] * nb[4 * q + e]; } }
            Zv[si] = a; Nv[si] = -tn; }
        *(u32x2*)(B2T + (16 + tcol) * 32 + 8 * sq) = (u32x2){cvt_pk_bf16(Zv[0], Zv[1]), cvt_pk_bf16(Zv[2], Zv[3])};
        *(u32x2*)(B1T + (16 + tcol) * 64 + 8 * sq) = (u32x2){cvt_pk_bf16(Nv[0], Nv[1]), cvt_pk_bf16(Nv[2], Nv[3])};
    }
    LFENCE();
    {
        f32x16 C0 = {}, C1 = {};
#pragma unroll
        for (int ks = 0; ks < 2; ++ks) { const bf16x8 b = *(const bf16x8*)(B1T + m * 64 + (16 * ks + 8 * hi) * 2);
            C0 = __builtin_amdgcn_mfma_f32_32x32x16_bf16(*(const bf16x8*)(slot + 12544 + m * 64 + (16 * ks + 8 * hi) * 2), b, C0, 0, 0, 0);
            C1 = __builtin_amdgcn_mfma_f32_32x32x16_bf16(*(const bf16x8*)(slot + 12544 + (32 + m) * 64 + (16 * ks + 8 * hi) * 2), b, C1, 0, 0, 0); }
        LFENCE();
        const int tile = m >> 4, t = m & 15;
#pragma unroll
        for (int half = 0; half < 2; ++half) { const int gq = 2 * half + hi;
            *(u32x4*)(slot + ((tile * 2 + 0) * 64 + t + 16 * gq) * 16) = (u32x4){cvt_pk_bf16(C0[4 * half], C0[4 * half + 1]), cvt_pk_bf16(C0[4 * half + 2], C0[4 * half + 3]),
                                                                             cvt_pk_bf16(C0[4 * half + 8], C0[4 * half + 9]), cvt_pk_bf16(C0[4 * half + 10], C0[4 * half + 11])};
            *(u32x4*)(slot + ((tile * 2 + 1) * 64 + t + 16 * gq) * 16) = (u32x4){cvt_pk_bf16(C1[4 * half], C1[4 * half + 1]), cvt_pk_bf16(C1[4 * half + 2], C1[4 * half + 3]),
                                                                             cvt_pk_bf16(C1[4 * half + 8], C1[4 * half + 9]), cvt_pk_bf16(C1[4 * half + 10], C1[4 * half + 11])}; }
    }
#pragma unroll
    for (int q = 0; q < 2; ++q)
        *(u32x4*)(slot + 16640 + lane * 32 + 16 * q) = (u32x4){cvt_pk_bf16(vv[8 * q], vv[8 * q + 1]), cvt_pk_bf16(vv[8 * q + 2], vv[8 * q + 3]), cvt_pk_bf16(vv[8 * q + 4], vv[8 * q + 5]), cvt_pk_bf16(vv[8 * q + 6], vv[8 * q + 7])};
    LFENCE();
    {
        const bf16x8 b = *(const bf16x8*)(B2T + m * 32 + 8 * hi * 2);
        const f32x16 z16 = {};
        const f32x16 C0 = __builtin_amdgcn_mfma_f32_32x32x16_bf16(*(const bf16x8*)(slot + 16640 + m * 32 + 8 * hi * 2), b, z16, 0, 0, 0);
        const f32x16 C1 = __builtin_amdgcn_mfma_f32_32x32x16_bf16(*(const bf16x8*)(slot + 16640 + (32 + m) * 32 + 8 * hi * 2), b, z16, 0, 0, 0);
        LFENCE();
        char* dst = slot + (m < 16 ? 8192 : 12544) + (m & 15) * 4;
#pragma unroll
        for (int r = 0; r < 16; ++r) { *(float*)(dst + crow(r, hi) * 64) = C0[r]; *(float*)(dst + (32 + crow(r, hi)) * 64) = C1[r]; }
    }
#pragma unroll
    for (int g4 = 0; g4 < 4; ++g4) {
        u32x4 w; w.x = cvt_pk_bf16(kq[4 * g4] * gL, kq[4 * g4 + 1] * gL); w.y = cvt_pk_bf16(kq[4 * g4 + 2] * gL, kq[4 * g4 + 3] * gL);
        w.z = cvt_pk_bf16(-bt[4 * g4] * gL, -bt[4 * g4 + 1] * gL); w.w = cvt_pk_bf16(-bt[4 * g4 + 2] * gL, -bt[4 * g4 + 3] * gL);
        *(u32x4*)(slot + 4096 + ((lane >> 4) * 64 + (lane & 15) + 16 * g4) * 16) = w;
    }
}

__device__ __forceinline__ void scanB(const Chain& c, int chunk, int lane_, int sl, const char* slot, f32x4 (&acc)[4]) {
    int lane = lane_; asm volatile("" : "+v"(lane));
    const int n = lane & 15, g = lane >> 4; const int col = c.h * 64 + 16 * sl + n;
    unsigned offs[4]; const int estride = c.d ? -AW * 4 : AW * 4; const unsigned e0 = chain_eoff(c, chunk * 16 + 4 * g, col);
#pragma unroll
    for (int e = 0; e < 4; ++e) offs[e] = e0 + (unsigned)(e * estride);
    const u32x2 vq2 = *(const u32x2*)(slot + 16640 + (16 * sl + n) * 32 + 8 * g);

    bf16x8 bfr[2];
#pragma unroll
    for (int s = 0; s < 2; ++s) { u32x4 w; w.x = cvt_pk_bf16(acc[2 * s][0], acc[2 * s][1]); w.y = cvt_pk_bf16(acc[2 * s][2], acc[2 * s][3]);
        w.z = cvt_pk_bf16(acc[2 * s + 1][0], acc[2 * s + 1][1]); w.w = cvt_pk_bf16(acc[2 * s + 1][2], acc[2 * s + 1][3]); bfr[s] = *reinterpret_cast<bf16x8*>(&w); }
    f32x4 aU = *(const f32x4*)(slot + 8192 + (16 * sl + n) * 64 + 16 * g);
    f32x4 aY = *(const f32x4*)(slot + 12544 + (16 * sl + n) * 64 + 16 * g);
#pragma unroll
    for (int s = 0; s < 2; ++s) {
        aU = __builtin_amdgcn_mfma_f32_16x16x32_bf16(*(const bf16x8*)(slot + ((0 * 2 + s) * 64 + lane) * 16), bfr[s], aU, 0, 0, 0);
        aY = __builtin_amdgcn_mfma_f32_16x16x32_bf16(*(const bf16x8*)(slot + ((1 * 2 + s) * 64 + lane) * 16), bfr[s], aY, 0, 0, 0);
    }
#pragma unroll
    for (int e = 0; e < 4; ++e) *(bf16_t*)((char*)c.Yd + (offs[e] >> 1)) = (bf16_t)(cvt_pk_bf16(aY[e], 0.f) & 0xffffu);
    bf16x8 b2; { u32x4 w; w.x = vq2.x; w.y = vq2.y; w.z = cvt_pk_bf16(aU[0], aU[1]); w.w = cvt_pk_bf16(aU[2], aU[3]); b2 = *reinterpret_cast<bf16x8*>(&w); }
#pragma unroll
    for (int tl = 0; tl < 4; ++tl) { const f32x4 gm = *(const f32x4*)(slot + 12288 + (16 * tl + 4 * g) * 4);
        acc[tl] = __builtin_amdgcn_mfma_f32_16x16x32_bf16(*(const bf16x8*)(slot + 4096 + (tl * 64 + lane) * 16), b2, acc[tl] * gm, 0, 0, 0); }
}

__device__ __forceinline__ void scan_pair(KP p, bool samp, int q, char* lds) {
    int tid_ = TIDX; asm volatile("" : "+v"(tid_));
    const int lane = tid_ & 63, wave = __builtin_amdgcn_readfirstlane(tid_ >> 6), grp = wave >> 2, sl = wave & 3;
    unsigned char* ws = p->ws;
    const int ci = 2 * q + grp, b = ci >> 6, h = (ci >> 1) & 31, d = ci & 1;
    Chain c; c.Rb = (const bf16_t*)(ws + WS_R); c.KKb = (const bf16_t*)(p->out + OUT_Y); c.Vb = (const bf16_t*)(p->out + OUT_Y + (size_t)NT * AW);
    c.Wd = (const bf16_t*)(ws + WS_WD + (size_t)d * 2 * SZA); c.Ad = (const bf16_t*)(ws + WS_WD + (size_t)d * 2 * SZA + SZA); c.Kb = (const bf16_t*)(ws + WS_K); c.k_a = p->in[I_KA][h * 64 + lane];
    c.Yd = (bf16_t*)(ws + WS_YA + (size_t)d * SZA); c.T = samp ? 2048 : 256; c.row0 = samp ? NP + b * 2048 : b * 256; c.h = h; c.d = d;
    const int n = lane & 15, g = lane >> 4;
    f32x4 acc[4];
    if (samp) { const float* s0 = p->in[I_STATE] + ((size_t)((b * 2 + d) * 32 + h)) * 4096 + (16 * sl + n) * 64 + 4 * g;
#pragma unroll
        for (int tl = 0; tl < 4; ++tl) acc[tl] = *(const f32x4*)(s0 + 16 * tl); }
    else {
#pragma unroll
        for (int tl = 0; tl < 4; ++tl) acc[tl] = (f32x4){0.f, 0.f, 0.f, 0.f}; }
    char* slots = lds + grp * 4 * SLOT_BYTES;
    const int NR = c.T / 64;
    ScanStage stg; scanA_issue(c, sl, lane, stg);
    for (int R = 0; R < NR; ++R) {
        { ScanOps ops; scanA_unpack(stg, lane, slots + sl * SLOT_BYTES, ops);
          if (R + 1 < NR) scanA_issue(c, 4 * (R + 1) + sl, lane, stg);
          scanA(c, 4 * R + sl, ops, lane, slots + sl * SLOT_BYTES); }
        asm volatile("s_waitcnt lgkmcnt(0)" ::: "memory"); __builtin_amdgcn_s_barrier(); asm volatile("" ::: "memory");
#pragma unroll
        for (int cc = 0; cc < 4; ++cc) scanB(c, 4 * R + cc, lane, sl, slots + cc * SLOT_BYTES, acc);
        asm volatile("s_waitcnt lgkmcnt(0)" ::: "memory"); __builtin_amdgcn_s_barrier(); asm volatile("" ::: "memory");
    }
    if (!samp) { float* so = p->out + OUT_STATE + ((size_t)((b * 2 + d) * 32 + h)) * 4096 + (16 * sl + n) * 64 + 4 * g;
#pragma unroll
        for (int tl = 0; tl < 4; ++tl) *(f32x4*)(so + 16 * tl) = acc[tl]; }
}

__device__ __forceinline__ void phase_scan_attn(KP p, char* lds) {
    unsigned char* ws = p->ws;
    unsigned* qhead = (unsigned*)(ws + WS_CTL) + 4096;
    bf16_t* projB = (bf16_t*)(ws + WS_PROJB); bf16_t* mixed = (bf16_t*)(ws + WS_MIXED);
#ifdef STATIC_Q
    for (int item = blockIdx.x; item < 1408; item += gridDim.x) {
        __syncthreads();
#else
    for (;;) {
        unsigned qa = LDS_X + 64; asm volatile("" : "+s"(qa));
        volatile LAS unsigned* qslot = (volatile LAS unsigned*)(LAS char*)(uintptr_t)qa;
        __syncthreads();
        if (TIDX == 0) *qslot = __hip_atomic_fetch_add(qhead, 1u, __ATOMIC_RELAXED, __HIP_MEMORY_SCOPE_AGENT);
        __syncthreads();
        const int item = (int)__builtin_amdgcn_readfirstlane(*qslot);
        if (item >= 1408) break;
#endif
#ifndef Q_NO_SCAN
        if (item < 128) scan_pair(p, true, item, lds); else
#endif
#ifndef Q_NO_ATTN
        if (item < 640) { const int su = item - 128;
            const int b = su >> 7, h = (su >> 3) & 15, qb = su & 7; const size_t row0 = (size_t)NP + b * 2048 + qb * 256; const size_t k0 = ((size_t)b * 2304) * 512 + (h >> 2) * 128;
            attn_body<CfgGqa>(projB + row0 * N1B + 2048 + h * 128, (const bf16_t*)(ws + WS_KBS) + k0, (const bf16_t*)(ws + WS_VBS) + k0, nullptr,
                              mixed + row0 * DM + 2048 + h * 128, projB + row0 * N1B + 5120 + h * 128, 2304, lds, (const float*)(ws + WS_ROPEB_COS), (const float*)(ws + WS_ROPEB_SIN), qb * 256, p->in[I_QG]); }
        else
#endif
#ifndef Q_NO_SCAN
        if (item < 1152) scan_pair(p, false, item - 640, lds); else
#endif
#ifndef Q_NO_ATTN
        { const int pu = item - 1152;
            const int b = pu >> 4, h = pu & 15; const size_t row0 = (size_t)b * 256; const size_t k0 = row0 * 512 + (h >> 2) * 128;
            attn_body<CfgGqa>(projB + row0 * N1B + 2048 + h * 128, (const bf16_t*)(ws + WS_KBP) + k0, (const bf16_t*)(ws + WS_VBP) + k0, nullptr,
                              mixed + row0 * DM + 2048 + h * 128, projB + row0 * N1B + 5120 + h * 128, 256, lds, nullptr, nullptr, 0, p->in[I_QG]); }
#else
        {}
#endif
    }
}

__device__ __forceinline__ void phase_mix(KP p) {
    unsigned char* ws = p->ws;
    const int lane = TIDX & 63, wave = TIDX >> 6, gw = blockIdx.x * 8 + wave, nw = gridDim.x * 8;
    const bf16_t* Y0 = (const bf16_t*)(ws + WS_YA); const bf16_t* Y1 = (const bf16_t*)(ws + WS_YA + SZA);
    const bf16_t* Rb = (const bf16_t*)(ws + WS_R); const bf16_t* Vb = (const bf16_t*)(p->out + OUT_Y + (size_t)NT * AW);
    const bf16_t* A0 = (const bf16_t*)(ws + WS_WD + SZA); const bf16_t* A1 = (const bf16_t*)(ws + WS_WD + 3 * SZA); const bf16_t* Kb = (const bf16_t*)(ws + WS_K); const float* k_a = p->in[I_KA];
    const bf16_t* projB = (const bf16_t*)(ws + WS_PROJB); bf16_t* mixed = (bf16_t*)(ws + WS_MIXED);
    const float* lnw = p->in[I_LNW]; const float* lnb = p->in[I_LNB]; const float* rk = p->in[I_RK];
    for (int row = gw; row < NT; row += nw) {
#pragma unroll
      for (int hh = 0; hh < 2; ++hh) {
        u32x4 qy0[4], qy1[4], qr[4], qk[4], qa0[4], qa1[4], qv[4], qg[4];
#pragma unroll
        for (int it = 2 * hh; it < 2 * hh + 2; ++it) { const int col = (lane + 64 * it) * 8; const size_t o = (size_t)row * AW + col;
            qy0[it] = *(const u32x4*)(Y0 + o); qy1[it] = *(const u32x4*)(Y1 + o); qr[it] = *(const u32x4*)(Rb + o); qk[it] = *(const u32x4*)(Kb + o);
            qa0[it] = *(const u32x4*)(A0 + o); qa1[it] = *(const u32x4*)(A1 + o); qv[it] = *(const u32x4*)(Vb + o); qg[it] = *(const u32x4*)(projB + (size_t)row * N1B + col); }
#pragma unroll
        for (int it = 2 * hh; it < 2 * hh + 2; ++it) { const int col = (lane + 64 * it) * 8;
            float y[8], t1[8], t2[8];
            unpack8(qy0[it], y); unpack8(qy1[it], t1);
            float sm = 0.f;
#pragma unroll
            for (int e = 0; e < 8; ++e) { y[e] += t1[e]; sm += y[e]; }
            sm += __shfl_xor(sm, 1); sm += __shfl_xor(sm, 2); sm += __shfl_xor(sm, 4);
            const float mean = sm * (1.0f / 64.0f); float vs = 0.f;
#pragma unroll
            for (int e = 0; e < 8; ++e) { y[e] -= mean; vs += y[e] * y[e]; }
            vs += __shfl_xor(vs, 1); vs += __shfl_xor(vs, 2); vs += __shfl_xor(vs, 4);
            const float rs = rsqrtf(vs * (1.0f / 64.0f) + 64e-5f);
            float rr[8], kk8[8]; unpack8(qr[it], rr); unpack8(qk[it], kk8); unpack8(qa0[it], t1); unpack8(qa1[it], t2);
            const f32x4 ka0 = *(const f32x4*)(k_a + col), ka1 = *(const f32x4*)(k_a + col + 4), rk0 = *(const f32x4*)(rk + col), rk1 = *(const f32x4*)(rk + col + 4);
            float bs = 0.f;
#pragma unroll
            for (int e = 0; e < 8; ++e) { const float kav = e < 4 ? ka0[e & 3] : ka1[e & 3], rkv = e < 4 ? rk0[e & 3] : rk1[e & 3];
                bs += rr[e] * kk8[e] * ((t1[e] + t2[e] - 2.0f) * kav + 2.0f) * rkv; }
            bs += __shfl_xor(bs, 1); bs += __shfl_xor(bs, 2); bs += __shfl_xor(bs, 4);
            float vv8[8], gg[8], ov[8]; unpack8(qv[it], vv8); unpack8(qg[it], gg);
            const f32x4 lw0 = *(const f32x4*)(lnw + col), lw1 = *(const f32x4*)(lnw + col + 4), lb0 = *(const f32x4*)(lnb + col), lb1 = *(const f32x4*)(lnb + col + 4);
#pragma unroll
            for (int e = 0; e < 8; ++e) { const float lw = e < 4 ? lw0[e & 3] : lw1[e & 3], lb = e < 4 ? lb0[e & 3] : lb1[e & 3];
                ov[e] = (y[e] * rs * lw + lb + vv8[e] * bs) * silu_f(gg[e]); }
            *(u32x4*)(mixed + (size_t)row * DM + col) = pack8(ov);
        }
        asm volatile("" ::: "memory");
      }
    }
}

__device__ __forceinline__ void phase_prepC(KP p) {
    unsigned char* ws = p->ws;
    const int lane = TIDX & 63, wave = TIDX >> 6, gw = blockIdx.x * 8 + wave, nw = gridDim.x * 8;
    const bf16_t* projC = (const bf16_t*)(ws + WS_PROJC); bf16_t* qn = (bf16_t*)(ws + WS_QN); bf16_t* ckv = (bf16_t*)(ws + WS_CKV); bf16_t* kpe = (bf16_t*)(ws + WS_KPE);
    const float* cosC = (const float*)(ws + WS_ROPEC_COS); const float* sinC = (const float*)(ws + WS_ROPEC_SIN);
    const float* qag = p->in[I_QAG]; const float* kvag = p->in[I_KVAG];
    for (int row = gw; row < NT + 1024; row += nw) {
        if (row >= NT) {
            const int cr = row - NT, b = cr >> 8, t = cr & 255; const size_t krow = (size_t)NP + b * 2304 + t;
            { const float* s = p->in[I_CCKV] + (size_t)cr * 512 + lane * 8; const f32x4 a = *(const f32x4*)s, c = *(const f32x4*)(s + 4);
              *(u32x4*)(ckv + krow * 512 + lane * 8) = (u32x4){cvt_pk_bf16(a[0], a[1]), cvt_pk_bf16(a[2], a[3]), cvt_pk_bf16(c[0], c[1]), cvt_pk_bf16(c[2], c[3])}; }
            if (lane < 32) { const f32x2 a = *(const f32x2*)(p->in[I_CKPE] + (size_t)cr * 64 + lane * 2); *(unsigned*)(kpe + krow * 64 + lane * 2) = cvt_pk_bf16(a[0], a[1]); }
            continue;
        }
        const bool samp = row >= NP; int b = 0, t = 0; if (samp) { const int rr = row - NP; b = rr >> 11; t = rr & 2047; }
        const size_t krow = samp ? (size_t)NP + b * 2304 + 256 + t : (size_t)row;
        const u32x2* pc = (const u32x2*)(projC + (size_t)row * N3C);
        {
            f32x4 v[6]; float ss = 0.f;
#pragma unroll
            for (int i = 0; i < 6; ++i) { v[i] = up4(pc[lane + 64 * i]); ss += (v[i][0] * v[i][0] + v[i][1] * v[i][1]) + (v[i][2] * v[i][2] + v[i][3] * v[i][3]); }
            ss = wave_sum(ss); const float inv = rsqrtf(ss * (1.0f / 1536.0f) + 1e-6f);
#pragma unroll
            for (int i = 0; i < 6; ++i) { const int c4 = lane + 64 * i; const f32x4 o = v[i] * inv * ((const f32x4*)qag)[c4];
                u32x2 w; w.x = cvt_pk_bf16(o[0], o[1]); w.y = cvt_pk_bf16(o[2], o[3]); *(u32x2*)(qn + (size_t)row * 1536 + c4 * 4) = w; }
        }
        {
            f32x4 v[2]; float ss = 0.f;
#pragma unroll
            for (int i = 0; i < 2; ++i) { v[i] = up4(pc[384 + lane + 64 * i]); ss += (v[i][0] * v[i][0] + v[i][1] * v[i][1]) + (v[i][2] * v[i][2] + v[i][3] * v[i][3]); }
            ss = wave_sum(ss); const float inv = rsqrtf(ss * (1.0f / 512.0f) + 1e-6f);
#pragma unroll
            for (int i = 0; i < 2; ++i) { const int c4 = lane + 64 * i; const f32x4 o = v[i] * inv * ((const f32x4*)kvag)[c4];
                u32x2 w; w.x = cvt_pk_bf16(o[0], o[1]); w.y = cvt_pk_bf16(o[2], o[3]); *(u32x2*)(ckv + krow * 512 + c4 * 4) = w;
                if (!samp) *(f32x4*)(p->out + OUT_CKV + (size_t)row * 512 + c4 * 4) = o; }
        }
        if (lane < 32) {
            const unsigned xw = *(const unsigned*)(projC + (size_t)row * N3C + 2048 + lane * 2); const f32x2 x = (f32x2){bf_lo(xw), bf_hi(xw)}; f32x2 o = x;
            if (samp) { const float c = cosC[t * 32 + lane], s = sinC[t * 32 + lane]; o[0] = x[0] * c - x[1] * s; o[1] = x[0] * s + x[1] * c; }
            else *(f32x2*)(p->out + OUT_KPE + (size_t)row * 64 + lane * 2) = x;
            *(unsigned*)(kpe + krow * 64 + lane * 2) = cvt_pk_bf16(o[0], o[1]);
        }
    }
}

__device__ __forceinline__ void phase_mla_attn(KP p, char* lds) {
    unsigned char* ws = p->ws; const int G = gridDim.x, bid = blockIdx.x;
    const bf16_t* q = (const bf16_t*)(ws + WS_Q); const bf16_t* kv = (const bf16_t*)(ws + WS_KV); const bf16_t* kpe = (const bf16_t*)(ws + WS_KPE);
    bf16_t* og = (bf16_t*)(ws + WS_OG); const bf16_t* gate = (const bf16_t*)(ws + WS_GATEB);
    const int vcu = (G % 8 == 0) ? (bid % 8) * (G / 8) + bid / 8 : bid;
    const int nS = vcu < 2048 ? (2048 - vcu + G - 1) / G : 0, nP = vcu < 1024 ? (1024 - vcu + G - 1) / G : 0;
    AttnPre pre; bool have = false;
    for (int i = 0; i < nS + nP; ++i) {
        const bf16_t *Qb, *Kb, *Vb, *Pb, *Gb; bf16_t* Ob; int seq, t0; const float *rc, *rs;
        AttnNext nx; nx.valid = (i + 1 < nS + nP);
        {   const int j = i;
            if (j < nS) { const int su = vcu + j * G; const int b = su >> 9, h = (su >> 3) & 63, qb = su & 7; const size_t row0 = (size_t)NP + b * 2048 + qb * 256, kr0 = (size_t)NP + b * 2304;
                Qb = q + row0 * 12288 + h * 192; Kb = kv + kr0 * 16384 + h * 256; Vb = Kb + 128; Pb = kpe + kr0 * 64; Ob = og + row0 * 8192 + h * 128; Gb = gate + row0 * 8192 + h * 128;
                seq = 2304; t0 = qb * 256; rc = (const float*)(ws + WS_ROPEC_COS); rs = (const float*)(ws + WS_ROPEC_SIN); }
            else { const int pu = vcu + (j - nS) * G; const int b = pu >> 6, h = pu & 63; const size_t row0 = (size_t)b * 256;
                Qb = q + row0 * 12288 + h * 192; Kb = kv + row0 * 16384 + h * 256; Vb = Kb + 128; Pb = kpe + row0 * 64; Ob = og + row0 * 8192 + h * 128; Gb = gate + row0 * 8192 + h * 128;
                seq = 256; t0 = 0; rc = nullptr; rs = nullptr; } }
        {   const int j = nx.valid ? i + 1 : i;
            if (j < nS) { const int su = vcu + j * G; const int b = su >> 9, h = (su >> 3) & 63, qb = su & 7; const size_t row0 = (size_t)NP + b * 2048 + qb * 256, kr0 = (size_t)NP + b * 2304;
                nx.Q = q + row0 * 12288 + h * 192; nx.K = kv + kr0 * 16384 + h * 256; nx.V = nx.K + 128; nx.P = kpe + kr0 * 64; }
            else { const int pu = vcu + (j - nS) * G; const int b = pu >> 6, h = pu & 63; const size_t row0 = (size_t)b * 256;
                nx.Q = q + row0 * 12288 + h * 192; nx.K = kv + row0 * 16384 + h * 256; nx.V = nx.K + 128; nx.P = kpe + row0 * 64; } }
        attn_body<CfgMla, true>(Qb, Kb, Vb, Pb, Ob, Gb, seq, lds, rc, rs, t0, nullptr, &pre, have, nx);
        have = nx.valid;
    }
}

__device__ __forceinline__ void phase_final(KP p) {
    const int lane = TIDX & 63, wave = TIDX >> 6, gw = blockIdx.x * 8 + wave, nw = gridDim.x * 8;
    const float* g = p->in[I_FINALG]; const bf16_t* x2 = (const bf16_t*)(p->ws + WS_Q);
    for (int row = gw; row < NT; row += nw) {
        const u32x2* x = (const u32x2*)(x2 + (size_t)row * DM); float* y = p->out + OUT_Y + (size_t)row * DM;
        f32x4 v[16]; float ss = 0.f;
#pragma unroll
        for (int i = 0; i < 16; ++i) { v[i] = up4(x[lane + 64 * i]); ss += v[i][0] * v[i][0] + v[i][1] * v[i][1] + v[i][2] * v[i][2] + v[i][3] * v[i][3]; }
        ss = wave_sum(ss);
        const float inv = rsqrtf(ss * (1.0f / 4096.0f) + 1e-6f);
#pragma unroll
        for (int i = 0; i < 16; ++i) { const int c4 = lane + 64 * i; ((f32x4*)y)[c4] = v[i] * inv * ((const f32x4*)g)[c4]; }
    }
}

__global__ void __launch_bounds__(512, 2) fwd(Params pv) {
    extern __shared__ __attribute__((aligned(16))) unsigned char lds[];
    LAS unsigned char* ldsl = (LAS unsigned char*)lds;
    volatile LAS unsigned* xbw = (volatile LAS unsigned*)(ldsl + LDS_X);
    if (threadIdx.x < 4) xbw[threadIdx.x] = 0u;
    if ((threadIdx.x & 63) == 0) *(volatile LAS unsigned*)(LAS char*)(uintptr_t)(TID_TAB_OFF + 4u * hw_wave_slot()) = threadIdx.x >> 6;
    __syncthreads();
    XcdBarrier bar; bar.bar = (unsigned*)(pv.ws + WS_CTL); bar.x = 0; bar.st = xbw;
    if (!MK_PER_PHASE) bar = xcd_barrier_post((unsigned*)(pv.ws + WS_CTL), xbw);
    const int lo = pv.ph_lo, hi = pv.ph_hi;
#ifndef PH_MASK
#define PH_MASK 0x7fff
#endif
#define IN(k) (((PH_MASK >> (k)) & 1) && lo <= (k) && (k) < hi)
#define SEAM(k) do { if (!MK_PER_PHASE && IN(k) && IN((k) + 1)) xcd_barrier(bar); } while (0)
#define PH_BEGIN KP p = get_params(); unsigned char* ws = p->ws; const int G = gridDim.x, bid = blockIdx.x; (void)ws; (void)G; (void)bid;

    if (IN(0)) { PH_BEGIN phase0(p, lds); } SEAM(0);
    if (IN(1)) { PH_BEGIN phase_h(p, 0, p->in[I_XP], p->in[I_XS], (bf16_t*)(ws + WS_H0)); } SEAM(1);
    if (IN(2)) { PH_BEGIN pg8::Gemm g{(const bf16_t*)(ws + WS_H0), (const bf16_t*)(ws + WS_WTA), NT, N1, DM}; pg8::StaticOrder S; S.init(NT, N1, G, bid);
        EpiG1 E{(bf16_t*)(ws + WS_PROJF), (bf16_t*)(ws + WS_PROJB)}; pg8::gemm_phase(ldsl, g, S, E);
        { const int extra = ((NT / 256) * (N1 / 256)) % G; if (bid >= extra) { phase_cvt1(p, lds, 0, G - extra, bid - extra); phase_cvt1(p, lds, 1, G - extra, bid - extra); } } } SEAM(2);
    if (IN(3)) { PH_BEGIN phase_prepA(p); } SEAM(3);
    if (IN(4)) { PH_BEGIN
#pragma unroll
        for (int d = 0; d < 2; ++d) {
            pg8::Gemm g{(const bf16_t*)(ws + WS_LORA) + (size_t)d * NT * 256, (const bf16_t*)(ws + WS_WTLORA) + (size_t)d * 4096 * 256, NT, 4096, 256}; pg8::StaticOrder S; S.init(NT, 4096, G, bid);
            EpiLora E{p->in[I_W0] + d * 2048, p->in[I_A0] + d * 2048, (bf16_t*)(ws + WS_WD + (size_t)d * 2 * SZA), (bf16_t*)(ws + WS_WD + (size_t)d * 2 * SZA + SZA)}; pg8::gemm_phase(ldsl, g, S, E);
        } } SEAM(4);
    if (IN(5)) { PH_BEGIN phase_scan_attn(p, (char*)lds); } SEAM(5);
    if (IN(6)) { PH_BEGIN phase_mix(p); } SEAM(6);
    if (IN(7)) { PH_BEGIN pg8::Gemm g{(const bf16_t*)(ws + WS_MIXED), (const bf16_t*)(ws + WS_WTOUT), NT, DM, DM}; pg8::StaticOrder S; S.init(NT, DM, G, bid);
        EpiRes<false> E{p->in[I_XP], p->in[I_XS], nullptr, (bf16_t*)(p->out + OUT_Y), (const float*)(ws + WS_MOD) + 8192}; pg8::gemm_phase(ldsl, g, S, E);
        } SEAM(7);
    if (IN(8)) { PH_BEGIN phase_h_bf(p, 1, (const bf16_t*)(p->out + OUT_Y), (bf16_t*)(ws + WS_H1)); } SEAM(8);
    if (IN(9)) { PH_BEGIN pg8::Gemm g{(const bf16_t*)(ws + WS_H1), (const bf16_t*)(ws + WS_WTC), NT, N3, DM}; pg8::StaticOrder S; S.init(NT, N3, G, bid);
        EpiG3 E{(bf16_t*)(ws + WS_GATEB), (bf16_t*)(ws + WS_PROJC)}; pg8::gemm_phase(ldsl, g, S, E);
        { const int extra = ((NT / 256) * (N3 / 256)) % G; if (extra != 0 && bid >= extra) phase_cvt1(p, lds, 2, G - extra, bid - extra); else if (extra == 0) phase_cvt1(p, lds, 2, G, bid); } } SEAM(9);
    if (IN(10)) { PH_BEGIN phase_prepC(p); } SEAM(10);
    if (IN(11)) { PH_BEGIN
        { pg8::Gemm g{(const bf16_t*)(ws + WS_QN), (const bf16_t*)(ws + WS_WTUQ), NT, 12288, 1536}; pg8::StaticOrder S; S.init(NT, 12288, G, bid);
          EpiBf16Plain E{(bf16_t*)(ws + WS_Q), 12288}; pg8::gemm_phase(ldsl, g, S, E); }
        { pg8::Gemm g{(const bf16_t*)(ws + WS_CKV), (const bf16_t*)(ws + WS_WTUKV), NKV, 16384, 512}; pg8::StaticOrder S; S.init(NKV, 16384, G, bid);
          EpiBf16Plain E{(bf16_t*)(ws + WS_KV), 16384}; pg8::gemm_phase(ldsl, g, S, E); }
    } SEAM(11);
    if (IN(12)) { PH_BEGIN phase_mla_attn(p, (char*)lds); } SEAM(12);
    if (IN(13)) { PH_BEGIN pg8::Gemm g{(const bf16_t*)(ws + WS_OG), (const bf16_t*)(ws + WS_WTCOUT), NT, DM, 8192}; pg8::StaticOrder S; S.init(NT, DM, G, bid);
        EpiRes<true> E{nullptr, nullptr, (const bf16_t*)(p->out + OUT_Y), (bf16_t*)(ws + WS_Q), (const float*)(ws + WS_MOD) + 5 * 12288 + 8192}; pg8::gemm_phase(ldsl, g, S, E); } SEAM(13);
    if (IN(14)) { PH_BEGIN phase_final(p); }
#undef IN
#undef SEAM
#undef PH_BEGIN
}

extern "C" void kernel_launch(void* const* d_in, const int* in_sizes, int n_in, void* d_out, int out_size, void* d_ws, size_t ws_size, hipStream_t stream) {
    static int grid = 0;
    if (grid == 0) {
        if (n_in != 33 || out_size != (int)OUT_TOTAL || ws_size < WS_NEED) { grid = -1; return; }
        int dev = 0, cus = 0;
        if (hipGetDevice(&dev) != hipSuccess || hipDeviceGetAttribute(&cus, hipDeviceAttributeMultiprocessorCount, dev) != hipSuccess) { grid = -1; return; }
        if (hipFuncSetAttribute((const void*)fwd, hipFuncAttributeMaxDynamicSharedMemorySize, LDS_BYTES) != hipSuccess) { grid = -1; return; }
        int per_cu = 0;
        if (hipOccupancyMaxActiveBlocksPerMultiprocessor(&per_cu, (const void*)fwd, 512, LDS_BYTES) != hipSuccess || per_cu < 1) { (void)hipGetLastError(); }
        grid = cus;
    }
    if (grid < 0) return;
    (void)hipMemsetAsync((char*)d_ws + WS_CTL, 0, 65536, stream);
    Params p{};
    for (int i = 0; i < 33; ++i) p.in[i] = (const float*)d_in[i];
    p.out = (float*)d_out; p.ws = (unsigned char*)d_ws;
#if MK_PER_PHASE
#ifndef PROBE_REP
#define PROBE_REP 0
#endif
    for (int k = 0; k < NPH; ++k) { p.ph_lo = k; p.ph_hi = k + 1; const int nrep = ((PROBE_REP >> k) & 1) ? 2 : 1;
        for (int r = 0; r < nrep; ++r) hipLaunchKernelGGL(fwd, dim3(grid), dim3(512), LDS_BYTES, stream, p); }
#else
    p.ph_lo = 0; p.ph_hi = NPH; hipLaunchKernelGGL(fwd, dim3(grid), dim3(512), LDS_BYTES, stream, p);
#endif
}
#ifdef TEST_ATTN
__global__ void __launch_bounds__(512, 2) t_attn(const bf16_t* Q, const bf16_t* K, const bf16_t* V, const bf16_t* P, bf16_t* O, const bf16_t* Gt, int seq) {
    extern __shared__ __attribute__((aligned(16))) unsigned char lds2[];
    attn_body<TEST_ATTN>(Q + (size_t)blockIdx.x * 256 * TEST_ATTN::LDQ, K, V, P, O + (size_t)blockIdx.x * 256 * TEST_ATTN::LDO, Gt + (size_t)blockIdx.x * 256 * TEST_ATTN::LDG, seq, (char*)lds2);
}
#endif
```

```cpp
#include <hip/hip_runtime.h>
#include <stdint.h>

#ifndef MK_PER_PHASE
#define MK_PER_PHASE 0
#endif

#define LAS __attribute__((address_space(3)))

#define TID_TAB_OFF (8 * 18688 + 128)
__device__ __forceinline__ int lane_id() { unsigned x; asm volatile("v_mbcnt_lo_u32_b32 %0, -1, 0\n\tv_mbcnt_hi_u32_b32 %0, -1, %0" : "=v"(x)); return (int)x; }
__device__ __forceinline__ unsigned hw_wave_slot() { return (unsigned)__builtin_amdgcn_s_getreg((5 << 11) | 4) & 63u; }
__device__ __forceinline__ int get_tid() {
    const unsigned w = *(const volatile LAS unsigned*)(LAS char*)(uintptr_t)(TID_TAB_OFF + 4u * hw_wave_slot());
    return (int)__builtin_amdgcn_readfirstlane(w) * 64 + lane_id();
}
#define TIDX get_tid()
typedef unsigned short bf16_t;
typedef short bf16x8 __attribute__((ext_vector_type(8)));
typedef short s16x4 __attribute__((ext_vector_type(4)));
typedef float f32x4 __attribute__((ext_vector_type(4)));
typedef float f32x2 __attribute__((ext_vector_type(2)));
typedef float f32x16 __attribute__((ext_vector_type(16)));
typedef unsigned u32x4 __attribute__((ext_vector_type(4)));
typedef unsigned u32x2 __attribute__((ext_vector_type(2)));

#define XB_TMO      128
#define XB_XCNT(j)  (256  + 64 * (j))
#define XB_XSUB(j)  (1280 + 64 * (j))
#define XB_XGEN(j)  (2304 + 64 * (j))
#define XB_TOP      3328
#define XB_TOPGEN   3392
#define XCD_BAR_WORDS 3456
#define XB_SPIN_CAP (1u << 22)

__device__ __forceinline__ unsigned xb_ld(unsigned* p)              { return __hip_atomic_load(p, __ATOMIC_RELAXED, __HIP_MEMORY_SCOPE_AGENT); }
__device__ __forceinline__ unsigned xb_add(unsigned* p, unsigned v) { return __hip_atomic_fetch_add(p, v, __ATOMIC_RELAXED, __HIP_MEMORY_SCOPE_AGENT); }
__device__ __forceinline__ unsigned xb_xcc_id() { return (unsigned)__builtin_amdgcn_s_getreg((3 << 11) | 20) & 0xFu; }
#define XB_SPIN(cond, bar) do { unsigned _sp = 0; while (cond) { __builtin_amdgcn_s_sleep(1); \
    if ((++_sp & 255u) == 0u) { if (xb_ld(&(bar)[XB_TMO])) break; if (_sp > XB_SPIN_CAP) { atomicAdd(&(bar)[XB_TMO], 1u); break; } } } } while (0)

struct XcdBarrier { unsigned* bar; unsigned x; volatile LAS unsigned* st; };

__device__ __forceinline__ XcdBarrier xcd_barrier_post(unsigned* bar, volatile LAS unsigned* st) {
    XcdBarrier b; b.bar = bar; b.x = xb_xcc_id(); b.st = st;
    if (TIDX == 0) (void)xb_add(&bar[XB_XCNT(b.x)], 1u);
    return b;
}
__device__ __forceinline__ void xcd_barrier_complete(unsigned* bar, unsigned x, unsigned& nloc, unsigned& nx) {
    const unsigned G = gridDim.x * gridDim.y * gridDim.z;
    unsigned sum, cnt, mine, sp = 0u;
    for (;;) {
        sum = 0u; cnt = 0u; mine = 0u;
#pragma unroll
        for (unsigned j = 0; j < 16; ++j) { const unsigned c = xb_ld(&bar[XB_XCNT(j)]); sum += c; cnt += (c > 0u) ? 1u : 0u; mine = (j == x) ? c : mine; }
        if (sum == G) break;
        __builtin_amdgcn_s_sleep(1);
        if ((++sp & 255u) == 0u) { if (xb_ld(&bar[XB_TMO])) break; if (sp > XB_SPIN_CAP) { atomicAdd(&bar[XB_TMO], 1u); break; } }
    }
    nloc = mine > 0u ? mine : 1u; nx = cnt > 0u ? cnt : 1u;
}
__device__ __forceinline__ void xcd_barrier(const XcdBarrier& b) {
    asm volatile("s_waitcnt vmcnt(0)" ::: "memory");
    __syncthreads();
    if (TIDX == 0) {
        unsigned* bar = b.bar;
        __builtin_amdgcn_s_waitcnt(0);
        unsigned nloc = b.st[0], nx = b.st[1];
        if (nloc == 0u) { xcd_barrier_complete(bar, b.x, nloc, nx); b.st[0] = nloc; b.st[1] = nx; }
        const unsigned old = xb_add(&bar[XB_XSUB(b.x)], 1u);
        const unsigned gen = old / nloc;
        if (old + 1u == (gen + 1u) * nloc) {
            __builtin_amdgcn_fence(__ATOMIC_RELEASE, "agent");
            asm volatile("s_waitcnt vmcnt(0)" ::: "memory");
            const unsigned og = xb_add(&bar[XB_TOP], 1u);
            const unsigned tg = og / nx;
            if (og + 1u == (tg + 1u) * nx) xb_add(&bar[XB_TOPGEN], 1u);
            else XB_SPIN(xb_ld(&bar[XB_TOPGEN]) == tg, bar);
            __builtin_amdgcn_fence(__ATOMIC_ACQUIRE, "agent");
            xb_add(&bar[XB_XGEN(b.x)], 1u);
            asm volatile("s_waitcnt vmcnt(0)" ::: "memory");
        } else {
            XB_SPIN(xb_ld(&bar[XB_XGEN(b.x)]) == gen, bar);
            __builtin_amdgcn_fence(__ATOMIC_ACQUIRE, "agent");
            asm volatile("s_waitcnt vmcnt(0)" ::: "memory");
        }
    }
    __syncthreads();
}

typedef __bf16 bf16v2 __attribute__((ext_vector_type(2)));
__device__ __forceinline__ unsigned cvt_pk_bf16(float lo, float hi) { f32x2 v = {lo, hi}; bf16v2 b = __builtin_convertvector(v, bf16v2); return __builtin_bit_cast(unsigned, b); }
__device__ __forceinline__ float bf_lo(unsigned w) { return __uint_as_float(w << 16); }
__device__ __forceinline__ float bf_hi(unsigned w) { return __uint_as_float(w & 0xffff0000u); }
__device__ __forceinline__ float bf2f(bf16_t b) { return __uint_as_float(((unsigned)b) << 16); }
__device__ __forceinline__ float ldh(const bf16_t* base, unsigned boff) { return bf2f(*(const bf16_t*)((const char*)base + boff)); }
__device__ __forceinline__ u32x2 pk4(const f32x4 v) { return (u32x2){cvt_pk_bf16(v[0], v[1]), cvt_pk_bf16(v[2], v[3])}; }
__device__ __forceinline__ f32x4 up4(const u32x2 w) { return (f32x4){bf_lo(w.x), bf_hi(w.x), bf_lo(w.y), bf_hi(w.y)}; }
__device__ __forceinline__ float sigmoid_f(float x) { return __builtin_amdgcn_rcpf(1.0f + __expf(-x)); }
__device__ __forceinline__ float silu_f(float x) { return x * __builtin_amdgcn_rcpf(1.0f + __expf(-x)); }
__device__ __forceinline__ float wave_sum(float v) {
#pragma unroll
    for (int o = 32; o >= 1; o >>= 1) v += __shfl_xor(v, o);
    return v;
}
__device__ __forceinline__ float sum16(float v) {
#pragma unroll
    for (int o = 8; o >= 1; o >>= 1) v += __shfl_xor(v, o);
    return v;
}

namespace pg8 {
constexpr int BM = 256, BK = 64, HALF = 128, HTB = HALF * BK * 2, STAGE_BYTES = 8 * HTB, NXCD = 8, WGM = 8;
__host__ __device__ __forceinline__ int lds_byte(int r, int c) { const int st = (r >> 4) * 2 + (c >> 5), rr = r & 15, cc = c & 31, ob = rr * 64 + cc * 2; return st * 1024 + (ob ^ (((ob >> 9) & 1) << 5)); }
__host__ __device__ __forceinline__ void stage_rc(int b, int& R, int& C) { const int st = b / 1024, sb = b % 1024, swz = sb ^ (((sb >> 9) & 1) << 5); R = (st >> 1) * 16 + swz / 64; C = (st & 1) * 32 + (swz % 64) / 2; }
__host__ __device__ __forceinline__ int perm32(int rho) { const int n = rho >> 4, i = rho & 15; return 8 * (i >> 2) + 4 * n + (i & 3); }
struct Unit { int pm, pn; };
struct Gemm { const bf16_t* A; const bf16_t* Bt; int M, N, K; };
struct StaticOrder {
    int nM, nN, nwg, G, c;
    __host__ __device__ void init(int M, int N, int G_, int c_) { nM = M / BM; nN = N / BM; nwg = nM * nN; G = G_; c = c_; }
    __host__ __device__ bool next(int i, Unit& u) const {
        const long L = (long)i * G + c; if (L >= nwg) return false;
        int wgid = (int)L; { const int q = nwg / NXCD, r = nwg % NXCD, xcd = wgid % NXCD, off = wgid / NXCD; wgid = (xcd < r ? xcd * (q + 1) : r * (q + 1) + (xcd - r) * q) + off; }
        const int nig = WGM * nN, gid = wgid / nig, fm = gid * WGM, gsz = (nM - fm) < WGM ? (nM - fm) : WGM;
        u.pm = fm + ((wgid % nig) % gsz); u.pn = (wgid % nig) / gsz; return true;
    }
    __device__ __forceinline__ void a_ready(const Unit&) const {}
    __device__ __forceinline__ void done(const Unit&) const {}
};
template <class Epi, class Sched>
__device__ __forceinline__ void gemm_phase(LAS unsigned char* lds, const Gemm g, const Sched& S, const Epi& E) {
    const int tid = TIDX, wid = __builtin_amdgcn_readfirstlane(tid >> 6), lane = tid & 63, wr = wid >> 2, wc = wid & 3, fr = lane & 15, fq = lane >> 4;
    const int K = g.K, nt = K / BK;
    unsigned voffA[2], voffB[2];
#pragma unroll
    for (int i = 0; i < 2; ++i) { int R, C; stage_rc(tid * 16 + i * 8192, R, C); const int Rb = (R & ~31) + perm32(R & 31);
        voffA[i] = (unsigned)(R * K + C) * 2u; voffB[i] = (unsigned)(Rb * K + C) * 2u; }
    const size_t kstep = (size_t)(BK * 2);
    const size_t hstep = (size_t)HALF * K * 2;
    const size_t tstep = 2 * hstep;
    const unsigned ldsw = (unsigned)wid * 1024u;
    const int aoff = lds_byte(wr * 64 + fr, fq * 8), boff = lds_byte(wc * 32 + fr, fq * 8);
#define PG8_SA(b, h) (((b) * 2 + (h)) * HTB)
#define PG8_SB(b, h) ((4 + (b) * 2 + (h)) * HTB)
#define PG8_STAGE(bufoff, gbase, voff) do { _Pragma("unroll") for (int _i = 0; _i < 2; ++_i) \
        __builtin_amdgcn_global_load_lds((const unsigned*)((const char*)(gbase) + (voff)[_i]), (LAS unsigned*)(lds + (bufoff) + ldsw + _i * 8192), 16, 0, 0); } while (0)
#define PG8_LDA(dst, b, h) do { _Pragma("unroll") for (int m = 0; m < 4; ++m) _Pragma("unroll") for (int k = 0; k < 2; ++k) dst[m][k] = *(const LAS bf16x8*)(lds + PG8_SA(b, h) + aoff + m * 2048 + k * 1024); } while (0)
#define PG8_LDB(dst, b, h) do { _Pragma("unroll") for (int n = 0; n < 2; ++n) _Pragma("unroll") for (int k = 0; k < 2; ++k) dst[n][k] = *(const LAS bf16x8*)(lds + PG8_SB(b, h) + boff + n * 2048 + k * 1024); } while (0)
#define PG8_MMA(ai, bj, At, Bt) do { __builtin_amdgcn_s_setprio(1); _Pragma("unroll") for (int m = 0; m < 4; ++m) _Pragma("unroll") for (int n = 0; n < 2; ++n) _Pragma("unroll") for (int k = 0; k < 2; ++k) \
        acc[ai][bj][m][n] = __builtin_amdgcn_mfma_f32_16x16x32_bf16(Bt[n][k], At[m][k], acc[ai][bj][m][n], 0, 0, 0); __builtin_amdgcn_s_setprio(0); } while (0)
#define PG8_WAIT_V(n) asm volatile("s_waitcnt vmcnt(" #n ")" ::: "memory")
#define PG8_WAIT_L(n) asm volatile("s_waitcnt lgkmcnt(" #n ")" ::: "memory")
#define PG8_BAR __builtin_amdgcn_s_barrier()
#define PG8_SCHED __builtin_amdgcn_sched_barrier(0)
    Unit cur, nxt; int ui = 0;
    if (!S.next(0, cur)) return;
    f32x4 acc[2][2][4][2];
#pragma unroll
    for (int a = 0; a < 2; ++a)
#pragma unroll
        for (int b = 0; b < 2; ++b)
#pragma unroll
            for (int m = 0; m < 4; ++m)
#pragma unroll
                for (int n = 0; n < 2; ++n) acc[a][b][m][n] = (f32x4){0.f, 0.f, 0.f, 0.f};
    bf16x8 At[4][2], B0[2][2], B1[2][2];
    const char* cA = (const char*)g.A + (size_t)cur.pm * tstep; const char* cB = (const char*)g.Bt + (size_t)cur.pn * tstep;
    S.a_ready(cur);
    PG8_STAGE(PG8_SB(0, 0), cB, voffB); PG8_STAGE(PG8_SA(0, 0), cA, voffA); PG8_STAGE(PG8_SB(0, 1), cB + hstep, voffB); PG8_STAGE(PG8_SA(0, 1), cA + hstep, voffA);
    if (wr == 1) PG8_BAR;
    PG8_WAIT_V(4); PG8_BAR;
    PG8_STAGE(PG8_SB(1, 0), cB + kstep, voffB); PG8_STAGE(PG8_SA(1, 0), cA + kstep, voffA); PG8_STAGE(PG8_SB(1, 1), cB + hstep + kstep, voffB);
    PG8_WAIT_V(6); PG8_BAR;
    for (;;) {
        const bool has_next = S.next(ui + 1, nxt);
        const char* nA = has_next ? (const char*)g.A + (size_t)nxt.pm * tstep : cA; const char* nB = has_next ? (const char*)g.Bt + (size_t)nxt.pn * tstep : cB;
        for (int t = 0; t < nt; t += 2) {
            const bool last = (t == nt - 2);
            const char* a1 = cA + (size_t)(t + 1) * kstep;
            const char* a2 = last ? nA : cA + (size_t)(t + 2) * kstep; const char* b2 = last ? nB : cB + (size_t)(t + 2) * kstep;
            const char* a3 = a2 + kstep; const char* b3 = b2 + kstep;
            if (last && has_next) S.a_ready(nxt);
            PG8_LDB(B0, 0, 0); PG8_SCHED; PG8_LDA(At, 0, 0); PG8_STAGE(PG8_SA(1, 1), a1 + hstep, voffA);
            PG8_WAIT_L(8); PG8_BAR; PG8_WAIT_L(0); PG8_MMA(0, 0, At, B0); PG8_BAR; PG8_SCHED;
            PG8_LDB(B1, 0, 1); PG8_STAGE(PG8_SB(0, 0), b2, voffB);
            PG8_BAR; PG8_WAIT_L(0); PG8_MMA(0, 1, At, B1); PG8_BAR;
            PG8_LDA(At, 0, 1); PG8_STAGE(PG8_SA(0, 0), a2, voffA);
            PG8_BAR; PG8_WAIT_L(0); PG8_MMA(1, 0, At, B0); PG8_BAR; PG8_SCHED;
            PG8_STAGE(PG8_SB(0, 1), b2 + hstep, voffB);
            PG8_WAIT_V(6); PG8_BAR; PG8_MMA(1, 1, At, B1); PG8_BAR;
            PG8_LDB(B0, 1, 0); PG8_SCHED; PG8_LDA(At, 1, 0); PG8_STAGE(PG8_SA(0, 1), a2 + hstep, voffA);
            PG8_WAIT_L(8); PG8_BAR; PG8_WAIT_L(0); PG8_MMA(0, 0, At, B0); PG8_BAR; PG8_SCHED;
            PG8_LDB(B1, 1, 1); PG8_STAGE(PG8_SB(1, 0), b3, voffB);
            PG8_BAR; PG8_WAIT_L(0); PG8_MMA(0, 1, At, B1); PG8_BAR;
            PG8_LDA(At, 1, 1); PG8_STAGE(PG8_SA(1, 0), a3, voffA);
            PG8_BAR; PG8_WAIT_L(0); PG8_MMA(1, 0, At, B0); PG8_BAR; PG8_SCHED;
            PG8_STAGE(PG8_SB(1, 1), b3 + hstep, voffB);
            PG8_WAIT_V(6); PG8_BAR; PG8_MMA(1, 1, At, B1); PG8_BAR;
        }
        E(acc, cur, wr, wc, fr, fq); S.done(cur);
        if (!has_next) break;
#pragma unroll
        for (int a = 0; a < 2; ++a)
#pragma unroll
            for (int b = 0; b < 2; ++b)
#pragma unroll
                for (int m = 0; m < 4; ++m)
#pragma unroll
                    for (int n = 0; n < 2; ++n) acc[a][b][m][n] = (f32x4){0.f, 0.f, 0.f, 0.f};
        cur = nxt; cA = nA; cB = nB; ++ui;
    }
    PG8_WAIT_V(0);
    if (wr == 0) PG8_BAR;
    PG8_BAR;
#undef PG8_SA
#undef PG8_SB
#undef PG8_STAGE
#undef PG8_LDA
#undef PG8_LDB
#undef PG8_MMA
#undef PG8_WAIT_V
#undef PG8_WAIT_L
#undef PG8_BAR
#undef PG8_SCHED
}
}

constexpr int DM = 4096, NP = 4096, NS = 8192, NT = 12288, AW = 2048;
constexpr int N1 = 13824, N1F = 6656, N1B = 7168;
constexpr int N3 = 10496, N3G = 8192, N3C = 2304;
constexpr int NKV = 13312;
constexpr size_t SZA = (size_t)NT * AW * 4;

constexpr size_t WS_CTL = 0;
constexpr size_t WS_MOD = 65536;
constexpr size_t WS_ROPEB_COS = 589824, WS_ROPEB_SIN = WS_ROPEB_COS + 524288;
constexpr size_t WS_ROPEC_COS = WS_ROPEB_SIN + 524288, WS_ROPEC_SIN = WS_ROPEC_COS + 262144;
constexpr size_t WS_R0 = 2228224;
constexpr size_t WS_PROJF = WS_R0;
constexpr size_t WS_YA = WS_R0;
constexpr size_t WS_MIXED = WS_R0 + 2 * SZA;
constexpr size_t WS_R1 = WS_R0 + (size_t)NT * N1F * 4;
constexpr size_t WS_PROJB = WS_R1;
constexpr size_t WS_R2 = WS_R1 + (size_t)NT * N1B * 2;
constexpr size_t WS_WTA = WS_R2;
constexpr size_t WS_H0 = WS_R2 + (size_t)N1 * DM * 2;
constexpr size_t WS_R = WS_R2;
constexpr size_t WS_K = WS_R2 + SZA;
constexpr size_t WS_R4 = WS_R2 + (size_t)N1 * DM * 2 + (size_t)NT * DM * 2;
constexpr size_t WS_WD = WS_R4;
constexpr size_t WS_R5 = WS_R4 + 4 * SZA;
constexpr size_t WS_LORA = WS_R5;
constexpr size_t WS_KBP = WS_LORA + (size_t)NT * 512 * 2;
constexpr size_t WS_VBP = WS_KBP + (size_t)NP * 512 * 2;
constexpr size_t WS_KBS = WS_VBP + (size_t)NP * 512 * 2;
constexpr size_t WS_VBS = WS_KBS + (size_t)9216 * 512 * 2;
constexpr size_t WS_R6 = WS_VBS + (size_t)9216 * 512 * 2;
constexpr size_t WS_WTOUT = WS_R6;
constexpr size_t WS_WTLORA = WS_WTOUT + (size_t)DM * DM * 2;
constexpr size_t WS_END0 = WS_WTLORA + (size_t)2 * 4096 * 256 * 2;
constexpr size_t WS_Q = WS_R0;
constexpr size_t WS_CKV = WS_Q + (size_t)NT * 12288 * 2;
constexpr size_t WS_KPE = WS_CKV + (size_t)NKV * 512 * 2;
constexpr size_t WS_H1 = WS_R1;
constexpr size_t WS_OG = WS_H1;
constexpr size_t WS_PROJC = WS_H1 + (size_t)NT * DM * 2;
constexpr size_t WS_GATEB = WS_PROJC + (size_t)NT * N3C * 4;
constexpr size_t WS_QN = WS_GATEB + (size_t)NT * 8192 * 2;
constexpr size_t WS_KV = WS_QN + (size_t)NT * 1536 * 2;
constexpr size_t WS_L1END = WS_KV + (size_t)NKV * 16384 * 2;
constexpr size_t WS_WTC = WS_L1END > WS_END0 ? WS_L1END : WS_END0;
constexpr size_t WS_WTUQ = WS_WTC + (size_t)N3 * DM * 2;
constexpr size_t WS_WTUKV = WS_WTUQ + (size_t)12288 * 1536 * 2;
constexpr size_t WS_WTCOUT = WS_WTUKV + (size_t)16384 * 512 * 2;
constexpr size_t WS_END1 = WS_WTCOUT + (size_t)DM * 8192 * 2;
static_assert(WS_KPE + (size_t)NKV * 64 * 2 <= WS_R1, "q, ckv, kpe must fit in R0");
constexpr size_t WS_NEED = WS_END0 > WS_END1 ? WS_END0 : WS_END1;
static_assert((size_t)NT * (DM * 2 + N3C * 4) >= (size_t)NT * 8192 * 2, "og must fit over h1 + projC");
static_assert(WS_R2 + 2 * SZA <= WS_R4, "r,k must fit in R2");

constexpr size_t OUT_Y = 0, OUT_STATE = 50331648, OUT_GK = 54525952, OUT_GV = 56623104, OUT_CKV = 58720256, OUT_KPE = 60817408, OUT_TOTAL = 61079552;

constexpr int LDS_X = 8 * 18688;
constexpr int LDS_BYTES = LDS_X + 512;
static_assert(TID_TAB_OFF == LDS_X + 128, "tid table behind the barrier / queue words");
constexpr int NPH = 15;

struct Params { const float* in[33]; float* out; unsigned char* ws; int ph_lo, ph_hi; };
typedef const __attribute__((address_space(4))) Params* KP;
__device__ __forceinline__ KP get_params() { unsigned long long a = (unsigned long long)__builtin_amdgcn_kernarg_segment_ptr(); asm volatile("" : "+s"(a)); return (KP)a; }

enum { I_XP = 0, I_XS, I_C, I_STATE, I_CGK, I_CGV, I_CCKV, I_CKPE, I_CCTX, I_MODW, I_MODB, I_NORMG, I_ABWIN, I_ABMIX, I_W0, I_W2, I_A0, I_A2, I_KK, I_KA, I_RK, I_LNW, I_LNB,
       I_QG, I_KG, I_ABWOUT, I_CWIN, I_QAG, I_KVAG, I_WUQ, I_WUKV, I_CWOUT, I_FINALG };

__device__ __forceinline__ void transpose_tile(const float* __restrict__ src, int ldn, int K, int k0, int n0, bf16_t* __restrict__ dst, int drow0, unsigned char* lds) {
    const int t = TIDX;
    constexpr int RS = 528;
    __syncthreads();
    {
        const int nq = t & 15, kr = t >> 4;
#pragma unroll
        for (int it = 0; it < 4; ++it) {
            const int k = 2 * kr + 64 * it;
            const f32x4 a = *(const f32x4*)(src + (size_t)(k0 + k) * ldn + n0 + nq * 4);
            const f32x4 b = *(const f32x4*)(src + (size_t)(k0 + k + 1) * ldn + n0 + nq * 4);
#pragma unroll
            for (int e = 0; e < 4; ++e) *(unsigned*)(lds + (nq * 4 + e) * RS + k * 2) = cvt_pk_bf16(a[e], b[e]);
        }
    }
    __syncthreads();
    {
        const int n = t >> 3, kc = (t & 7) * 32;
        bf16_t* d = dst + (size_t)(drow0 + n) * K + k0 + kc;
#pragma unroll
        for (int q = 0; q < 4; ++q) *(u32x4*)(d + q * 8) = *(const u32x4*)(lds + n * RS + (kc + q * 8) * 2);
    }
}
template <class RowMap>
__device__ __forceinline__ int transpose_all(const float* src, int K, int Nsrc, bf16_t* dst, RowMap rm, int u0, unsigned char* lds, int G = (int)gridDim.x, int wg = (int)blockIdx.x) {
    const int nkt = K / 256, nnt = Nsrc / 64, nu = nkt * nnt;
    int first = (wg - (u0 % G) + G) % G;
    for (int u = first; u < nu; u += G) { const int kt = u % nkt, ntile = u / nkt; transpose_tile(src, Nsrc, K, kt * 256, ntile * 64, dst, rm(ntile * 64), lds); }
    return nu;
}
struct RowId { __device__ int operator()(int n) const { return n; } };
struct RowMla { __device__ int operator()(int n) const { return n < 2112 ? 8192 + n : n - 2112; } };

__device__ __forceinline__ void phase0(KP p, unsigned char* lds) {
    unsigned char* ws = p->ws;
    const int tid = TIDX, G = gridDim.x, bid = blockIdx.x;
    {
        float* cb = (float*)(ws + WS_ROPEB_COS); float* sb = (float*)(ws + WS_ROPEB_SIN);
        float* cc = (float*)(ws + WS_ROPEC_COS); float* sc = (float*)(ws + WS_ROPEC_SIN);
        for (int i = bid * 512 + tid; i < 2048 * 64 + 2048 * 32; i += G * 512) {
            if (i < 2048 * 64) { const int t = i >> 6, pi = i & 63; const int fi = pi & 31; const float pos = (float)(pi < 32 ? (t >> 6) : (t & 63));
                const float inv = exp2f(-(float)fi * (13.287712379549449f / 32.0f)); const float a = pos * inv; cb[i] = cosf(a); sb[i] = sinf(a); }
            else { const int j = i - 2048 * 64; const int t = j >> 5, pi = j & 31; const int fi = pi & 15; const float pos = (float)(pi < 16 ? (t >> 6) : (t & 63));
                const float inv = exp2f(-(float)fi * (13.287712379549449f / 16.0f)); const float a = pos * inv; cc[j] = cosf(a); sc[j] = sinf(a); }
        }
    }
    {
        bf16_t* WL = (bf16_t*)(ws + WS_WTLORA);
        for (int i = bid * 512 + tid; i < 2 * 4096 * 32; i += G * 512) {
            const int d = i >> 17, n = (i >> 5) & 4095, k8 = (i & 31) * 8; const int isa = n >> 11, nn = n & 2047;
            u32x4 o = (u32x4){0u, 0u, 0u, 0u};
            if ((k8 >> 7) == isa) {
                const float* src = (isa ? p->in[I_A2] : p->in[I_W2]) + (size_t)d * 128 * 2048 + nn; const int kb = k8 & 127;
                float v[8];
#pragma unroll
                for (int e = 0; e < 8; ++e) v[e] = src[(size_t)(kb + e) * 2048];
                o = (u32x4){cvt_pk_bf16(v[0], v[1]), cvt_pk_bf16(v[2], v[3]), cvt_pk_bf16(v[4], v[5]), cvt_pk_bf16(v[6], v[7])};
            }
            *(u32x4*)(WL + ((size_t)d * 4096 + n) * 256 + k8) = o;
        }
    }
    {
        unsigned* qhead = (unsigned*)(ws + WS_CTL) + 4096 + 64;
        float* S = (float*)lds;
        float* RED = (float*)(lds + 81920);
        bool have_s = false;
        for (;;) {
            unsigned qa = LDS_X + 64; asm volatile("" : "+s"(qa));
            volatile LAS unsigned* qslot = (volatile LAS unsigned*)(LAS char*)(uintptr_t)qa;
            __syncthreads();
            if (TIDX == 0) *qslot = __hip_atomic_fetch_add(qhead, 1u, __ATOMIC_RELAXED, __HIP_MEMORY_SCOPE_AGENT);
            __syncthreads();
            const int u = (int)__builtin_amdgcn_readfirstlane(*qslot);
            if (u >= 192 + 3456 + 1024) break;
            if (u >= 192) {
                const int t = u - 192;
                if (t < 3456) transpose_tile(p->in[I_ABWIN], N1, 4096, (t & 15) * 256, (t >> 4) * 64, (bf16_t*)(ws + WS_WTA), (t >> 4) * 64, lds);
                else { const int t2 = t - 3456; transpose_tile(p->in[I_ABWOUT], 4096, 4096, (t2 & 15) * 256, (t2 >> 4) * 64, (bf16_t*)(ws + WS_WTOUT), (t2 >> 4) * 64, lds); }
                continue;
            }
            if (!have_s) {
                for (int i = tid; i < 5 * 4096; i += 512) { const int r = i >> 12, k = i & 4095; const float x = r == 0 ? p->in[I_CCTX][k] : p->in[I_C][(r - 1) * 4096 + k]; S[i] = silu_f(x); }
                have_s = true;
            }
            __syncthreads();
            const int layer = u / 96, c0 = (u % 96) * 128;
            const int cg = tid & 31, ks = tid >> 5;
            const float* W = p->in[I_MODW] + (size_t)layer * 4096 * 12288 + c0 + cg * 4;
            f32x4 acc[5];
#pragma unroll
            for (int r = 0; r < 5; ++r) acc[r] = (f32x4){0.f, 0.f, 0.f, 0.f};
#pragma unroll 8
            for (int kk = 0; kk < 256; ++kk) {
                const int k = ks * 256 + kk;
                const f32x4 w = *(const f32x4*)(W + (size_t)k * 12288);
#pragma unroll
                for (int r = 0; r < 5; ++r) acc[r] += w * S[r * 4096 + k];
            }
#pragma unroll
            for (int r = 0; r < 5; ++r) *(f32x4*)(RED + (ks * 5 + r) * 128 + cg * 4) = acc[r];
            __syncthreads();
            for (int o = tid; o < 640; o += 512) {
                const int r = o >> 7, c = o & 127; float sacc = 0.f;
#pragma unroll
                for (int q = 0; q < 16; ++q) sacc += RED[(q * 5 + r) * 128 + c];
                ((float*)(ws + WS_MOD))[((size_t)layer * 5 + r) * 12288 + c0 + c] = sacc + p->in[I_MODB][layer * 12288 + c0 + c];
            }
        }
        __syncthreads();
    }
}

__device__ __forceinline__ void phase_cvt1(KP p, unsigned char* lds, int part, int G, int wg) {
    unsigned char* ws = p->ws; int u0 = 0;
    if (part == 0) {
        u0 += transpose_all(p->in[I_CWIN], 4096, 10304, (bf16_t*)(ws + WS_WTC), RowMla(), u0, lds, G, wg);
        u0 += transpose_all(p->in[I_WUQ], 1536, 12288, (bf16_t*)(ws + WS_WTUQ), RowId(), u0, lds, G, wg);
        bf16_t* pad = (bf16_t*)(ws + WS_WTC) + (size_t)10304 * 4096;
        for (int i = wg * 512 + TIDX; i < 192 * 4096 / 8; i += G * 512) *(u32x4*)(pad + (size_t)i * 8) = (u32x4){0u, 0u, 0u, 0u};
    } else if (part == 1) {
        u0 += transpose_all(p->in[I_WUKV], 512, 16384, (bf16_t*)(ws + WS_WTUKV), RowId(), u0, lds, G, wg);
    } else {
        u0 += transpose_all(p->in[I_CWOUT], 8192, 4096, (bf16_t*)(ws + WS_WTCOUT), RowId(), u0, lds, G, wg);
    }
}

__device__ __forceinline__ void phase_h(KP p, int layer, const float* x0  , const float* x1  , bf16_t* h) {
    const int lane = TIDX & 63, wave = TIDX >> 6, gw = blockIdx.x * 8 + wave, nw = gridDim.x * 8;
    const float* mod = (const float*)(p->ws + WS_MOD) + (size_t)layer * 5 * 12288;
    const float* g = p->in[I_NORMG] + layer * 4096;
    for (int row = gw; row < NT; row += nw) {
        const float* x = row < NP ? x0 + (size_t)row * DM : x1 + (size_t)(row - NP) * DM;
        const int mr = row < NP ? 0 : 1 + (row - NP) / 2048;
        f32x4 v[16]; float ss = 0.f;
#pragma unroll
        for (int i = 0; i < 16; ++i) { v[i] = ((const f32x4*)x)[lane + 64 * i]; ss += v[i][0] * v[i][0] + v[i][1] * v[i][1] + v[i][2] * v[i][2] + v[i][3] * v[i][3]; }
        ss = wave_sum(ss);
        const float inv = rsqrtf(ss * (1.0f / 4096.0f) + 1e-6f);
        const float* msh = mod + (size_t)mr * 12288; const float* msc = msh + 4096;
#pragma unroll
        for (int i = 0; i < 16; ++i) {
            const int c4 = lane + 64 * i;
            const f32x4 g4 = ((const f32x4*)g)[c4], sc = ((const f32x4*)msc)[c4], sh = ((const f32x4*)msh)[c4];
            const f32x4 o = v[i] * inv * g4 * (sc + 1.0f) + sh;
            u32x2 w; w.x = cvt_pk_bf16(o[0], o[1]); w.y = cvt_pk_bf16(o[2], o[3]);
            *(u32x2*)(h + (size_t)row * DM + c4 * 4) = w;
        }
    }
}

__device__ __forceinline__ void phase_h_bf(KP p, int layer, const bf16_t* xb, bf16_t* h) {
    const int lane = TIDX & 63, wave = TIDX >> 6, gw = blockIdx.x * 8 + wave, nw = gridDim.x * 8;
    const float* mod = (const float*)(p->ws + WS_MOD) + (size_t)layer * 5 * 12288;
    const float* g = p->in[I_NORMG] + layer * 4096;
    for (int row = gw; row < NT; row += nw) {
        const u32x2* x = (const u32x2*)(xb + (size_t)row * DM);
        const int mr = row < NP ? 0 : 1 + (row - NP) / 2048;
        f32x4 v[16]; float ss = 0.f;
#pragma unroll
        for (int i = 0; i < 16; ++i) { v[i] = up4(x[lane + 64 * i]); ss += v[i][0] * v[i][0] + v[i][1] * v[i][1] + v[i][2] * v[i][2] + v[i][3] * v[i][3]; }
        ss = wave_sum(ss);
        const float inv = rsqrtf(ss * (1.0f / 4096.0f) + 1e-6f);
        const float* msh = mod + (size_t)mr * 12288; const float* msc = msh + 4096;
#pragma unroll
        for (int i = 0; i < 16; ++i) {
            const int c4 = lane + 64 * i;
            const f32x4 g4 = ((const f32x4*)g)[c4], sc = ((const f32x4*)msc)[c4], sh = ((const f32x4*)msh)[c4];
            *(u32x2*)(h + (size_t)row * DM + c4 * 4) = pk4(v[i] * inv * g4 * (sc + 1.0f) + sh);
        }
    }
}

#define EPI_LOOP_BEGIN \
    _Pragma("unroll") for (int ai = 0; ai < 2; ++ai) _Pragma("unroll") for (int m = 0; m < 4; ++m) { const int row = u.pm * 256 + ai * 128 + wr * 64 + m * 16 + fr; \
    _Pragma("unroll") for (int bj = 0; bj < 2; ++bj) _Pragma("unroll") for (int n = 0; n < 2; ++n) { const int col = u.pn * 256 + bj * 128 + wc * 32 + fq * 8 + n * 4; const f32x4 a = acc[ai][bj][m][n];
#define EPI_LOOP_END } }

struct EpiG1 {
    bf16_t* F; bf16_t* B;
    __device__ __forceinline__ void operator()(const f32x4 (&acc)[2][2][4][2], const pg8::Unit& u, int wr, int wc, int fr, int fq) const {
        if (u.pn < 26) {
            EPI_LOOP_BEGIN *(u32x2*)(F + (size_t)row * N1F + col) = pk4(a); EPI_LOOP_END
        } else {
            EPI_LOOP_BEGIN *(u32x2*)(B + (size_t)row * N1B + (col - N1F)) = pk4(a); EPI_LOOP_END
        }
    }
};
struct EpiBf16Plain {
    bf16_t* O; int ldc;
    __device__ __forceinline__ void operator()(const f32x4 (&acc)[2][2][4][2], const pg8::Unit& u, int wr, int wc, int fr, int fq) const {
        EPI_LOOP_BEGIN u32x2 w; w.x = cvt_pk_bf16(a[0], a[1]); w.y = cvt_pk_bf16(a[2], a[3]); *(u32x2*)(O + (size_t)row * ldc + col) = w; EPI_LOOP_END
    }
};
struct EpiLora {
    const float* w0; const float* a0; bf16_t* Wd; bf16_t* Ad;
    __device__ __forceinline__ void operator()(const f32x4 (&acc)[2][2][4][2], const pg8::Unit& u, int wr, int wc, int fr, int fq) const {
        if (u.pn < 8) {
            EPI_LOOP_BEGIN const int c = col & 2047; const f32x4 b0 = *(const f32x4*)(w0 + c); f32x4 o;
#pragma unroll
                for (int e = 0; e < 4; ++e) o[e] = -0.8750270622f * sigmoid_f(a[e] + b0[e]);
                *(u32x2*)(Wd + (size_t)row * AW + c) = pk4(o); EPI_LOOP_END
        } else {
            EPI_LOOP_BEGIN const int c = col & 2047; const f32x4 b0 = *(const f32x4*)(a0 + c); f32x4 o;
#pragma unroll
                for (int e = 0; e < 4; ++e) o[e] = sigmoid_f(a[e] + b0[e]);
                *(u32x2*)(Ad + (size_t)row * AW + c) = pk4(o); EPI_LOOP_END
        }
    }
};
template <bool XBF> struct EpiRes {
    const float* x0; const float* x1; const bf16_t* xb; bf16_t* out; const float* gate;
    __device__ __forceinline__ void operator()(const f32x4 (&acc)[2][2][4][2], const pg8::Unit& u, int wr, int wc, int fr, int fq) const {
        const int rbase = u.pm * 256; const float* xin = rbase < NP ? x0 + (size_t)0 : x1 - (size_t)NP * DM; const int mr = rbase < NP ? 0 : 1 + (rbase - NP) / 2048;
        const float* gr = gate + (size_t)mr * 12288;
        EPI_LOOP_BEGIN f32x4 xv; if constexpr (XBF) xv = up4(*(const u32x2*)(xb + (size_t)row * DM + col)); else xv = *(const f32x4*)(xin + (size_t)row * DM + col);
            const f32x4 gv = *(const f32x4*)(gr + col);
            *(u32x2*)(out + (size_t)row * DM + col) = pk4(xv + gv * a); EPI_LOOP_END
    }
};
struct EpiG3 {
    bf16_t* Gt; bf16_t* C;
    __device__ __forceinline__ void operator()(const f32x4 (&acc)[2][2][4][2], const pg8::Unit& u, int wr, int wc, int fr, int fq) const {
        if (u.pn < 32) {
            EPI_LOOP_BEGIN *(u32x2*)(Gt + (size_t)row * N3G + col) = pk4(a); EPI_LOOP_END
        } else {
            EPI_LOOP_BEGIN *(u32x2*)(C + (size_t)row * N3C + (col - N3G)) = pk4(a); EPI_LOOP_END
        }
    }
};
struct EpiQ {
    bf16_t* Q; const float* cosC; const float* sinC;
    __device__ __forceinline__ void operator()(const f32x4 (&acc)[2][2][4][2], const pg8::Unit& u, int wr, int wc, int fr, int fq) const {
        const bool samp = u.pm * 256 >= NP;
        EPI_LOOP_BEGIN f32x4 o = a; const int hc = col % 192;
            if (samp && hc >= 128) { const int t = (row - NP) & 2047; const int pi = (hc - 128) >> 1;
                const f32x2 cs = *(const f32x2*)(cosC + t * 32 + pi), sn = *(const f32x2*)(sinC + t * 32 + pi);
                o[0] = a[0] * cs[0] - a[1] * sn[0]; o[1] = a[0] * sn[0] + a[1] * cs[0]; o[2] = a[2] * cs[1] - a[3] * sn[1]; o[3] = a[2] * sn[1] + a[3] * cs[1]; }
            u32x2 w; w.x = cvt_pk_bf16(o[0], o[1]); w.y = cvt_pk_bf16(o[2], o[3]); *(u32x2*)(Q + (size_t)row * 12288 + col) = w; EPI_LOOP_END
    }
};

__device__ __forceinline__ void unpack8(const u32x4 w, float (&x)[8]) { x[0] = bf_lo(w.x); x[1] = bf_hi(w.x); x[2] = bf_lo(w.y); x[3] = bf_hi(w.y); x[4] = bf_lo(w.z); x[5] = bf_hi(w.z); x[6] = bf_lo(w.w); x[7] = bf_hi(w.w); }
__device__ __forceinline__ u32x4 pack8(const float (&x)[8]) { return (u32x4){cvt_pk_bf16(x[0], x[1]), cvt_pk_bf16(x[2], x[3]), cvt_pk_bf16(x[4], x[5]), cvt_pk_bf16(x[6], x[7])}; }
__device__ __forceinline__ void rope8(float (&x)[8], const float* cs, const float* sn) {
    const f32x4 c = *(const f32x4*)cs, s = *(const f32x4*)sn;
#pragma unroll
    for (int e = 0; e < 4; ++e) { const float xr = x[2 * e], xi = x[2 * e + 1]; x[2 * e] = xr * c[e] - xi * s[e]; x[2 * e + 1] = xr * s[e] + xi * c[e]; }
}
__device__ __forceinline__ void phase_prepA(KP p) {
    unsigned char* ws = p->ws;
    const int lane = TIDX & 63, wave = TIDX >> 6, gw = blockIdx.x * 8 + wave, nw = gridDim.x * 8;
    const bf16_t* projF = (const bf16_t*)(ws + WS_PROJF); bf16_t* projB = (bf16_t*)(ws + WS_PROJB);
    bf16_t* Rb = (bf16_t*)(ws + WS_R); bf16_t* Kb = (bf16_t*)(ws + WS_K); bf16_t* KKb = (bf16_t*)(p->out + OUT_Y); bf16_t* Vb = (bf16_t*)(p->out + OUT_Y + (size_t)NT * AW);
    bf16_t* lora = (bf16_t*)(ws + WS_LORA);
    bf16_t* KbP = (bf16_t*)(ws + WS_KBP); bf16_t* VbP = (bf16_t*)(ws + WS_VBP); bf16_t* KbS = (bf16_t*)(ws + WS_KBS); bf16_t* VbS = (bf16_t*)(ws + WS_VBS);
    const float* cosB = (const float*)(ws + WS_ROPEB_COS); const float* sinB = (const float*)(ws + WS_ROPEB_SIN);
    const float* mix = p->in[I_ABMIX]; const float* k_k = p->in[I_KK]; const float* qg = p->in[I_QG]; const float* kg = p->in[I_KG];
    for (int row = gw; row < NT + 1024; row += nw) {
        if (row >= NT) {
            const int cr = row - NT, b = cr >> 8, t = cr & 255; const size_t drow = (size_t)(b * 2304 + t) * 512 + lane * 8;
            { const float* s = p->in[I_CGK] + (size_t)cr * 512 + lane * 8; const f32x4 a = *(const f32x4*)s, c = *(const f32x4*)(s + 4);
              *(u32x4*)(KbS + drow) = (u32x4){cvt_pk_bf16(a[0], a[1]), cvt_pk_bf16(a[2], a[3]), cvt_pk_bf16(c[0], c[1]), cvt_pk_bf16(c[2], c[3])}; }
            { const float* s = p->in[I_CGV] + (size_t)cr * 512 + lane * 8; const f32x4 a = *(const f32x4*)s, c = *(const f32x4*)(s + 4);
              *(u32x4*)(VbS + drow) = (u32x4){cvt_pk_bf16(a[0], a[1]), cvt_pk_bf16(a[2], a[3]), cvt_pk_bf16(c[0], c[1]), cvt_pk_bf16(c[2], c[3])}; }
            continue;
        }
        const bool samp = row >= NP; int b, t, T;
        if (!samp) { b = row >> 8; t = row & 255; T = 256; } else { const int rr = row - NP; b = rr >> 11; t = rr & 2047; T = 2048; }
        const bool hp = t > 0, hn = t < T - 1;
        const u32x2* pc = (const u32x2*)(projF + (size_t)row * N1F); const u32x2* pp = pc - N1F / 4; const u32x2* pn = pc + N1F / 4;
        const f32x4 z4 = (f32x4){0.f, 0.f, 0.f, 0.f};
        const u32x4* pc8 = (const u32x4*)pc; const u32x4* pp8 = (const u32x4*)pp; const u32x4* pn8 = (const u32x4*)pn;
#pragma unroll
        for (int it = 0; it < 13; ++it) {
            const int c8 = lane + 64 * it;
            float cur[8], prv[8], nxt[8], sh[8];
            unpack8(pc8[c8], cur);
            if (hp) unpack8(pp8[c8], prv); else {
#pragma unroll
                for (int e = 0; e < 8; ++e) prv[e] = 0.f; }
            if (hn) unpack8(pn8[c8], nxt); else {
#pragma unroll
                for (int e = 0; e < 8; ++e) nxt[e] = 0.f; }
            const f32x4 m0 = ((const f32x4*)mix)[2 * c8], m1 = ((const f32x4*)mix)[2 * c8 + 1];
#pragma unroll
            for (int e = 0; e < 8; ++e) { const float mx = e < 4 ? m0[e & 3] : m1[e & 3]; sh[e] = cur[e] + mx * ((prv[e] + nxt[e]) * 0.5f - cur[e]); }
            if (it < 12) {
                const int which = it >> 2, cc = (c8 & 255) * 8; const size_t o = (size_t)row * AW + cc;
                if (which == 0) *(u32x4*)(Rb + o) = pack8(sh);
                else if (which == 2) *(u32x4*)(Vb + o) = pack8(sh);
                else { *(u32x4*)(Kb + o) = pack8(sh);
                    const f32x4 k0 = *(const f32x4*)(k_k + cc), k1 = *(const f32x4*)(k_k + cc + 4); float kk[8]; float ss = 0.f;
#pragma unroll
                    for (int e = 0; e < 8; ++e) { kk[e] = sh[e] * (e < 4 ? k0[e & 3] : k1[e & 3]); ss += kk[e] * kk[e]; }
                    ss += __shfl_xor(ss, 1); ss += __shfl_xor(ss, 2); ss += __shfl_xor(ss, 4);
                    const float inv = 1.0f / fmaxf(sqrtf(ss), 1e-12f);
#pragma unroll
                    for (int e = 0; e < 8; ++e) kk[e] *= inv;
                    *(u32x4*)(KKb + o) = pack8(kk); }
            } else {
                const int cl = lane * 8;
                if ((cl & 255) < 128) {
#pragma unroll
                    for (int e = 0; e < 8; ++e) { const float ex = __expf(2.0f * sh[e]); sh[e] = 1.0f - 2.0f * __builtin_amdgcn_rcpf(ex + 1.0f); } }
                *(u32x4*)(lora + ((size_t)(cl >> 8) * NT + row) * 256 + (cl & 255)) = pack8(sh);
            }
        }
        bf16_t* pb = projB + (size_t)row * N1B;
        {
            const int col = lane * 8, hc = col & 127; float x[8]; unpack8(*(const u32x4*)(pb + 4096 + col), x);
            float ss = 0.f;
#pragma unroll
            for (int e = 0; e < 8; ++e) ss += x[e] * x[e];
            ss = sum16(ss); const float inv = rsqrtf(ss * (1.0f / 128.0f) + 1e-6f);
            const f32x4 g0 = *(const f32x4*)(kg + hc), g1 = *(const f32x4*)(kg + hc + 4);
#pragma unroll
            for (int e = 0; e < 4; ++e) { x[e] = x[e] * inv * g0[e]; x[4 + e] = x[4 + e] * inv * g1[e]; }
            if (!samp) {
                float* o = p->out + OUT_GK + (size_t)row * 512 + col; *(f32x4*)o = (f32x4){x[0], x[1], x[2], x[3]}; *(f32x4*)(o + 4) = (f32x4){x[4], x[5], x[6], x[7]};
                *(u32x4*)(KbP + (size_t)row * 512 + col) = pack8(x);
            } else {
                rope8(x, cosB + t * 64 + (hc >> 1), sinB + t * 64 + (hc >> 1));
                *(u32x4*)(KbS + (size_t)(b * 2304 + 256 + t) * 512 + col) = pack8(x);
            }
        }
        {
            const int col = lane * 8; const u32x4 w = *(const u32x4*)(pb + 4608 + col);
            if (!samp) { float x[8]; unpack8(w, x);
                float* o = p->out + OUT_GV + (size_t)row * 512 + col; *(f32x4*)o = (f32x4){x[0], x[1], x[2], x[3]}; *(f32x4*)(o + 4) = (f32x4){x[4], x[5], x[6], x[7]};
                *(u32x4*)(VbP + (size_t)row * 512 + col) = w;
            } else *(u32x4*)(VbS + (size_t)(b * 2304 + 256 + t) * 512 + col) = w;
        }
    }
}

#define KSWZ(row, colB) ((row) * 256 + ((colB) ^ ((((row) & 7) | ((((row) >> 4) & 1) << 3)) << 4)))
#define PSWZ(row, colB) ((row) * 128 + ((colB) ^ ((((row) >> 1) & 7) << 4)))
#define SBAR() __builtin_amdgcn_sched_barrier(0)
__device__ __forceinline__ int crow(int r, int hi) { return (r & 3) + 8 * (r >> 2) + 4 * hi; }
template <class C>
__device__ __forceinline__ void partialSM(f32x16& p0, f32x16& p1, float& m_reg, float& mn, float& alpha) {
    constexpr float Cc = C::SCALE * 1.4426950408889634f;
    float pmax = p0[0];
#pragma unroll
    for (int r = 1; r < 16; ++r) pmax = fmaxf(pmax, p0[r]);
#pragma unroll
    for (int r = 0; r < 16; ++r) pmax = fmaxf(pmax, p1[r]);
    { auto rr = __builtin_amdgcn_permlane32_swap(__float_as_uint(pmax), __float_as_uint(pmax), false, false);
      pmax = fmaxf(__uint_as_float(rr[0]), __uint_as_float(rr[1])); }
    if (__builtin_expect(__all(pmax - m_reg <= 8.0f / C::SCALE), 1)) { mn = m_reg; alpha = 1.f; }
    else { mn = fmaxf(m_reg, pmax); alpha = __builtin_amdgcn_exp2f((m_reg - mn) * Cc); m_reg = mn; }
    const float mnC = -mn * Cc;
#pragma unroll
    for (int r = 0; r < 16; ++r) p0[r] = fmaf(p0[r], Cc, mnC);
#pragma unroll
    for (int r = 0; r < 16; ++r) p1[r] = fmaf(p1[r], Cc, mnC);
#pragma unroll
    for (int r = 0; r < 16; ++r) p0[r] = __builtin_amdgcn_exp2f(p0[r]);
}
__device__ __forceinline__ void finishSM(f32x16& p0, f32x16& p1, float alpha, float& l_reg, bf16x8& pa0, bf16x8& pa1, bf16x8& pa2, bf16x8& pa3) {
#pragma unroll
    for (int r = 0; r < 16; ++r) p1[r] = __builtin_amdgcn_exp2f(p1[r]);
    float ps = 0;
#pragma unroll
    for (int r = 0; r < 16; ++r) ps += p0[r];
#pragma unroll
    for (int r = 0; r < 16; ++r) ps += p1[r];
    { auto rr = __builtin_amdgcn_permlane32_swap(__float_as_uint(ps), __float_as_uint(ps), false, false);
      ps = __uint_as_float(rr[0]) + __uint_as_float(rr[1]); }
    l_reg = l_reg * alpha + ps;
#define PK4(P, BASE, OUT) do { unsigned a0 = cvt_pk_bf16(P[BASE + 0], P[BASE + 1]), a1 = cvt_pk_bf16(P[BASE + 2], P[BASE + 3]);   \
    unsigned b0 = cvt_pk_bf16(P[BASE + 4], P[BASE + 5]), b1 = cvt_pk_bf16(P[BASE + 6], P[BASE + 7]);                              \
    auto r0 = __builtin_amdgcn_permlane32_swap(a0, b0, false, false); auto r1 = __builtin_amdgcn_permlane32_swap(a1, b1, false, false); \
    u32x4 w = {r0[0], r1[0], r0[1], r1[1]}; OUT = *reinterpret_cast<bf16x8*>(&w); } while (0)
    PK4(p0, 0, pa0); PK4(p0, 8, pa1); PK4(p1, 0, pa2); PK4(p1, 8, pa3);
#undef PK4
}
template <class C>
__device__ __forceinline__ void qkt(f32x16& p0, f32x16& p1, const char* Ks, const char* Ps, const bf16x8* qr, const char* Qpe, int r32, int hi) {
    p0 = f32x16{}; p1 = f32x16{};
#pragma unroll
    for (int d0 = 0; d0 < 8; ++d0) { const int cb = (d0 * 16 + hi * 8) * 2;
        const bf16x8 b0 = *reinterpret_cast<const bf16x8*>(Ks + KSWZ(r32, cb));
        const bf16x8 b1 = *reinterpret_cast<const bf16x8*>(Ks + KSWZ(32 + r32, cb));
        bf16x8 qf; if constexpr (true) { if (d0 < C::NDR) qf = qr[d0 < C::NDR ? d0 : 0]; else qf = *reinterpret_cast<const bf16x8*>(Qpe + (d0 - C::NDR) * 1024); }
        p0 = __builtin_amdgcn_mfma_f32_32x32x16_bf16(b0, qf, p0, 0, 0, 0);
        p1 = __builtin_amdgcn_mfma_f32_32x32x16_bf16(b1, qf, p1, 0, 0, 0); }
    if constexpr (C::PE) {
#pragma unroll
        for (int d1 = 0; d1 < 4; ++d1) { const int cb = (d1 * 16 + hi * 8) * 2;
            const bf16x8 b0 = *reinterpret_cast<const bf16x8*>(Ps + PSWZ(r32, cb));
            const bf16x8 b1 = *reinterpret_cast<const bf16x8*>(Ps + PSWZ(32 + r32, cb));
            const bf16x8 qf = *reinterpret_cast<const bf16x8*>(Qpe + (8 - C::NDR + d1) * 1024);
            p0 = __builtin_amdgcn_mfma_f32_32x32x16_bf16(b0, qf, p0, 0, 0, 0);
            p1 = __builtin_amdgcn_mfma_f32_32x32x16_bf16(b1, qf, p1, 0, 0, 0); }
    }
}
#define QK_PIPE 1
template <class C> __device__ __forceinline__ void qk_pipe() {
#ifdef QK_PIPE
    if constexpr (C::PE) {
        constexpr int NV = 7, NG = 12;
        __builtin_amdgcn_sched_group_barrier(0x100, 2, 0);
#pragma unroll
        for (int g_ = 0; g_ < NG; ++g_) {
            if (g_ + 1 < NG) { if (g_ + 1 < 8) __builtin_amdgcn_sched_group_barrier(0x100, 2, 0); else __builtin_amdgcn_sched_group_barrier(0x100, 3, 0); }
            __builtin_amdgcn_sched_group_barrier(0x400, 2, 0); __builtin_amdgcn_sched_group_barrier(0x002, NV - 2, 0); __builtin_amdgcn_sched_group_barrier(0x008, 2, 0); }
    } else {
        constexpr int NV = 10;
        __builtin_amdgcn_sched_group_barrier(0x100, 2, 0);
#pragma unroll
        for (int g_ = 0; g_ < 8; ++g_) { if (g_ + 1 < 8) __builtin_amdgcn_sched_group_barrier(0x100, 2, 0); __builtin_amdgcn_sched_group_barrier(0x400, 2, 0); __builtin_amdgcn_sched_group_barrier(0x002, NV - 2, 0); __builtin_amdgcn_sched_group_barrier(0x008, 2, 0); }
    }
#endif
}
__device__ __forceinline__ int v_st(int k, int c) { const int kk = (k & ~0xC) | ((k & 4) << 1) | ((k & 8) >> 1); return ((kk >> 3) * 4 + (c >> 5)) * 512 + ((kk & 7) * 32 + (c & 31)) * 2; }
__device__ __forceinline__ int v_rd_base(int lane) { return ((lane & 3) << 3) | (((lane >> 2) & 3) << 6) | (((lane >> 4) & 1) << 5) | (((lane >> 5) & 1) << 8); }
constexpr int v_rd_off(int d0, int ks, int half) { return d0 * 512 + ks * 4096 + half * 2048; }
template <int OFF> __device__ __forceinline__ s16x4 tr_read(int vb) {
    s16x4 r; asm volatile("ds_read_b64_tr_b16 %0, %1 offset:%2" : "=&v"(r) : "v"(vb), "i"(OFF) : "memory"); return r;
}
template <int D0> __device__ __forceinline__ void pv_one(f32x16& od, int vb, bf16x8 pa0, bf16x8 pa1, bf16x8 pa2, bf16x8 pa3) {
    const s16x4 l0 = tr_read<v_rd_off(D0, 0, 0)>(vb), h0 = tr_read<v_rd_off(D0, 0, 1)>(vb), l1 = tr_read<v_rd_off(D0, 1, 0)>(vb), h1 = tr_read<v_rd_off(D0, 1, 1)>(vb);
    const s16x4 l2 = tr_read<v_rd_off(D0, 2, 0)>(vb), h2 = tr_read<v_rd_off(D0, 2, 1)>(vb), l3 = tr_read<v_rd_off(D0, 3, 0)>(vb), h3 = tr_read<v_rd_off(D0, 3, 1)>(vb);
    asm volatile("s_waitcnt lgkmcnt(0)" ::: "memory"); SBAR();
#define PK(L, H) (bf16x8){L[0], L[1], L[2], L[3], H[0], H[1], H[2], H[3]}
    od = __builtin_amdgcn_mfma_f32_32x32x16_bf16(pa0, PK(l0, h0), od, 0, 0, 0);
    od = __builtin_amdgcn_mfma_f32_32x32x16_bf16(pa1, PK(l1, h1), od, 0, 0, 0);
    od = __builtin_amdgcn_mfma_f32_32x32x16_bf16(pa2, PK(l2, h2), od, 0, 0, 0);
    od = __builtin_amdgcn_mfma_f32_32x32x16_bf16(pa3, PK(l3, h3), od, 0, 0, 0);
#undef PK
}
__device__ __forceinline__ void pv_d0(f32x16* o, int vb, bf16x8 pa0, bf16x8 pa1, bf16x8 pa2, bf16x8 pa3) {
    pv_one<0>(o[0], vb, pa0, pa1, pa2, pa3); pv_one<1>(o[1], vb, pa0, pa1, pa2, pa3); pv_one<2>(o[2], vb, pa0, pa1, pa2, pa3); pv_one<3>(o[3], vb, pa0, pa1, pa2, pa3);
}
template <class C>
__device__ __forceinline__ void pv_psm(f32x16* o, int vb, bf16x8 pa0, bf16x8 pa1, bf16x8 pa2, bf16x8 pa3, f32x16& p0, f32x16& p1, float& m_reg, float& mn, float& alpha) {
    constexpr float Cc = C::SCALE * 1.4426950408889634f;
#define PK(L, H) (bf16x8){L[0], L[1], L[2], L[3], H[0], H[1], H[2], H[3]}
#define PVG_READ(D0) const s16x4 l0 = tr_read<v_rd_off(D0, 0, 0)>(vb), h0 = tr_read<v_rd_off(D0, 0, 1)>(vb), l1 = tr_read<v_rd_off(D0, 1, 0)>(vb), h1 = tr_read<v_rd_off(D0, 1, 1)>(vb); \
    const s16x4 l2 = tr_read<v_rd_off(D0, 2, 0)>(vb), h2 = tr_read<v_rd_off(D0, 2, 1)>(vb), l3 = tr_read<v_rd_off(D0, 3, 0)>(vb), h3 = tr_read<v_rd_off(D0, 3, 1)>(vb);
#define PVG_MMA(D0) asm volatile("s_waitcnt lgkmcnt(0)" ::: "memory"); SBAR(); \
    o[D0] = __builtin_amdgcn_mfma_f32_32x32x16_bf16(pa0, PK(l0, h0), o[D0], 0, 0, 0); o[D0] = __builtin_amdgcn_mfma_f32_32x32x16_bf16(pa1, PK(l1, h1), o[D0], 0, 0, 0); \
    o[D0] = __builtin_amdgcn_mfma_f32_32x32x16_bf16(pa2, PK(l2, h2), o[D0], 0, 0, 0); o[D0] = __builtin_amdgcn_mfma_f32_32x32x16_bf16(pa3, PK(l3, h3), o[D0], 0, 0, 0);
    float mnC;
    {   PVG_READ(0)
        float pmax = p0[0];
#pragma unroll
        for (int r = 1; r < 16; ++r) pmax = fmaxf(pmax, p0[r]);
#pragma unroll
        for (int r = 0; r < 16; ++r) pmax = fmaxf(pmax, p1[r]);
        { auto rr = __builtin_amdgcn_permlane32_swap(__float_as_uint(pmax), __float_as_uint(pmax), false, false);
          pmax = fmaxf(__uint_as_float(rr[0]), __uint_as_float(rr[1])); }
        const bool keep = __all(pmax - m_reg <= 8.0f / C::SCALE);
        mn = keep ? m_reg : fmaxf(m_reg, pmax);
        alpha = __builtin_amdgcn_exp2f((m_reg - mn) * Cc); m_reg = mn; mnC = -mn * Cc;
        PVG_MMA(0) }
    {   PVG_READ(1)
#pragma unroll
        for (int r = 0; r < 16; ++r) p0[r] = fmaf(p0[r], Cc, mnC);
        PVG_MMA(1) }
    {   PVG_READ(2)
#pragma unroll
        for (int r = 0; r < 16; ++r) p1[r] = fmaf(p1[r], Cc, mnC);
        PVG_MMA(2) }
    {   PVG_READ(3)
#pragma unroll
        for (int r = 0; r < 16; ++r) p0[r] = __builtin_amdgcn_exp2f(p0[r]);
        PVG_MMA(3) }
    asm volatile("" : "+v"(p0), "+v"(p1));
#undef PK
#undef PVG_READ
#undef PVG_MMA
}
#ifndef MLA_NDR
#define MLA_NDR 8
#endif
#ifndef MLA_SD
#define MLA_SD 1
#endif
struct CfgGqa { static constexpr bool QNORM = true; static constexpr bool PE = false; static constexpr int ND = 8, NDR = 8, LDQ = N1B, LDK = 512, LDV = 512, LDO = DM, LDG = N1B, SDEPTH = 2; static constexpr float SCALE = 0.08838834764831845f; };
struct CfgMla { static constexpr bool QNORM = false; static constexpr bool PE = true; static constexpr int ND = 12, NDR = MLA_NDR, LDQ = 12288, LDK = 16384, LDV = 16384, LDO = 8192, LDG = 8192, SDEPTH = MLA_SD; static constexpr float SCALE = 0.07216878364870323f; };

struct AttnPre { bf16x8 q[8]; u32x4 qp[4]; bf16x8 vs0, vs1, ks0, ks1, ps; };
struct AttnNext { const bf16_t* Q; const bf16_t* K; const bf16_t* V; const bf16_t* P; bool valid; };
template <class C, bool XP = false>
__device__ __forceinline__ void attn_body(const bf16_t* __restrict__ Qb, const bf16_t* __restrict__ Kh, const bf16_t* __restrict__ Vh, const bf16_t* __restrict__ Ph,
                                          bf16_t* __restrict__ Ob, const bf16_t* __restrict__ Gb, int seq, char* lds, const float* ropeC = nullptr, const float* ropeS = nullptr, int t0 = 0, const float* qg = nullptr,
                                          AttnPre* pre = nullptr, bool have = false, AttnNext nxt = AttnNext{nullptr, nullptr, nullptr, nullptr, false}) {
    constexpr int SD = C::SDEPTH; constexpr size_t SHM_V = 64 * 128 * 2, SHM_K = 64 * 128 * 2, SHM_P = C::PE ? 64 * 64 * 2 : 0;
    int tid_ = TIDX; asm volatile("" : "+v"(tid_));
    const int tid = tid_, wid = tid >> 6, lane = tid & 63, r32 = lane & 31, hi = lane >> 5;
    char* V_lds = lds; char* K_lds = lds + 2 * SHM_V; char* P_lds = lds + 2 * SHM_V + 2 * SHM_K;
    float* wsf = (float*)(lds + 2 * SHM_V + 2 * SHM_K + 2 * SHM_P) + wid * 64; float* li_l = wsf; float* al_l = wsf + 32;
    float m_reg = -1e30f, l_reg = 0; f32x16 o[4] = {}; bf16x8 qr[C::NDR];
    const bf16_t* Qw = Qb + (long)(wid * 32 + r32) * C::LDQ + hi * 8;
    char* Qpe = (char*)(wsf - wid * 64) + 2048 + wid * ((C::ND - C::NDR) * 1024) + lane * 16;
    __syncthreads();
    const int sr = tid >> 4, sc = (tid & 15) * 8, vst0 = v_st(sr, sc), vst1 = v_st(32 + sr, sc);
    const int pr = tid >> 3, pc = (tid & 7) * 8;
    const int vb0 = (int)(uintptr_t)V_lds + v_rd_base(lane);
    struct { bf16x8 vs0, vs1, ks0, ks1, ps; } sr_[SD];
#define GAS __attribute__((address_space(1)))
    static_assert(C::LDV == C::LDK, "K and V tiles share their lane offset");
    const unsigned vo = (unsigned)((sr * C::LDV + sc) * 2), po = (unsigned)((pr * 64 + pc) * 2);
#define SLOAD(i, k0) do { const char* vb_ = (const char*)Vh + (size_t)(k0) * (C::LDV * 2); const char* kb_ = (const char*)Kh + (size_t)(k0) * (C::LDK * 2); \
    const char* pb_ = C::PE ? (const char*)Ph + (size_t)(k0) * 128 : nullptr; asm volatile("" : "+s"(vb_), "+s"(kb_), "+s"(pb_)); \
    sr_[i].vs0 = *(const GAS bf16x8*)((const GAS char*)vb_ + vo); sr_[i].vs1 = *(const GAS bf16x8*)((const GAS char*)vb_ + (size_t)32 * C::LDV * 2 + vo); \
    sr_[i].ks0 = *(const GAS bf16x8*)((const GAS char*)kb_ + vo); sr_[i].ks1 = *(const GAS bf16x8*)((const GAS char*)kb_ + (size_t)32 * C::LDK * 2 + vo); \
    if constexpr (C::PE) sr_[i].ps = *(const GAS bf16x8*)((const GAS char*)pb_ + po); } while (0)
#define SWRITE(b, i) do { *(bf16x8*)(V_lds + (b) * SHM_V + vst0) = sr_[i].vs0; *(bf16x8*)(V_lds + (b) * SHM_V + vst1) = sr_[i].vs1; const int kc = sc * 2; \
    *(bf16x8*)(K_lds + (b) * SHM_K + KSWZ(sr, kc)) = sr_[i].ks0; *(bf16x8*)(K_lds + (b) * SHM_K + KSWZ(32 + sr, kc)) = sr_[i].ks1; \
    if constexpr (C::PE) *(bf16x8*)(P_lds + (b) * SHM_P + PSWZ(pr, pc * 2)) = sr_[i].ps; } while (0)
#define SWAIT() do { if constexpr (SD == 2) { if constexpr (C::PE) asm volatile("s_waitcnt vmcnt(5)" ::: "memory"); else asm volatile("s_waitcnt vmcnt(4)" ::: "memory"); } else asm volatile("s_waitcnt vmcnt(0)" ::: "memory"); } while (0)
#define RESC(a) do { if (__any((a) < 1.f)) { if (hi == 0) al_l[r32] = (a); asm volatile("s_waitcnt lgkmcnt(0)" ::: "memory"); \
    _Pragma("unroll") for (int d = 0; d < 4; ++d) _Pragma("unroll") for (int r = 0; r < 16; ++r) o[d][r] *= al_l[crow(r, hi)]; } } while (0)
    f32x16 pA0, pA1, pB0, pB1; float mnA, mnB, alA, alB; bf16x8 pa0, pa1, pa2, pa3; const int NTl = seq / 64;
    if (__builtin_amdgcn_readfirstlane(wid) >= 4) __builtin_amdgcn_s_setprio(1);
    constexpr int SE = 0, SO = SD - 1;
    constexpr int NPK = (C::ND - C::NDR) > 0 ? (C::ND - C::NDR) : 1; u32x4 qp[NPK];
    if (XP && have) {
        if constexpr (XP) {
#pragma unroll
            for (int d0 = 0; d0 < C::NDR; ++d0) qr[d0] = pre->q[d0];
#pragma unroll
            for (int d1 = 0; d1 < C::ND - C::NDR; ++d1) qp[d1] = pre->qp[d1];
            sr_[SE].vs0 = pre->vs0; sr_[SE].vs1 = pre->vs1; sr_[SE].ks0 = pre->ks0; sr_[SE].ks1 = pre->ks1; sr_[SE].ps = pre->ps;
        }
    } else {
#pragma unroll
        for (int d0 = 0; d0 < C::NDR; ++d0) qr[d0] = *reinterpret_cast<const bf16x8*>(Qw + d0 * 16);
        if constexpr (C::PE) {
#pragma unroll
            for (int d1 = 0; d1 < C::ND - C::NDR; ++d1) qp[d1] = *reinterpret_cast<const u32x4*>(Qw + (C::NDR + d1) * 16);
        }
        SLOAD(SE, 0); if constexpr (SD == 2) SLOAD(SO, 64);
    }
    if constexpr (C::QNORM) {
        float ss = 0.f;
#pragma unroll
        for (int d0 = 0; d0 < 8; ++d0) { float x[8]; unpack8(*reinterpret_cast<const u32x4*>(&qr[d0]), x);
#pragma unroll
            for (int e = 0; e < 8; ++e) ss += x[e] * x[e]; }
        { auto rr = __builtin_amdgcn_permlane32_swap(__float_as_uint(ss), __float_as_uint(ss), false, false); ss = __uint_as_float(rr[0]) + __uint_as_float(rr[1]); }
        const float inv = rsqrtf(ss * (1.0f / 128.0f) + 1e-6f);
#pragma unroll
        for (int d0 = 0; d0 < 8; ++d0) { float x[8]; unpack8(*reinterpret_cast<const u32x4*>(&qr[d0]), x); const int dim = d0 * 16 + hi * 8;
            const f32x4 g0 = *(const f32x4*)(qg + dim), g1 = *(const f32x4*)(qg + dim + 4);
#pragma unroll
            for (int e = 0; e < 4; ++e) { x[e] = x[e] * inv * g0[e]; x[4 + e] = x[4 + e] * inv * g1[e]; }
            if (ropeC != nullptr) { const int to = (t0 + wid * 32 + r32) * 64 + (dim >> 1); rope8(x, ropeC + to, ropeS + to); }
            const u32x4 w = pack8(x); qr[d0] = *reinterpret_cast<const bf16x8*>(&w); }
    }
    if constexpr (C::PE) {
#pragma unroll
        for (int d1 = 0; d1 < C::ND - C::NDR; ++d1) {
            u32x4 f = qp[d1];
            if (C::NDR + d1 >= 8 && ropeC != nullptr) {
                const int pe = C::NDR + d1 - 8; const int to = (t0 + wid * 32 + r32) * 32 + pe * 8 + hi * 4;
                float x[8]; unpack8(f, x); rope8(x, ropeC + to, ropeS + to); f = pack8(x); }
            *reinterpret_cast<u32x4*>(Qpe + d1 * 1024) = f; }
    }
    if constexpr (SD == 2) { if constexpr (C::PE) asm volatile("s_waitcnt vmcnt(5)" ::: "memory"); else asm volatile("s_waitcnt vmcnt(4)" ::: "memory"); } else asm volatile("s_waitcnt vmcnt(0)" ::: "memory");
    SWRITE(0, SE);
    if constexpr (SD == 1) SLOAD(SO, 64); else { if (2 < NTl) SLOAD(SE, 2 * 64); }
    __syncthreads();
    qkt<C>(pA0, pA1, K_lds, P_lds, qr, Qpe, r32, hi); partialSM<C>(pA0, pA1, m_reg, mnA, alA);
    SWAIT(); SWRITE(1, SO); if constexpr (SD == 1) { if (2 < NTl) SLOAD(SO, 2 * 64); } __syncthreads();
    for (int j = 1; j + 1 < NTl; j += 2) {
        SBAR(); qkt<C>(pB0, pB1, K_lds + SHM_K, P_lds + SHM_P, qr, Qpe, r32, hi);
        finishSM(pA0, pA1, alA, l_reg, pa0, pa1, pa2, pa3); qk_pipe<C>(); SBAR();
        if constexpr (SD == 2) SLOAD(SO, (j + SD) * 64); SBAR();
        pv_psm<C>(o, vb0, pa0, pa1, pa2, pa3, pB0, pB1, m_reg, mnB, alB);
        __syncthreads(); SWAIT(); SWRITE(0, SE); if constexpr (SD == 1) SLOAD(SE, (j + 2) * 64);
        RESC(alB); __syncthreads();
        SBAR(); qkt<C>(pA0, pA1, K_lds, P_lds, qr, Qpe, r32, hi);
        finishSM(pB0, pB1, alB, l_reg, pa0, pa1, pa2, pa3); qk_pipe<C>(); SBAR();
        if constexpr (SD == 2) { if (j + 3 < NTl) SLOAD(SE, (j + 1 + SD) * 64); } SBAR();
        pv_psm<C>(o, vb0 + (int)SHM_V, pa0, pa1, pa2, pa3, pA0, pA1, m_reg, mnA, alA);
        __syncthreads(); SWAIT(); SWRITE(1, SO); if constexpr (SD == 1) { if (j + 3 < NTl) SLOAD(SO, (j + 3) * 64); }
        RESC(alA); __syncthreads();
    }
    SBAR(); qkt<C>(pB0, pB1, K_lds + SHM_K, P_lds + SHM_P, qr, Qpe, r32, hi);
    finishSM(pA0, pA1, alA, l_reg, pa0, pa1, pa2, pa3); SBAR();
    const int widu = __builtin_amdgcn_readfirstlane(wid);
    const char* Gw = (const char*)(Gb + (long)(widu * 32) * C::LDG); char* Ow = (char*)(Ob + (long)(widu * 32) * C::LDO);
    asm volatile("" : "+s"(Gw));
    u32x4 gq[8];
#pragma unroll
    for (int i = 0; i < 8; ++i) { const int ch = i * 64 + lane; gq[i] = *(const GAS u32x4*)((const GAS char*)Gw + (unsigned)((ch >> 4) * C::LDG * 2 + (ch & 15) * 16)); }
    SBAR();
    pv_psm<C>(o, vb0, pa0, pa1, pa2, pa3, pB0, pB1, m_reg, mnB, alB);
    __syncthreads(); RESC(alB);
    finishSM(pB0, pB1, alB, l_reg, pa0, pa1, pa2, pa3); SBAR();
    pv_d0(o, vb0 + (int)SHM_V, pa0, pa1, pa2, pa3);
    if constexpr (XP) {
        static_assert(!XP || (SD == 1 && C::PE && C::NDR == 8 && C::ND == 12), "cross-unit prefetch is written for the MLA configuration");
        {
            int t2 = tid; asm volatile("" : "+v"(t2));
            const int w2 = t2 >> 6, l2 = t2 & 63, sr2 = t2 >> 4, sc2 = (t2 & 15) * 8, pr2 = t2 >> 3, pc2 = (t2 & 7) * 8;
            const bf16_t* nQw = nxt.Q + (long)(w2 * 32 + (l2 & 31)) * C::LDQ + (l2 >> 5) * 8;
#pragma unroll
            for (int d0 = 0; d0 < C::NDR; ++d0) pre->q[d0] = *reinterpret_cast<const bf16x8*>(nQw + d0 * 16);
#pragma unroll
            for (int d1 = 0; d1 < C::ND - C::NDR; ++d1) pre->qp[d1] = *reinterpret_cast<const u32x4*>(nQw + (C::NDR + d1) * 16);
            pre->vs0 = *reinterpret_cast<const bf16x8*>(&nxt.V[(long)sr2 * C::LDV + sc2]); pre->vs1 = *reinterpret_cast<const bf16x8*>(&nxt.V[(long)(32 + sr2) * C::LDV + sc2]);
            pre->ks0 = *reinterpret_cast<const bf16x8*>(&nxt.K[(long)sr2 * C::LDK + sc2]); pre->ks1 = *reinterpret_cast<const bf16x8*>(&nxt.K[(long)(32 + sr2) * C::LDK + sc2]);
            pre->ps = *reinterpret_cast<const bf16x8*>(&nxt.P[(long)pr2 * 64 + pc2]);
        }
    }
    if (hi == 0) li_l[r32] = l_reg; asm volatile("s_waitcnt lgkmcnt(0)" ::: "memory");
    float rli[16];
#pragma unroll
    for (int r = 0; r < 16; ++r) rli[r] = __builtin_amdgcn_rcpf(li_l[crow(r, hi)]);
    __builtin_amdgcn_s_setprio(0);
    __syncthreads();
    int te = tid; asm volatile("" : "+v"(te));
    const int lane_e = te & 63, r32e = te & 31, hie = (te >> 5) & 1;
    char* Ost = lds + (te >> 6) * 8192;
#pragma unroll
    for (int r = 0; r < 16; ++r)
#pragma unroll
        for (int d0 = 0; d0 < 4; ++d0) *(bf16_t*)(Ost + crow(r, hie) * 256 + (d0 * 32 + r32e) * 2) = (bf16_t)(cvt_pk_bf16(o[d0][r] * rli[r], 0.f) & 0xffffu);
    asm volatile("s_waitcnt lgkmcnt(0)" ::: "memory");
#pragma unroll
    for (int i = 0; i < 8; ++i) { const int ch = i * 64 + lane_e; const int row = ch >> 4, c8 = ch & 15;
        float ov[8], gvv[8]; unpack8(*(const u32x4*)(Ost + row * 256 + c8 * 16), ov); unpack8(gq[i], gvv);
#pragma unroll
        for (int e = 0; e < 8; ++e) ov[e] *= silu_f(gvv[e]);
        *(u32x4*)(Ow + (unsigned)(row * C::LDO * 2 + c8 * 16)) = pack8(ov); if constexpr (XP) SBAR(); }
#undef SLOAD
#undef GAS
#undef SWRITE
#undef SWAIT
#undef RESC
}

constexpr int SLOT_BYTES = 18688;
#define LFENCE() asm volatile("s_waitcnt lgkmcnt(0)" ::: "memory")
#ifdef USE_LF2
#define LF2() __builtin_amdgcn_sched_barrier(0)
#else
#define LF2() do {} while (0)
#endif
__device__ __forceinline__ float ldf(const float* base, unsigned boff) { return *(const float*)((const char*)base + boff); }
__device__ __forceinline__ void stf(float* base, unsigned boff, float v) { *(float*)((char*)base + boff) = v; }
struct Chain { const bf16_t* Rb; const bf16_t* KKb; const bf16_t* Vb; const bf16_t* Wd; const bf16_t* Ad; const bf16_t* Kb; bf16_t* Yd; float k_a; int row0, T, h, d; };
__device__ __forceinline__ unsigned chain_eoff(const Chain& c, int step, int col) { const int row = c.row0 + (c.d ? c.T - 1 - step : step); return ((unsigned)row * (unsigned)AW + (unsigned)col) * 4u; }

struct ScanOps { float w[16], ka[16], b[16], k[16], r[16], v[16]; };
struct ScanStage { u32x4 st[6][2]; };
__device__ __forceinline__ void scanA_issue(const Chain& c, int chunk, int lane_, ScanStage& g) {
    int lane = lane_; asm volatile("" : "+v"(lane));
    const bf16_t* arr[6] = {c.Wd, c.KKb, c.Ad, c.Kb, c.Rb, c.Vb};
#pragma unroll
    for (int k2 = 0; k2 < 2; ++k2) { const int idx = lane + 64 * k2, tau = idx >> 3, q = idx & 7; const int step = chunk * 16 + tau;
        const int row = c.row0 + (c.d ? c.T - 1 - step : step); const unsigned boff = ((unsigned)row * (unsigned)AW + (unsigned)(c.h * 64 + q * 8)) * 2u;
#pragma unroll
        for (int a = 0; a < 6; ++a) g.st[a][k2] = *(const u32x4*)((const char*)arr[a] + boff); }
}
__device__ __forceinline__ void scanA_unpack(const ScanStage& g, int lane_, char* slot, ScanOps& o) {
    int lane = lane_; asm volatile("" : "+v"(lane));
#pragma unroll
    for (int k2 = 0; k2 < 2; ++k2) { const int idx = lane + 64 * k2;
#pragma unroll
        for (int a = 0; a < 6; ++a) *(u32x4*)(slot + a * 2048 + idx * 16) = g.st[a][k2]; }
    asm volatile("s_waitcnt lgkmcnt(0)" ::: "memory");
#pragma unroll
    for (int t = 0; t < 16; ++t) { const char* e = slot + t * 128 + lane * 2;
        o.w[t] = bf2f(*(const bf16_t*)(e)); o.ka[t] = bf2f(*(const bf16_t*)(e + 2048)); o.b[t] = bf2f(*(const bf16_t*)(e + 4096));
        o.k[t] = bf2f(*(const bf16_t*)(e + 6144)); o.r[t] = bf2f(*(const bf16_t*)(e + 8192)); o.v[t] = bf2f(*(const bf16_t*)(e + 10240)); }
    asm volatile("s_waitcnt lgkmcnt(0)" ::: "memory");
}
__device__ __forceinline__ void scanA(const Chain& c, int chunk, const ScanOps& o, int lane_, char* slot) {
    int lane = lane_; asm volatile("" : "+v"(lane));
    float bt[16], kq[16]; float gL;
    float vv[16];
#pragma unroll
    for (int t = 0; t < 16; ++t) vv[t] = o.v[t];
    {
        float kt[16], rt[16]; float g = 1.0f;
        float cu = 0.f;
#pragma unroll
        for (int t = 0; t < 16; ++t) { const float gp = g; cu += o.w[t]; g = __builtin_amdgcn_exp2f(cu); const float ig = __builtin_amdgcn_exp2f(-cu);
            const float av = o.b[t], bb = o.ka[t] * av, kd = o.k[t] * (1.0f + (av - 1.0f) * c.k_a);
            kt[t] = o.ka[t] * gp; rt[t] = o.r[t] * g; bt[t] = bb * ig; kq[t] = kd * ig; }
        gL = g;
#pragma unroll
        for (int t = 0; t < 16; ++t) {
            const int o0 = t * 128 + ((lane * 2) ^ ((t & 7) << 4)), o1 = (16 + t) * 128 + ((lane * 2) ^ ((t & 7) << 4));
            *(bf16_t*)(slot + o0) = (bf16_t)(cvt_pk_bf16(bt[t], 0.f) & 0xffffu); *(bf16_t*)(slot + o1) = (bf16_t)(cvt_pk_bf16(kq[t], 0.f) & 0xffffu);
            *(bf16_t*)(slot + 8192 + o0) = (bf16_t)(cvt_pk_bf16(kt[t], 0.f) & 0xffffu); *(bf16_t*)(slot + 8192 + o1) = (bf16_t)(cvt_pk_bf16(rt[t], 0.f) & 0xffffu);
        }
#pragma unroll
        for (int q = 0; q < 2; ++q) {
            *(u32x4*)(slot + 12544 + lane * 64 + 16 * q) = (u32x4){cvt_pk_bf16(kt[8 * q], kt[8 * q + 1]), cvt_pk_bf16(kt[8 * q + 2], kt[8 * q + 3]), cvt_pk_bf16(kt[8 * q + 4], kt[8 * q + 5]), cvt_pk_bf16(kt[8 * q + 6], kt[8 * q + 7])};
            *(u32x4*)(slot + 12544 + lane * 64 + 32 + 16 * q) = (u32x4){cvt_pk_bf16(rt[8 * q], rt[8 * q + 1]), cvt_pk_bf16(rt[8 * q + 2], rt[8 * q + 3]), cvt_pk_bf16(rt[8 * q + 4], rt[8 * q + 5]), cvt_pk_bf16(rt[8 * q + 6], rt[8 * q + 7])};
        }

        *(float*)(slot + 12288 + lane * 4) = gL;
    }
    LFENCE();
    const int m = lane & 31, hi = lane >> 5;
    {
        f32x16 C = {};
#pragma unroll
        for (int ks = 0; ks < 4; ++ks) { const int o = m * 128 + (((2 * ks + hi) ^ (m & 7)) << 4);
            const bf16x8 a = *(const bf16x8*)(slot + o), b = *(const bf16x8*)(slot + 8192 + o);
            C = __builtin_amdgcn_mfma_f32_32x32x16_bf16(a, b, C, 0, 0, 0); }
        LFENCE();
#pragma unroll
        for (int r = 0; r < 16; ++r) *(float*)(slot + (crow(r, hi) * 32 + m) * 4) = C[r];
    }
    LFENCE();
    const float* G = (const float*)slot; float* Tm = (float*)(slot + 8192); float* Wm = (float*)(slot + 6144);
    char* B1T = slot + 9216; char* B2T = slot + 11264;
    {
        const int tcol = lane & 15, sq = lane >> 4;
        float Tc[16];
#pragma unroll
        for (int s = 0; s < 16; ++s) Tc[s] = (s == tcol) ? 1.0f : 0.0f;
#pragma unroll
        for (int s = 14; s >= 0; --s) {
            float a = 0.f;
#pragma unroll
            for (int q = (s + 1) / 4; q < 4; ++q) { const f32x4 gr = *(const f32x4*)(G + s * 32 + 4 * q);
#pragma unroll
                for (int e = 0; e < 4; ++e) if (4 * q + e > s) a += gr[e] * Tc[4 * q + e]; }
            if (s < tcol) Tc[s] = -a;
        }
        if (lane < 16) {
#pragma unroll
            for (int s = 0; s < 16; ++s) Tm[s * 16 + tcol] = Tc[s];
            const u32x4 z4 = (u32x4){0u, 0u, 0u, 0u};
            *(u32x4*)(B1T + tcol * 64) = (u32x4){cvt_pk_bf16(Tc[0], Tc[1]), cvt_pk_bf16(Tc[2], Tc[3]), cvt_pk_bf16(Tc[4], Tc[5]), cvt_pk_bf16(Tc[6], Tc[7])};
            *(u32x4*)(B1T + tcol * 64 + 16) = (u32x4){cvt_pk_bf16(Tc[8], Tc[9]), cvt_pk_bf16(Tc[10], Tc[11]), cvt_pk_bf16(Tc[12], Tc[13]), cvt_pk_bf16(Tc[14], Tc[15])};
            *(u32x4*)(B1T + tcol * 64 + 32) = z4; *(u32x4*)(B1T + tcol * 64 + 48) = z4;
            const unsigned one = (tcol & 1) ? 0x3F800000u : 0x00003F80u; const int wi = tcol >> 1;
            *(u32x4*)(B1T + (16 + tcol) * 64 + 32) = (u32x4){wi == 0 ? one : 0u, wi == 1 ? one : 0u, wi == 2 ? one : 0u, wi == 3 ? one : 0u};
            *(u32x4*)(B1T + (16 + tcol) * 64 + 48) = (u32x4){wi == 4 ? one : 0u, wi == 5 ? one : 0u, wi == 6 ? one : 0u, wi == 7 ? one : 0u};
        }
        float Wv[4];
#pragma unroll
        for (int si = 0; si < 4; ++si) { const int s = 4 * sq + si; float a = 0.f;
#pragma unroll
            for (int q = 0; q < 4; ++q) { const f32x4 gr = *(const f32x4*)(G + (16 + s) * 32 + 4 * q);
#pragma unroll
                for (int e = 0; e < 4; ++e) a += ((4 * q + e > s) ? gr[e] : 0.f) * Tc[4 * q + e]; }
            Wv[si] = a; Wm[s * 16 + tcol] = a; }
        *(u32x2*)(B2T + tcol * 32 + 8 * sq) = (u32x2){cvt_pk_bf16(Wv[0], Wv[1]), cvt_pk_bf16(Wv[2], Wv[3])};
        LFENCE();
        float nb[16];
#pragma unroll
        for (int u = 0; u < 16; ++u) { const float x = G[u * 32 + 16 + tcol]; nb[u] = (u <= tcol) ? x : 0.f; }
        float Zv[4], Nv[4];
#pragma unroll
        for (int si = 0; si < 4; ++si) { const int s = 4 * sq + si; const float nk = G[(16 + s) * 32 + 16 + tcol]; float a = (s <= tcol) ? nk : 0.f; float tn = 0.f;
#pragma unroll
            for (int q = 0; q < 4; ++q) { const f32x4 wr = *(const f32x4*)(Wm + s * 16 + 4 * q); const f32x4 tr = *(const f32x4*)(Tm + s * 16 + 4 * q);
#pragma unroll
                for (int e = 0; e < 4; ++e) { a -= wr[e] * nb[4 * q + e]; tn += tr[e] * nb[4 * q + e]; } }
            Zv[si] = a; Nv[si] = -tn; }
        *(u32x2*)(B2T + (16 + tcol) * 32 + 8 * sq) = (u32x2){cvt_pk_bf16(Zv[0], Zv[1]), cvt_pk_bf16(Zv[2], Zv[3])};
        *(u32x2*)(B1T + (16 + tcol) * 64 + 8 * sq) = (u32x2){cvt_pk_bf16(Nv[0], Nv[1]), cvt_pk_bf16(Nv[2], Nv[3])};
    }
    LFENCE();
    {
        f32x16 C0 = {}, C1 = {};
#pragma unroll
        for (int ks = 0; ks < 2; ++ks) { const bf16x8 b = *(const bf16x8*)(B1T + m * 64 + (16 * ks + 8 * hi) * 2);
            C0 = __builtin_amdgcn_mfma_f32_32x32x16_bf16(*(const bf16x8*)(slot + 12544 + m * 64 + (16 * ks + 8 * hi) * 2), b, C0, 0, 0, 0);
            C1 = __builtin_amdgcn_mfma_f32_32x32x16_bf16(*(const bf16x8*)(slot + 12544 + (32 + m) * 64 + (16 * ks + 8 * hi) * 2), b, C1, 0, 0, 0); }
        LFENCE();
        const int tile = m >> 4, t = m & 15;
#pragma unroll
        for (int half = 0; half < 2; ++half) { const int gq = 2 * half + hi;
            *(u32x4*)(slot + ((tile * 2 + 0) * 64 + t + 16 * gq) * 16) = (u32x4){cvt_pk_bf16(C0[4 * half], C0[4 * half + 1]), cvt_pk_bf16(C0[4 * half + 2], C0[4 * half + 3]),
                                                                             cvt_pk_bf16(C0[4 * half + 8], C0[4 * half + 9]), cvt_pk_bf16(C0[4 * half + 10], C0[4 * half + 11])};
            *(u32x4*)(slot + ((tile * 2 + 1) * 64 + t + 16 * gq) * 16) = (u32x4){cvt_pk_bf16(C1[4 * half], C1[4 * half + 1]), cvt_pk_bf16(C1[4 * half + 2], C1[4 * half + 3]),
                                                                             cvt_pk_bf16(C1[4 * half + 8], C1[4 * half + 9]), cvt_pk_bf16(C1[4 * half + 10], C1[4 * half + 11])}; }
    }
#pragma unroll
    for (int q = 0; q < 2; ++q)
        *(u32x4*)(slot + 16640 + lane * 32 + 16 * q) = (u32x4){cvt_pk_bf16(vv[8 * q], vv[8 * q + 1]), cvt_pk_bf16(vv[8 * q + 2], vv[8 * q + 3]), cvt_pk_bf16(vv[8 * q + 4], vv[8 * q + 5]), cvt_pk_bf16(vv[8 * q + 6], vv[8 * q + 7])};
    LFENCE();
    {
        const bf16x8 b = *(const bf16x8*)(B2T + m * 32 + 8 * hi * 2);
        const f32x16 z16 = {};
        const f32x16 C0 = __builtin_amdgcn_mfma_f32_32x32x16_bf16(*(const bf16x8*)(slot + 16640 + m * 32 + 8 * hi * 2), b, z16, 0, 0, 0);
        const f32x16 C1 = __builtin_amdgcn_mfma_f32_32x32x16_bf16(*(const bf16x8*)(slot + 16640 + (32 + m) * 32 + 8 * hi * 2), b, z16, 0, 0, 0);
        LFENCE();
        char* dst = slot + (m < 16 ? 8192 : 12544) + (m & 15) * 4;
#pragma unroll
        for (int r = 0; r < 16; ++r) { *(float*)(dst + crow(r, hi) * 64) = C0[r]; *(float*)(dst + (32 + crow(r, hi)) * 64) = C1[r]; }
    }
#pragma unroll
    for (int g4 = 0; g4 < 4; ++g4) {
        u32x4 w; w.x = cvt_pk_bf16(kq[4 * g4] * gL, kq[4 * g4 + 1] * gL); w.y = cvt_pk_bf16(kq[4 * g4 + 2] * gL, kq[4 * g4 + 3] * gL);
        w.z = cvt_pk_bf16(-bt[4 * g4] * gL, -bt[4 * g4 + 1] * gL); w.w = cvt_pk_bf16(-bt[4 * g4 + 2] * gL, -bt[4 * g4 + 3] * gL);
        *(u32x4*)(slot + 4096 + ((lane >> 4) * 64 + (lane & 15) + 16 * g4) * 16) = w;
    }
}

__device__ __forceinline__ void scanB(const Chain& c, int chunk, int lane_, int sl, const char* slot, f32x4 (&acc)[4]) {
    int lane = lane_; asm volatile("" : "+v"(lane));
    const int n = lane & 15, g = lane >> 4; const int col = c.h * 64 + 16 * sl + n;
    unsigned offs[4]; const int estride = c.d ? -AW * 4 : AW * 4; const unsigned e0 = chain_eoff(c, chunk * 16 + 4 * g, col);
#pragma unroll
    for (int e = 0; e < 4; ++e) offs[e] = e0 + (unsigned)(e * estride);
    const u32x2 vq2 = *(const u32x2*)(slot + 16640 + (16 * sl + n) * 32 + 8 * g);

    bf16x8 bfr[2];
#pragma unroll
    for (int s = 0; s < 2; ++s) { u32x4 w; w.x = cvt_pk_bf16(acc[2 * s][0], acc[2 * s][1]); w.y = cvt_pk_bf16(acc[2 * s][2], acc[2 * s][3]);
        w.z = cvt_pk_bf16(acc[2 * s + 1][0], acc[2 * s + 1][1]); w.w = cvt_pk_bf16(acc[2 * s + 1][2], acc[2 * s + 1][3]); bfr[s] = *reinterpret_cast<bf16x8*>(&w); }
    f32x4 aU = *(const f32x4*)(slot + 8192 + (16 * sl + n) * 64 + 16 * g);
    f32x4 aY = *(const f32x4*)(slot + 12544 + (16 * sl + n) * 64 + 16 * g);
#pragma unroll
    for (int s = 0; s < 2; ++s) {
        aU = __builtin_amdgcn_mfma_f32_16x16x32_bf16(*(const bf16x8*)(slot + ((0 * 2 + s) * 64 + lane) * 16), bfr[s], aU, 0, 0, 0);
        aY = __builtin_amdgcn_mfma_f32_16x16x32_bf16(*(const bf16x8*)(slot + ((1 * 2 + s) * 64 + lane) * 16), bfr[s], aY, 0, 0, 0);
    }
#pragma unroll
    for (int e = 0; e < 4; ++e) *(bf16_t*)((char*)c.Yd + (offs[e] >> 1)) = (bf16_t)(cvt_pk_bf16(aY[e], 0.f) & 0xffffu);
    bf16x8 b2; { u32x4 w; w.x = vq2.x; w.y = vq2.y; w.z = cvt_pk_bf16(aU[0], aU[1]); w.w = cvt_pk_bf16(aU[2], aU[3]); b2 = *reinterpret_cast<bf16x8*>(&w); }
#pragma unroll
    for (int tl = 0; tl < 4; ++tl) { const f32x4 gm = *(const f32x4*)(slot + 12288 + (16 * tl + 4 * g) * 4);
        acc[tl] = __builtin_amdgcn_mfma_f32_16x16x32_bf16(*(const bf16x8*)(slot + 4096 + (tl * 64 + lane) * 16), b2, acc[tl] * gm, 0, 0, 0); }
}

__device__ __forceinline__ void scan_pair(KP p, bool samp, int q, char* lds) {
    int tid_ = TIDX; asm volatile("" : "+v"(tid_));
    const int lane = tid_ & 63, wave = __builtin_amdgcn_readfirstlane(tid_ >> 6), grp = wave >> 2, sl = wave & 3;
    unsigned char* ws = p->ws;
    const int ci = 2 * q + grp, b = ci >> 6, h = (ci >> 1) & 31, d = ci & 1;
    Chain c; c.Rb = (const bf16_t*)(ws + WS_R); c.KKb = (const bf16_t*)(p->out + OUT_Y); c.Vb = (const bf16_t*)(p->out + OUT_Y + (size_t)NT * AW);
    c.Wd = (const bf16_t*)(ws + WS_WD + (size_t)d * 2 * SZA); c.Ad = (const bf16_t*)(ws + WS_WD + (size_t)d * 2 * SZA + SZA); c.Kb = (const bf16_t*)(ws + WS_K); c.k_a = p->in[I_KA][h * 64 + lane];
    c.Yd = (bf16_t*)(ws + WS_YA + (size_t)d * SZA); c.T = samp ? 2048 : 256; c.row0 = samp ? NP + b * 2048 : b * 256; c.h = h; c.d = d;
    const int n = lane & 15, g = lane >> 4;
    f32x4 acc[4];
    if (samp) { const float* s0 = p->in[I_STATE] + ((size_t)((b * 2 + d) * 32 + h)) * 4096 + (16 * sl + n) * 64 + 4 * g;
#pragma unroll
        for (int tl = 0; tl < 4; ++tl) acc[tl] = *(const f32x4*)(s0 + 16 * tl); }
    else {
#pragma unroll
        for (int tl = 0; tl < 4; ++tl) acc[tl] = (f32x4){0.f, 0.f, 0.f, 0.f}; }
    char* slots = lds + grp * 4 * SLOT_BYTES;
    const int NR = c.T / 64;
    ScanStage stg; scanA_issue(c, sl, lane, stg);
    for (int R = 0; R < NR; ++R) {
        { ScanOps ops; scanA_unpack(stg, lane, slots + sl * SLOT_BYTES, ops);
          if (R + 1 < NR) scanA_issue(c, 4 * (R + 1) + sl, lane, stg);
          scanA(c, 4 * R + sl, ops, lane, slots + sl * SLOT_BYTES); }
        asm volatile("s_waitcnt lgkmcnt(0)" ::: "memory"); __builtin_amdgcn_s_barrier(); asm volatile("" ::: "memory");
#pragma unroll
        for (int cc = 0; cc < 4; ++cc) scanB(c, 4 * R + cc, lane, sl, slots + cc * SLOT_BYTES, acc);
        asm volatile("s_waitcnt lgkmcnt(0)" ::: "memory"); __builtin_amdgcn_s_barrier(); asm volatile("" ::: "memory");
    }
    if (!samp) { float* so = p->out + OUT_STATE + ((size_t)((b * 2 + d) * 32 + h)) * 4096 + (16 * sl + n) * 64 + 4 * g;
#pragma unroll
        for (int tl = 0; tl < 4; ++tl) *(f32x4*)(so + 16 * tl) = acc[tl]; }
}

__device__ __forceinline__ void phase_scan_attn(KP p, char* lds) {
    unsigned char* ws = p->ws;
    unsigned* qhead = (unsigned*)(ws + WS_CTL) + 4096;
    bf16_t* projB = (bf16_t*)(ws + WS_PROJB); bf16_t* mixed = (bf16_t*)(ws + WS_MIXED);
#ifdef STATIC_Q
    for (int item = blockIdx.x; item < 1408; item += gridDim.x) {
        __syncthreads();
#else
    for (;;) {
        unsigned qa = LDS_X + 64; asm volatile("" : "+s"(qa));
        volatile LAS unsigned* qslot = (volatile LAS unsigned*)(LAS char*)(uintptr_t)qa;
        __syncthreads();
        if (TIDX == 0) *qslot = __hip_atomic_fetch_add(qhead, 1u, __ATOMIC_RELAXED, __HIP_MEMORY_SCOPE_AGENT);
        __syncthreads();
        const int item = (int)__builtin_amdgcn_readfirstlane(*qslot);
        if (item >= 1408) break;
#endif
#ifndef Q_NO_SCAN
        if (item < 128) scan_pair(p, true, item, lds); else
#endif
#ifndef Q_NO_ATTN
        if (item < 640) { const int su = item - 128;
            const int b = su >> 7, h = (su >> 3) & 15, qb = su & 7; const size_t row0 = (size_t)NP + b * 2048 + qb * 256; const size_t k0 = ((size_t)b * 2304) * 512 + (h >> 2) * 128;
            attn_body<CfgGqa>(projB + row0 * N1B + 2048 + h * 128, (const bf16_t*)(ws + WS_KBS) + k0, (const bf16_t*)(ws + WS_VBS) + k0, nullptr,
                              mixed + row0 * DM + 2048 + h * 128, projB + row0 * N1B + 5120 + h * 128, 2304, lds, (const float*)(ws + WS_ROPEB_COS), (const float*)(ws + WS_ROPEB_SIN), qb * 256, p->in[I_QG]); }
        else
#endif
#ifndef Q_NO_SCAN
        if (item < 1152) scan_pair(p, false, item - 640, lds); else
#endif
#ifndef Q_NO_ATTN
        { const int pu = item - 1152;
            const int b = pu >> 4, h = pu & 15; const size_t row0 = (size_t)b * 256; const size_t k0 = row0 * 512 + (h >> 2) * 128;
            attn_body<CfgGqa>(projB + row0 * N1B + 2048 + h * 128, (const bf16_t*)(ws + WS_KBP) + k0, (const bf16_t*)(ws + WS_VBP) + k0, nullptr,
                              mixed + row0 * DM + 2048 + h * 128, projB + row0 * N1B + 5120 + h * 128, 256, lds, nullptr, nullptr, 0, p->in[I_QG]); }
#else
        {}
#endif
    }
}

__device__ __forceinline__ void phase_mix(KP p) {
    unsigned char* ws = p->ws;
    const int lane = TIDX & 63, wave = TIDX >> 6, gw = blockIdx.x * 8 + wave, nw = gridDim.x * 8;
    const bf16_t* Y0 = (const bf16_t*)(ws + WS_YA); const bf16_t* Y1 = (const bf16_t*)(ws + WS_YA + SZA);
    const bf16_t* Rb = (const bf16_t*)(ws + WS_R); const bf16_t* Vb = (const bf16_t*)(p->out + OUT_Y + (size_t)NT * AW);
    const bf16_t* A0 = (const bf16_t*)(ws + WS_WD + SZA); const bf16_t* A1 = (const bf16_t*)(ws + WS_WD + 3 * SZA); const bf16_t* Kb = (const bf16_t*)(ws + WS_K); const float* k_a = p->in[I_KA];
    const bf16_t* projB = (const bf16_t*)(ws + WS_PROJB); bf16_t* mixed = (bf16_t*)(ws + WS_MIXED);
    const float* lnw = p->in[I_LNW]; const float* lnb = p->in[I_LNB]; const float* rk = p->in[I_RK];
    for (int row = gw; row < NT; row += nw) {
#pragma unroll
      for (int hh = 0; hh < 2; ++hh) {
        u32x4 qy0[4], qy1[4], qr[4], qk[4], qa0[4], qa1[4], qv[4], qg[4];
#pragma unroll
        for (int it = 2 * hh; it < 2 * hh + 2; ++it) { const int col = (lane + 64 * it) * 8; const size_t o = (size_t)row * AW + col;
            qy0[it] = *(const u32x4*)(Y0 + o); qy1[it] = *(const u32x4*)(Y1 + o); qr[it] = *(const u32x4*)(Rb + o); qk[it] = *(const u32x4*)(Kb + o);
            qa0[it] = *(const u32x4*)(A0 + o); qa1[it] = *(const u32x4*)(A1 + o); qv[it] = *(const u32x4*)(Vb + o); qg[it] = *(const u32x4*)(projB + (size_t)row * N1B + col); }
#pragma unroll
        for (int it = 2 * hh; it < 2 * hh + 2; ++it) { const int col = (lane + 64 * it) * 8;
            float y[8], t1[8], t2[8];
            unpack8(qy0[it], y); unpack8(qy1[it], t1);
            float sm = 0.f;
#pragma unroll
            for (int e = 0; e < 8; ++e) { y[e] += t1[e]; sm += y[e]; }
            sm += __shfl_xor(sm, 1); sm += __shfl_xor(sm, 2); sm += __shfl_xor(sm, 4);
            const float mean = sm * (1.0f / 64.0f); float vs = 0.f;
#pragma unroll
            for (int e = 0; e < 8; ++e) { y[e] -= mean; vs += y[e] * y[e]; }
            vs += __shfl_xor(vs, 1); vs += __shfl_xor(vs, 2); vs += __shfl_xor(vs, 4);
            const float rs = rsqrtf(vs * (1.0f / 64.0f) + 64e-5f);
            float rr[8], kk8[8]; unpack8(qr[it], rr); unpack8(qk[it], kk8); unpack8(qa0[it], t1); unpack8(qa1[it], t2);
            const f32x4 ka0 = *(const f32x4*)(k_a + col), ka1 = *(const f32x4*)(k_a + col + 4), rk0 = *(const f32x4*)(rk + col), rk1 = *(const f32x4*)(rk + col + 4);
            float bs = 0.f;
#pragma unroll
            for (int e = 0; e < 8; ++e) { const float kav = e < 4 ? ka0[e & 3] : ka1[e & 3], rkv = e < 4 ? rk0[e & 3] : rk1[e & 3];
                bs += rr[e] * kk8[e] * ((t1[e] + t2[e] - 2.0f) * kav + 2.0f) * rkv; }
            bs += __shfl_xor(bs, 1); bs += __shfl_xor(bs, 2); bs += __shfl_xor(bs, 4);
            float vv8[8], gg[8], ov[8]; unpack8(qv[it], vv8); unpack8(qg[it], gg);
            const f32x4 lw0 = *(const f32x4*)(lnw + col), lw1 = *(const f32x4*)(lnw + col + 4), lb0 = *(const f32x4*)(lnb + col), lb1 = *(const f32x4*)(lnb + col + 4);
#pragma unroll
            for (int e = 0; e < 8; ++e) { const float lw = e < 4 ? lw0[e & 3] : lw1[e & 3], lb = e < 4 ? lb0[e & 3] : lb1[e & 3];
                ov[e] = (y[e] * rs * lw + lb + vv8[e] * bs) * silu_f(gg[e]); }
            *(u32x4*)(mixed + (size_t)row * DM + col) = pack8(ov);
        }
        asm volatile("" ::: "memory");
      }
    }
}

__device__ __forceinline__ void phase_prepC(KP p) {
    unsigned char* ws = p->ws;
    const int lane = TIDX & 63, wave = TIDX >> 6, gw = blockIdx.x * 8 + wave, nw = gridDim.x * 8;
    const bf16_t* projC = (const bf16_t*)(ws + WS_PROJC); bf16_t* qn = (bf16_t*)(ws + WS_QN); bf16_t* ckv = (bf16_t*)(ws + WS_CKV); bf16_t* kpe = (bf16_t*)(ws + WS_KPE);
    const float* cosC = (const float*)(ws + WS_ROPEC_COS); const float* sinC = (const float*)(ws + WS_ROPEC_SIN);
    const float* qag = p->in[I_QAG]; const float* kvag = p->in[I_KVAG];
    for (int row = gw; row < NT + 1024; row += nw) {
        if (row >= NT) {
            const int cr = row - NT, b = cr >> 8, t = cr & 255; const size_t krow = (size_t)NP + b * 2304 + t;
            { const float* s = p->in[I_CCKV] + (size_t)cr * 512 + lane * 8; const f32x4 a = *(const f32x4*)s, c = *(const f32x4*)(s + 4);
              *(u32x4*)(ckv + krow * 512 + lane * 8) = (u32x4){cvt_pk_bf16(a[0], a[1]), cvt_pk_bf16(a[2], a[3]), cvt_pk_bf16(c[0], c[1]), cvt_pk_bf16(c[2], c[3])}; }
            if (lane < 32) { const f32x2 a = *(const f32x2*)(p->in[I_CKPE] + (size_t)cr * 64 + lane * 2); *(unsigned*)(kpe + krow * 64 + lane * 2) = cvt_pk_bf16(a[0], a[1]); }
            continue;
        }
        const bool samp = row >= NP; int b = 0, t = 0; if (samp) { const int rr = row - NP; b = rr >> 11; t = rr & 2047; }
        const size_t krow = samp ? (size_t)NP + b * 2304 + 256 + t : (size_t)row;
        const u32x2* pc = (const u32x2*)(projC + (size_t)row * N3C);
        {
            f32x4 v[6]; float ss = 0.f;
#pragma unroll
            for (int i = 0; i < 6; ++i) { v[i] = up4(pc[lane + 64 * i]); ss += (v[i][0] * v[i][0] + v[i][1] * v[i][1]) + (v[i][2] * v[i][2] + v[i][3] * v[i][3]); }
            ss = wave_sum(ss); const float inv = rsqrtf(ss * (1.0f / 1536.0f) + 1e-6f);
#pragma unroll
            for (int i = 0; i < 6; ++i) { const int c4 = lane + 64 * i; const f32x4 o = v[i] * inv * ((const f32x4*)qag)[c4];
                u32x2 w; w.x = cvt_pk_bf16(o[0], o[1]); w.y = cvt_pk_bf16(o[2], o[3]); *(u32x2*)(qn + (size_t)row * 1536 + c4 * 4) = w; }
        }
        {
            f32x4 v[2]; float ss = 0.f;
#pragma unroll
            for (int i = 0; i < 2; ++i) { v[i] = up4(pc[384 + lane + 64 * i]); ss += (v[i][0] * v[i][0] + v[i][1] * v[i][1]) + (v[i][2] * v[i][2] + v[i][3] * v[i][3]); }
            ss = wave_sum(ss); const float inv = rsqrtf(ss * (1.0f / 512.0f) + 1e-6f);
#pragma unroll
            for (int i = 0; i < 2; ++i) { const int c4 = lane + 64 * i; const f32x4 o = v[i] * inv * ((const f32x4*)kvag)[c4];
                u32x2 w; w.x = cvt_pk_bf16(o[0], o[1]); w.y = cvt_pk_bf16(o[2], o[3]); *(u32x2*)(ckv + krow * 512 + c4 * 4) = w;
                if (!samp) *(f32x4*)(p->out + OUT_CKV + (size_t)row * 512 + c4 * 4) = o; }
        }
        if (lane < 32) {
            const unsigned xw = *(const unsigned*)(projC + (size_t)row * N3C + 2048 + lane * 2); const f32x2 x = (f32x2){bf_lo(xw), bf_hi(xw)}; f32x2 o = x;
            if (samp) { const float c = cosC[t * 32 + lane], s = sinC[t * 32 + lane]; o[0] = x[0] * c - x[1] * s; o[1] = x[0] * s + x[1] * c; }
            else *(f32x2*)(p->out + OUT_KPE + (size_t)row * 64 + lane * 2) = x;
            *(unsigned*)(kpe + krow * 64 + lane * 2) = cvt_pk_bf16(o[0], o[1]);
        }
    }
}

__device__ __forceinline__ void phase_mla_attn(KP p, char* lds) {
    unsigned char* ws = p->ws; const int G = gridDim.x, bid = blockIdx.x;
    const bf16_t* q = (const bf16_t*)(ws + WS_Q); const bf16_t* kv = (const bf16_t*)(ws + WS_KV); const bf16_t* kpe = (const bf16_t*)(ws + WS_KPE);
    bf16_t* og = (bf16_t*)(ws + WS_OG); const bf16_t* gate = (const bf16_t*)(ws + WS_GATEB);
    const int vcu = (G % 8 == 0) ? (bid % 8) * (G / 8) + bid / 8 : bid;
    const int nS = vcu < 2048 ? (2048 - vcu + G - 1) / G : 0, nP = vcu < 1024 ? (1024 - vcu + G - 1) / G : 0;
    AttnPre pre; bool have = false;
    for (int i = 0; i < nS + nP; ++i) {
        const bf16_t *Qb, *Kb, *Vb, *Pb, *Gb; bf16_t* Ob; int seq, t0; const float *rc, *rs;
        AttnNext nx; nx.valid = (i + 1 < nS + nP);
        {   const int j = i;
            if (j < nS) { const int su = vcu + j * G; const int b = su >> 9, h = (su >> 3) & 63, qb = su & 7; const size_t row0 = (size_t)NP + b * 2048 + qb * 256, kr0 = (size_t)NP + b * 2304;
                Qb = q + row0 * 12288 + h * 192; Kb = kv + kr0 * 16384 + h * 256; Vb = Kb + 128; Pb = kpe + kr0 * 64; Ob = og + row0 * 8192 + h * 128; Gb = gate + row0 * 8192 + h * 128;
                seq = 2304; t0 = qb * 256; rc = (const float*)(ws + WS_ROPEC_COS); rs = (const float*)(ws + WS_ROPEC_SIN); }
            else { const int pu = vcu + (j - nS) * G; const int b = pu >> 6, h = pu & 63; const size_t row0 = (size_t)b * 256;
                Qb = q + row0 * 12288 + h * 192; Kb = kv + row0 * 16384 + h * 256; Vb = Kb + 128; Pb = kpe + row0 * 64; Ob = og + row0 * 8192 + h * 128; Gb = gate + row0 * 8192 + h * 128;
                seq = 256; t0 = 0; rc = nullptr; rs = nullptr; } }
        {   const int j = nx.valid ? i + 1 : i;
            if (j < nS) { const int su = vcu + j * G; const int b = su >> 9, h = (su >> 3) & 63, qb = su & 7; const size_t row0 = (size_t)NP + b * 2048 + qb * 256, kr0 = (size_t)NP + b * 2304;
                nx.Q = q + row0 * 12288 + h * 192; nx.K = kv + kr0 * 16384 + h * 256; nx.V = nx.K + 128; nx.P = kpe + kr0 * 64; }
            else { const int pu = vcu + (j - nS) * G; const int b = pu >> 6, h = pu & 63; const size_t row0 = (size_t)b * 256;
                nx.Q = q + row0 * 12288 + h * 192; nx.K = kv + row0 * 16384 + h * 256; nx.V = nx.K + 128; nx.P = kpe + row0 * 64; } }
        attn_body<CfgMla, true>(Qb, Kb, Vb, Pb, Ob, Gb, seq, lds, rc, rs, t0, nullptr, &pre, have, nx);
        have = nx.valid;
    }
}

__device__ __forceinline__ void phase_final(KP p) {
    const int lane = TIDX & 63, wave = TIDX >> 6, gw = blockIdx.x * 8 + wave, nw = gridDim.x * 8;
    const float* g = p->in[I_FINALG]; const bf16_t* x2 = (const bf16_t*)(p->ws + WS_Q);
    for (int row = gw; row < NT; row += nw) {
        const u32x2* x = (const u32x2*)(x2 + (size_t)row * DM); float* y = p->out + OUT_Y + (size_t)row * DM;
        f32x4 v[16]; float ss = 0.f;
#pragma unroll
        for (int i = 0; i < 16; ++i) { v[i] = up4(x[lane + 64 * i]); ss += v[i][0] * v[i][0] + v[i][1] * v[i][1] + v[i][2] * v[i][2] + v[i][3] * v[i][3]; }
        ss = wave_sum(ss);
        const float inv = rsqrtf(ss * (1.0f / 4096.0f) + 1e-6f);
#pragma unroll
        for (int i = 0; i < 16; ++i) { const int c4 = lane + 64 * i; ((f32x4*)y)[c4] = v[i] * inv * ((const f32x4*)g)[c4]; }
    }
}

__global__ void __launch_bounds__(512, 2) fwd(Params pv) {
    extern __shared__ __attribute__((aligned(16))) unsigned char lds[];
    LAS unsigned char* ldsl = (LAS unsigned char*)lds;
    volatile LAS unsigned* xbw = (volatile LAS unsigned*)(ldsl + LDS_X);
    if (threadIdx.x < 4) xbw[threadIdx.x] = 0u;
    if ((threadIdx.x & 63) == 0) *(volatile LAS unsigned*)(LAS char*)(uintptr_t)(TID_TAB_OFF + 4u * hw_wave_slot()) = threadIdx.x >> 6;
    __syncthreads();
    XcdBarrier bar; bar.bar = (unsigned*)(pv.ws + WS_CTL); bar.x = 0; bar.st = xbw;
    if (!MK_PER_PHASE) bar = xcd_barrier_post((unsigned*)(pv.ws + WS_CTL), xbw);
    const int lo = pv.ph_lo, hi = pv.ph_hi;
#ifndef PH_MASK
#define PH_MASK 0x7fff
#endif
#define IN(k) (((PH_MASK >> (k)) & 1) && lo <= (k) && (k) < hi)
#define SEAM(k) do { if (!MK_PER_PHASE && IN(k) && IN((k) + 1)) xcd_barrier(bar); } while (0)
#define PH_BEGIN KP p = get_params(); unsigned char* ws = p->ws; const int G = gridDim.x, bid = blockIdx.x; (void)ws; (void)G; (void)bid;

    if (IN(0)) { PH_BEGIN phase0(p, lds); } SEAM(0);
    if (IN(1)) { PH_BEGIN phase_h(p, 0, p->in[I_XP], p->in[I_XS], (bf16_t*)(ws + WS_H0)); } SEAM(1);
    if (IN(2)) { PH_BEGIN pg8::Gemm g{(const bf16_t*)(ws + WS_H0), (const bf16_t*)(ws + WS_WTA), NT, N1, DM}; pg8::StaticOrder S; S.init(NT, N1, G, bid);
        EpiG1 E{(bf16_t*)(ws + WS_PROJF), (bf16_t*)(ws + WS_PROJB)}; pg8::gemm_phase(ldsl, g, S, E);
        { const int extra = ((NT / 256) * (N1 / 256)) % G; if (bid >= extra) { phase_cvt1(p, lds, 0, G - extra, bid - extra); phase_cvt1(p, lds, 1, G - extra, bid - extra); } } } SEAM(2);
    if (IN(3)) { PH_BEGIN phase_prepA(p); } SEAM(3);
    if (IN(4)) { PH_BEGIN
#pragma unroll
        for (int d = 0; d < 2; ++d) {
            pg8::Gemm g{(const bf16_t*)(ws + WS_LORA) + (size_t)d * NT * 256, (const bf16_t*)(ws + WS_WTLORA) + (size_t)d * 4096 * 256, NT, 4096, 256}; pg8::StaticOrder S; S.init(NT, 4096, G, bid);
            EpiLora E{p->in[I_W0] + d * 2048, p->in[I_A0] + d * 2048, (bf16_t*)(ws + WS_WD + (size_t)d * 2 * SZA), (bf16_t*)(ws + WS_WD + (size_t)d * 2 * SZA + SZA)}; pg8::gemm_phase(ldsl, g, S, E);
        } } SEAM(4);
    if (IN(5)) { PH_BEGIN phase_scan_attn(p, (char*)lds); } SEAM(5);
    if (IN(6)) { PH_BEGIN phase_mix(p); } SEAM(6);
    if (IN(7)) { PH_BEGIN pg8::Gemm g{(const bf16_t*)(ws + WS_MIXED), (const bf16_t*)(ws + WS_WTOUT), NT, DM, DM}; pg8::StaticOrder S; S.init(NT, DM, G, bid);
        EpiRes<false> E{p->in[I_XP], p->in[I_XS], nullptr, (bf16_t*)(p->out + OUT_Y), (const float*)(ws + WS_MOD) + 8192}; pg8::gemm_phase(ldsl, g, S, E);
        } SEAM(7);
    if (IN(8)) { PH_BEGIN phase_h_bf(p, 1, (const bf16_t*)(p->out + OUT_Y), (bf16_t*)(ws + WS_H1)); } SEAM(8);
    if (IN(9)) { PH_BEGIN pg8::Gemm g{(const bf16_t*)(ws + WS_H1), (const bf16_t*)(ws + WS_WTC), NT, N3, DM}; pg8::StaticOrder S; S.init(NT, N3, G, bid);
        EpiG3 E{(bf16_t*)(ws + WS_GATEB), (bf16_t*)(ws + WS_PROJC)}; pg8::gemm_phase(ldsl, g, S, E);
        { const int extra = ((NT / 256) * (N3 / 256)) % G; if (extra != 0 && bid >= extra) phase_cvt1(p, lds, 2, G - extra, bid - extra); else if (extra == 0) phase_cvt1(p, lds, 2, G, bid); } } SEAM(9);
    if (IN(10)) { PH_BEGIN phase_prepC(p); } SEAM(10);
    if (IN(11)) { PH_BEGIN
        { pg8::Gemm g{(const bf16_t*)(ws + WS_QN), (const bf16_t*)(ws + WS_WTUQ), NT, 12288, 1536}; pg8::StaticOrder S; S.init(NT, 12288, G, bid);
          EpiBf16Plain E{(bf16_t*)(ws + WS_Q), 12288}; pg8::gemm_phase(ldsl, g, S, E); }
        { pg8::Gemm g{(const bf16_t*)(ws + WS_CKV), (const bf16_t*)(ws + WS_WTUKV), NKV, 16384, 512}; pg8::StaticOrder S; S.init(NKV, 16384, G, bid);
          EpiBf16Plain E{(bf16_t*)(ws + WS_KV), 16384}; pg8::gemm_phase(ldsl, g, S, E); }
    } SEAM(11);
    if (IN(12)) { PH_BEGIN phase_mla_attn(p, (char*)lds); } SEAM(12);
    if (IN(13)) { PH_BEGIN pg8::Gemm g{(const bf16_t*)(ws + WS_OG), (const bf16_t*)(ws + WS_WTCOUT), NT, DM, 8192}; pg8::StaticOrder S; S.init(NT, DM, G, bid);
        EpiRes<true> E{nullptr, nullptr, (const bf16_t*)(p->out + OUT_Y), (bf16_t*)(ws + WS_Q), (const float*)(ws + WS_MOD) + 5 * 12288 + 8192}; pg8::gemm_phase(ldsl, g, S, E); } SEAM(13);
    if (IN(14)) { PH_BEGIN phase_final(p); }
#undef IN
#undef SEAM
#undef PH_BEGIN
}

extern "C" void kernel_launch(void* const* d_in, const int* in_sizes, int n_in, void* d_out, int out_size, void* d_ws, size_t ws_size, hipStream_t stream) {
    static int grid = 0;
    if (grid == 0) {
        if (n_in != 33 || out_size != (int)OUT_TOTAL || ws_size < WS_NEED) { grid = -1; return; }
        int dev = 0, cus = 0;
        if (hipGetDevice(&dev) != hipSuccess || hipDeviceGetAttribute(&cus, hipDeviceAttributeMultiprocessorCount, dev) != hipSuccess) { grid = -1; return; }
        if (hipFuncSetAttribute((const void*)fwd, hipFuncAttributeMaxDynamicSharedMemorySize, LDS_BYTES) != hipSuccess) { grid = -1; return; }
        int per_cu = 0;
        if (hipOccupancyMaxActiveBlocksPerMultiprocessor(&per_cu, (const void*)fwd, 512, LDS_BYTES) != hipSuccess || per_cu < 1) { (void)hipGetLastError(); }
        grid = cus;
    }
    if (grid < 0) return;
    (void)hipMemsetAsync((char*)d_ws + WS_CTL, 0, 65536, stream);
    Params p{};
    for (int i = 0; i < 33; ++i) p.in[i] = (const float*)d_in[i];
    p.out = (float*)d_out; p.ws = (unsigned char*)d_ws;
#if MK_PER_PHASE
#ifndef PROBE_REP
#define PROBE_REP 0
#endif
    for (int k = 0; k < NPH; ++k) { p.ph_lo = k; p.ph_hi = k + 1; const int nrep = ((PROBE_REP >> k) & 1) ? 2 : 1;
        for (int r = 0; r < nrep; ++r) hipLaunchKernelGGL(fwd, dim3(grid), dim3(512), LDS_BYTES, stream, p); }
#else
    p.ph_lo = 0; p.ph_hi = NPH; hipLaunchKernelGGL(fwd, dim3(grid), dim3(512), LDS_BYTES, stream, p);
#endif
}
#ifdef TEST_ATTN
__global__ void __launch_bounds__(512, 2) t_attn(const bf16_t* Q, const bf16_t* K, const bf16_t* V, const bf16_t* P, bf16_t* O, const bf16_t* Gt, int seq) {
    extern __shared__ __attribute__((aligned(16))) unsigned char lds2[];
    attn_body<TEST_ATTN>(Q + (size_t)blockIdx.x * 256 * TEST_ATTN::LDQ, K, V, P, O + (size_t)blockIdx.x * 256 * TEST_ATTN::LDO, Gt + (size_t)blockIdx.x * 256 * TEST_ATTN::LDG, seq, (char*)lds2);
}
#endif
```

```cpp
#include <hip/hip_runtime.h>
#include <stdint.h>

#ifndef MK_PER_PHASE
#define MK_PER_PHASE 0
#endif

#define LAS __attribute__((address_space(3)))

#define TID_TAB_OFF (8 * 18688 + 128)
__device__ __forceinline__ int lane_id() { unsigned x; asm volatile("v_mbcnt_lo_u32_b32 %0, -1, 0\n\tv_mbcnt_hi_u32_b32 %0, -1, %0" : "=v"(x)); return (int)x; }
__device__ __forceinline__ unsigned hw_wave_slot() { return (unsigned)__builtin_amdgcn_s_getreg((5 << 11) | 4) & 63u; }
__device__ __forceinline__ int get_tid() {
    const unsigned w = *(const volatile LAS unsigned*)(LAS char*)(uintptr_t)(TID_TAB_OFF + 4u * hw_wave_slot());
    return (int)__builtin_amdgcn_readfirstlane(w) * 64 + lane_id();
}
#define TIDX get_tid()
typedef unsigned short bf16_t;
typedef short bf16x8 __attribute__((ext_vector_type(8)));
typedef short s16x4 __attribute__((ext_vector_type(4)));
typedef float f32x4 __attribute__((ext_vector_type(4)));
typedef float f32x2 __attribute__((ext_vector_type(2)));
typedef float f32x16 __attribute__((ext_vector_type(16)));
typedef unsigned u32x4 __attribute__((ext_vector_type(4)));
typedef unsigned u32x2 __attribute__((ext_vector_type(2)));

#define XB_TMO      128
#define XB_XCNT(j)  (256  + 64 * (j))
#define XB_XSUB(j)  (1280 + 64 * (j))
#define XB_XGEN(j)  (2304 + 64 * (j))
#define XB_TOP      3328
#define XB_TOPGEN   3392
#define XCD_BAR_WORDS 3456
#define XB_SPIN_CAP (1u << 22)

__device__ __forceinline__ unsigned xb_ld(unsigned* p)              { return __hip_atomic_load(p, __ATOMIC_RELAXED, __HIP_MEMORY_SCOPE_AGENT); }
__device__ __forceinline__ unsigned xb_add(unsigned* p, unsigned v) { return __hip_atomic_fetch_add(p, v, __ATOMIC_RELAXED, __HIP_MEMORY_SCOPE_AGENT); }
__device__ __forceinline__ unsigned xb_xcc_id() { return (unsigned)__builtin_amdgcn_s_getreg((3 << 11) | 20) & 0xFu; }
#define XB_SPIN(cond, bar) do { unsigned _sp = 0; while (cond) { __builtin_amdgcn_s_sleep(1); \
    if ((++_sp & 255u) == 0u) { if (xb_ld(&(bar)[XB_TMO])) break; if (_sp > XB_SPIN_CAP) { atomicAdd(&(bar)[XB_TMO], 1u); break; } } } } while (0)

struct XcdBarrier { unsigned* bar; unsigned x; volatile LAS unsigned* st; };

__device__ __forceinline__ XcdBarrier xcd_barrier_post(unsigned* bar, volatile LAS unsigned* st) {
    XcdBarrier b; b.bar = bar; b.x = xb_xcc_id(); b.st = st;
    if (TIDX == 0) (void)xb_add(&bar[XB_XCNT(b.x)], 1u);
    return b;
}
__device__ __forceinline__ void xcd_barrier_complete(unsigned* bar, unsigned x, unsigned& nloc, unsigned& nx) {
    const unsigned G = gridDim.x * gridDim.y * gridDim.z;
    unsigned sum, cnt, mine, sp = 0u;
    for (;;) {
        sum = 0u; cnt = 0u; mine = 0u;
#pragma unroll
        for (unsigned j = 0; j < 16; ++j) { const unsigned c = xb_ld(&bar[XB_XCNT(j)]); sum += c; cnt += (c > 0u) ? 1u : 0u; mine = (j == x) ? c : mine; }
        if (sum == G) break;
        __builtin_amdgcn_s_sleep(1);
        if ((++sp & 255u) == 0u) { if (xb_ld(&bar[XB_TMO])) break; if (sp > XB_SPIN_CAP) { atomicAdd(&bar[XB_TMO], 1u); break; } }
    }
    nloc = mine > 0u ? mine : 1u; nx = cnt > 0u ? cnt : 1u;
}
__device__ __forceinline__ void xcd_barrier(const XcdBarrier& b) {
    asm volatile("s_waitcnt vmcnt(0)" ::: "memory");
    __syncthreads();
    if (TIDX == 0) {
        unsigned* bar = b.bar;
        __builtin_amdgcn_s_waitcnt(0);
        unsigned nloc = b.st[0], nx = b.st[1];
        if (nloc == 0u) { xcd_barrier_complete(bar, b.x, nloc, nx); b.st[0] = nloc; b.st[1] = nx; }
        const unsigned old = xb_add(&bar[XB_XSUB(b.x)], 1u);
        const unsigned gen = old / nloc;
        if (old + 1u == (gen + 1u) * nloc) {
            __builtin_amdgcn_fence(__ATOMIC_RELEASE, "agent");
            asm volatile("s_waitcnt vmcnt(0)" ::: "memory");
            const unsigned og = xb_add(&bar[XB_TOP], 1u);
            const unsigned tg = og / nx;
            if (og + 1u == (tg + 1u) * nx) xb_add(&bar[XB_TOPGEN], 1u);
            else XB_SPIN(xb_ld(&bar[XB_TOPGEN]) == tg, bar);
            __builtin_amdgcn_fence(__ATOMIC_ACQUIRE, "agent");
            xb_add(&bar[XB_XGEN(b.x)], 1u);
            asm volatile("s_waitcnt vmcnt(0)" ::: "memory");
        } else {
            XB_SPIN(xb_ld(&bar[XB_XGEN(b.x)]) == gen, bar);
            __builtin_amdgcn_fence(__ATOMIC_ACQUIRE, "agent");
            asm volatile("s_waitcnt vmcnt(0)" ::: "memory");
        }
    }
    __syncthreads();
}

typedef __bf16 bf16v2 __attribute__((ext_vector_type(2)));
__device__ __forceinline__ unsigned cvt_pk_bf16(float lo, float hi) { f32x2 v = {lo, hi}; bf16v2 b = __builtin_convertvector(v, bf16v2); return __builtin_bit_cast(unsigned, b); }
__device__ __forceinline__ float bf_lo(unsigned w) { return __uint_as_float(w << 16); }
__device__ __forceinline__ float bf_hi(unsigned w) { return __uint_as_float(w & 0xffff0000u); }
__device__ __forceinline__ float bf2f(bf16_t b) { return __uint_as_float(((unsigned)b) << 16); }
__device__ __forceinline__ float ldh(const bf16_t* base, unsigned boff) { return bf2f(*(const bf16_t*)((const char*)base + boff)); }
__device__ __forceinline__ u32x2 pk4(const f32x4 v) { return (u32x2){cvt_pk_bf16(v[0], v[1]), cvt_pk_bf16(v[2], v[3])}; }
__device__ __forceinline__ f32x4 up4(const u32x2 w) { return (f32x4){bf_lo(w.x), bf_hi(w.x), bf_lo(w.y), bf_hi(w.y)}; }
__device__ __forceinline__ float sigmoid_f(float x) { return __builtin_amdgcn_rcpf(1.0f + __expf(-x)); }
__device__ __forceinline__ float silu_f(float x) { return x * __builtin_amdgcn_rcpf(1.0f + __expf(-x)); }
__device__ __forceinline__ float wave_sum(float v) {
#pragma unroll
    for (int o = 32; o >= 1; o >>= 1) v += __shfl_xor(v, o);
    return v;
}
__device__ __forceinline__ float sum16(float v) {
#pragma unroll
    for (int o = 8; o >= 1; o >>= 1) v += __shfl_xor(v, o);
    return v;
}

namespace pg8 {
constexpr int BM = 256, BK = 64, HALF = 128, HTB = HALF * BK * 2, STAGE_BYTES = 8 * HTB, NXCD = 8, WGM = 8;
__host__ __device__ __forceinline__ int lds_byte(int r, int c) { const int st = (r >> 4) * 2 + (c >> 5), rr = r & 15, cc = c & 31, ob = rr * 64 + cc * 2; return st * 1024 + (ob ^ (((ob >> 9) & 1) << 5)); }
__host__ __device__ __forceinline__ void stage_rc(int b, int& R, int& C) { const int st = b / 1024, sb = b % 1024, swz = sb ^ (((sb >> 9) & 1) << 5); R = (st >> 1) * 16 + swz / 64; C = (st & 1) * 32 + (swz % 64) / 2; }
__host__ __device__ __forceinline__ int perm32(int rho) { const int n = rho >> 4, i = rho & 15; return 8 * (i >> 2) + 4 * n + (i & 3); }
struct Unit { int pm, pn; };
struct Gemm { const bf16_t* A; const bf16_t* Bt; int M, N, K; };
struct StaticOrder {
    int nM, nN, nwg, G, c;
    __host__ __device__ void init(int M, int N, int G_, int c_) { nM = M / BM; nN = N / BM; nwg = nM * nN; G = G_; c = c_; }
    __host__ __device__ bool next(int i, Unit& u) const {
        const long L = (long)i * G + c; if (L >= nwg) return false;
        int wgid = (int)L; { const int q = nwg / NXCD, r = nwg % NXCD, xcd = wgid % NXCD, off = wgid / NXCD; wgid = (xcd < r ? xcd * (q + 1) : r * (q + 1) + (xcd - r) * q) + off; }
        const int nig = WGM * nN, gid = wgid / nig, fm = gid * WGM, gsz = (nM - fm) < WGM ? (nM - fm) : WGM;
        u.pm = fm + ((wgid % nig) % gsz); u.pn = (wgid % nig) / gsz; return true;
    }
    __device__ __forceinline__ void a_ready(const Unit&) const {}
    __device__ __forceinline__ void done(const Unit&) const {}
};
template <class Epi, class Sched>
__device__ __forceinline__ void gemm_phase(LAS unsigned char* lds, const Gemm g, const Sched& S, const Epi& E) {
    const int tid = TIDX, wid = __builtin_amdgcn_readfirstlane(tid >> 6), lane = tid & 63, wr = wid >> 2, wc = wid & 3, fr = lane & 15, fq = lane >> 4;
    const int K = g.K, nt = K / BK;
    unsigned voffA[2], voffB[2];
#pragma unroll
    for (int i = 0; i < 2; ++i) { int R, C; stage_rc(tid * 16 + i * 8192, R, C); const int Rb = (R & ~31) + perm32(R & 31);
        voffA[i] = (unsigned)(R * K + C) * 2u; voffB[i] = (unsigned)(Rb * K + C) * 2u; }
    const size_t kstep = (size_t)(BK * 2);
    const size_t hstep = (size_t)HALF * K * 2;
    const size_t tstep = 2 * hstep;
    const unsigned ldsw = (unsigned)wid * 1024u;
    const int aoff = lds_byte(wr * 64 + fr, fq * 8), boff = lds_byte(wc * 32 + fr, fq * 8);
#define PG8_SA(b, h) (((b) * 2 + (h)) * HTB)
#define PG8_SB(b, h) ((4 + (b) * 2 + (h)) * HTB)
#define PG8_STAGE(bufoff, gbase, voff) do { _Pragma("unroll") for (int _i = 0; _i < 2; ++_i) \
        __builtin_amdgcn_global_load_lds((const unsigned*)((const char*)(gbase) + (voff)[_i]), (LAS unsigned*)(lds + (bufoff) + ldsw + _i * 8192), 16, 0, 0); } while (0)
#define PG8_LDA(dst, b, h) do { _Pragma("unroll") for (int m = 0; m < 4; ++m) _Pragma("unroll") for (int k = 0; k < 2; ++k) dst[m][k] = *(const LAS bf16x8*)(lds + PG8_SA(b, h) + aoff + m * 2048 + k * 1024); } while (0)
#define PG8_LDB(dst, b, h) do { _Pragma("unroll") for (int n = 0; n < 2; ++n) _Pragma("unroll") for (int k = 0; k < 2; ++k) dst[n][k] = *(const LAS bf16x8*)(lds + PG8_SB(b, h) + boff + n * 2048 + k * 1024); } while (0)
#define PG8_MMA(ai, bj, At, Bt) do { __builtin_amdgcn_s_setprio(1); _Pragma("unroll") for (int m = 0; m < 4; ++m) _Pragma("unroll") for (int n = 0; n < 2; ++n) _Pragma("unroll") for (int k = 0; k < 2; ++k) \
        acc[ai][bj][m][n] = __builtin_amdgcn_mfma_f32_16x16x32_bf16(Bt[n][k], At[m][k], acc[ai][bj][m][n], 0, 0, 0); __builtin_amdgcn_s_setprio(0); } while (0)
#define PG8_WAIT_V(n) asm volatile("s_waitcnt vmcnt(" #n ")" ::: "memory")
#define PG8_WAIT_L(n) asm volatile("s_waitcnt lgkmcnt(" #n ")" ::: "memory")
#define PG8_BAR __builtin_amdgcn_s_barrier()
#define PG8_SCHED __builtin_amdgcn_sched_barrier(0)
    Unit cur, nxt; int ui = 0;
    if (!S.next(0, cur)) return;
    f32x4 acc[2][2][4][2];
#pragma unroll
    for (int a = 0; a < 2; ++a)
#pragma unroll
        for (int b = 0; b < 2; ++b)
#pragma unroll
            for (int m = 0; m < 4; ++m)
#pragma unroll
                for (int n = 0; n < 2; ++n) acc[a][b][m][n] = (f32x4){0.f, 0.f, 0.f, 0.f};
    bf16x8 At[4][2], B0[2][2], B1[2][2];
    const char* cA = (const char*)g.A + (size_t)cur.pm * tstep; const char* cB = (const char*)g.Bt + (size_t)cur.pn * tstep;
    S.a_ready(cur);
    PG8_STAGE(PG8_SB(0, 0), cB, voffB); PG8_STAGE(PG8_SA(0, 0), cA, voffA); PG8_STAGE(PG8_SB(0, 1), cB + hstep, voffB); PG8_STAGE(PG8_SA(0, 1), cA + hstep, voffA);
    if (wr == 1) PG8_BAR;
    PG8_WAIT_V(4); PG8_BAR;
    PG8_STAGE(PG8_SB(1, 0), cB + kstep, voffB); PG8_STAGE(PG8_SA(1, 0), cA + kstep, voffA); PG8_STAGE(PG8_SB(1, 1), cB + hstep + kstep, voffB);
    PG8_WAIT_V(6); PG8_BAR;
    for (;;) {
        const bool has_next = S.next(ui + 1, nxt);
        const char* nA = has_next ? (const char*)g.A + (size_t)nxt.pm * tstep : cA; const char* nB = has_next ? (const char*)g.Bt + (size_t)nxt.pn * tstep : cB;
        for (int t = 0; t < nt; t += 2) {
            const bool last = (t == nt - 2);
            const char* a1 = cA + (size_t)(t + 1) * kstep;
            const char* a2 = last ? nA : cA + (size_t)(t + 2) * kstep; const char* b2 = last ? nB : cB + (size_t)(t + 2) * kstep;
            const char* a3 = a2 + kstep; const char* b3 = b2 + kstep;
            if (last && has_next) S.a_ready(nxt);
            PG8_LDB(B0, 0, 0); PG8_SCHED; PG8_LDA(At, 0, 0); PG8_STAGE(PG8_SA(1, 1), a1 + hstep, voffA);
            PG8_WAIT_L(8); PG8_BAR; PG8_WAIT_L(0); PG8_MMA(0, 0, At, B0); PG8_BAR; PG8_SCHED;
            PG8_LDB(B1, 0, 1); PG8_STAGE(PG8_SB(0, 0), b2, voffB);
            PG8_BAR; PG8_WAIT_L(0); PG8_MMA(0, 1, At, B1); PG8_BAR;
            PG8_LDA(At, 0, 1); PG8_STAGE(PG8_SA(0, 0), a2, voffA);
            PG8_BAR; PG8_WAIT_L(0); PG8_MMA(1, 0, At, B0); PG8_BAR; PG8_SCHED;
            PG8_STAGE(PG8_SB(0, 1), b2 + hstep, voffB);
            PG8_WAIT_V(6); PG8_BAR; PG8_MMA(1, 1, At, B1); PG8_BAR;
            PG8_LDB(B0, 1, 0); PG8_SCHED; PG8_LDA(At, 1, 0); PG8_STAGE(PG8_SA(0, 1), a2 + hstep, voffA);
            PG8_WAIT_L(8); PG8_BAR; PG8_WAIT_L(0); PG8_MMA(0, 0, At, B0); PG8_BAR; PG8_SCHED;
            PG8_LDB(B1, 1, 1); PG8_STAGE(PG8_SB(1, 0), b3, voffB);
            PG8_BAR; PG8_WAIT_L(0); PG8_MMA(0, 1, At, B1); PG8_BAR;
            PG8_LDA(At, 1, 1); PG8_STAGE(PG8_SA(1, 0), a3, voffA);
            PG8_BAR; PG8_WAIT_L(0); PG8_MMA(1, 0, At, B0); PG8_BAR; PG8_SCHED;
            PG8_STAGE(PG8_SB(1, 1), b3 + hstep, voffB);
            PG8_WAIT_V(6); PG8_BAR; PG8_MMA(1, 1, At, B1); PG8_BAR;
        }
        E(acc, cur, wr, wc, fr, fq); S.done(cur);
        if (!has_next) break;
#pragma unroll
        for (int a = 0; a < 2; ++a)
#pragma unroll
            for (int b = 0; b < 2; ++b)
#pragma unroll
                for (int m = 0; m < 4; ++m)
#pragma unroll
                    for (int n = 0; n < 2; ++n) acc[a][b][m][n] = (f32x4){0.f, 0.f, 0.f, 0.f};
        cur = nxt; cA = nA; cB = nB; ++ui;
    }
    PG8_WAIT_V(0);
    if (wr == 0) PG8_BAR;
    PG8_BAR;
#undef PG8_SA
#undef PG8_SB
#undef PG8_STAGE
#undef PG8_LDA
#undef PG8_LDB
#undef PG8_MMA
#undef PG8_WAIT_V
#undef PG8_WAIT_L
#undef PG8_BAR
#undef PG8_SCHED
}
}

constexpr int DM = 4096, NP = 4096, NS = 8192, NT = 12288, AW = 2048;
constexpr int N1 = 13824, N1F = 6656, N1B = 7168;
constexpr int N3 = 10496, N3G = 8192, N3C = 2304;
constexpr int NKV = 13312;
constexpr size_t SZA = (size_t)NT * AW * 4;

constexpr size_t WS_CTL = 0;
constexpr size_t WS_MOD = 65536;
constexpr size_t WS_ROPEB_COS = 589824, WS_ROPEB_SIN = WS_ROPEB_COS + 524288;
constexpr size_t WS_ROPEC_COS = WS_ROPEB_SIN + 524288, WS_ROPEC_SIN = WS_ROPEC_COS + 262144;
constexpr size_t WS_R0 = 2228224;
constexpr size_t WS_PROJF = WS_R0;
constexpr size_t WS_YA = WS_R0;
constexpr size_t WS_MIXED = WS_R0 + 2 * SZA;
constexpr size_t WS_R1 = WS_R0 + (size_t)NT * N1F * 4;
constexpr size_t WS_PROJB = WS_R1;
constexpr size_t WS_R2 = WS_R1 + (size_t)NT * N1B * 2;
constexpr size_t WS_WTA = WS_R2;
constexpr size_t WS_H0 = WS_R2 + (size_t)N1 * DM * 2;
constexpr size_t WS_R = WS_R2;
constexpr size_t WS_K = WS_R2 + SZA;
constexpr size_t WS_R4 = WS_R2 + (size_t)N1 * DM * 2 + (size_t)NT * DM * 2;
constexpr size_t WS_WD = WS_R4;
constexpr size_t WS_R5 = WS_R4 + 4 * SZA;
constexpr size_t WS_LORA = WS_R5;
constexpr size_t WS_KBP = WS_LORA + (size_t)NT * 512 * 2;
constexpr size_t WS_VBP = WS_KBP + (size_t)NP * 512 * 2;
constexpr size_t WS_KBS = WS_VBP + (size_t)NP * 512 * 2;
constexpr size_t WS_VBS = WS_KBS + (size_t)9216 * 512 * 2;
constexpr size_t WS_R6 = WS_VBS + (size_t)9216 * 512 * 2;
constexpr size_t WS_WTOUT = WS_R6;
constexpr size_t WS_WTLORA = WS_WTOUT + (size_t)DM * DM * 2;
constexpr size_t WS_END0 = WS_WTLORA + (size_t)2 * 4096 * 256 * 2;
constexpr size_t WS_Q = WS_R0;
constexpr size_t WS_CKV = WS_Q + (size_t)NT * 12288 * 2;
constexpr size_t WS_KPE = WS_CKV + (size_t)NKV * 512 * 2;
constexpr size_t WS_H1 = WS_R1;
constexpr size_t WS_OG = WS_H1;
constexpr size_t WS_PROJC = WS_H1 + (size_t)NT * DM * 2;
constexpr size_t WS_GATEB = WS_PROJC + (size_t)NT * N3C * 4;
constexpr size_t WS_QN = WS_GATEB + (size_t)NT * 8192 * 2;
constexpr size_t WS_KV = WS_QN + (size_t)NT * 1536 * 2;
constexpr size_t WS_L1END = WS_KV + (size_t)NKV * 16384 * 2;
constexpr size_t WS_WTC = WS_L1END > WS_END0 ? WS_L1END : WS_END0;
constexpr size_t WS_WTUQ = WS_WTC + (size_t)N3 * DM * 2;
constexpr size_t WS_WTUKV = WS_WTUQ + (size_t)12288 * 1536 * 2;
constexpr size_t WS_WTCOUT = WS_WTUKV + (size_t)16384 * 512 * 2;
constexpr size_t WS_END1 = WS_WTCOUT + (size_t)DM * 8192 * 2;
static_assert(WS_KPE + (size_t)NKV * 64 * 2 <= WS_R1, "q, ckv, kpe must fit in R0");
constexpr size_t WS_NEED = WS_END0 > WS_END1 ? WS_END0 : WS_END1;
static_assert((size_t)NT * (DM * 2 + N3C * 4) >= (size_t)NT * 8192 * 2, "og must fit over h1 + projC");
static_assert(WS_R2 + 2 * SZA <= WS_R4, "r,k must fit in R2");

constexpr size_t OUT_Y = 0, OUT_STATE = 50331648, OUT_GK = 54525952, OUT_GV = 56623104, OUT_CKV = 58720256, OUT_KPE = 60817408, OUT_TOTAL = 61079552;

constexpr int LDS_X = 8 * 18688;
constexpr int LDS_BYTES = LDS_X + 512;
static_assert(TID_TAB_OFF == LDS_X + 128, "tid table behind the barrier / queue words");
constexpr int NPH = 15;

struct Params { const float* in[33]; float* out; unsigned char* ws; int ph_lo, ph_hi; };
typedef const __attribute__((address_space(4))) Params* KP;
__device__ __forceinline__ KP get_params() { unsigned long long a = (unsigned long long)__builtin_amdgcn_kernarg_segment_ptr(); asm volatile("" : "+s"(a)); return (KP)a; }

enum { I_XP = 0, I_XS, I_C, I_STATE, I_CGK, I_CGV, I_CCKV, I_CKPE, I_CCTX, I_MODW, I_MODB, I_NORMG, I_ABWIN, I_ABMIX, I_W0, I_W2, I_A0, I_A2, I_KK, I_KA, I_RK, I_LNW, I_LNB,
       I_QG, I_KG, I_ABWOUT, I_CWIN, I_QAG, I_KVAG, I_WUQ, I_WUKV, I_CWOUT, I_FINALG };

__device__ __forceinline__ void transpose_tile(const float* __restrict__ src, int ldn, int K, int k0, int n0, bf16_t* __restrict__ dst, int drow0, unsigned char* lds) {
    const int t = TIDX;
    constexpr int RS = 528;
    __syncthreads();
    {
        const int nq = t & 15, kr = t >> 4;
#pragma unroll
        for (int it = 0; it < 4; ++it) {
            const int k = 2 * kr + 64 * it;
            const f32x4 a = *(const f32x4*)(src + (size_t)(k0 + k) * ldn + n0 + nq * 4);
            const f32x4 b = *(const f32x4*)(src + (size_t)(k0 + k + 1) * ldn + n0 + nq * 4);
#pragma unroll
            for (int e = 0; e < 4; ++e) *(unsigned*)(lds + (nq * 4 + e) * RS + k * 2) = cvt_pk_bf16(a[e], b[e]);
        }
    }
    __syncthreads();
    {
        const int n = t >> 3, kc = (t & 7) * 32;
        bf16_t* d = dst + (size_t)(drow0 + n) * K + k0 + kc;
#pragma unroll
        for (int q = 0; q < 4; ++q) *(u32x4*)(d + q * 8) = *(const u32x4*)(lds + n * RS + (kc + q * 8) * 2);
    }
}
template <class RowMap>
__device__ __forceinline__ int transpose_all(const float* src, int K, int Nsrc, bf16_t* dst, RowMap rm, int u0, unsigned char* lds, int G = (int)gridDim.x, int wg = (int)blockIdx.x) {
    const int nkt = K / 256, nnt = Nsrc / 64, nu = nkt * nnt;
    int first = (wg - (u0 % G) + G) % G;
    for (int u = first; u < nu; u += G) { const int kt = u % nkt, ntile = u / nkt; transpose_tile(src, Nsrc, K, kt * 256, ntile * 64, dst, rm(ntile * 64), lds); }
    return nu;
}
struct RowId { __device__ int operator()(int n) const { return n; } };
struct RowMla { __device__ int operator()(int n) const { return n < 2112 ? 8192 + n : n - 2112; } };

__device__ __forceinline__ void phase0(KP p, unsigned char* lds) {
    unsigned char* ws = p->ws;
    const int tid = TIDX, G = gridDim.x, bid = blockIdx.x;
    {
        float* cb = (float*)(ws + WS_ROPEB_COS); float* sb = (float*)(ws + WS_ROPEB_SIN);
        float* cc = (float*)(ws + WS_ROPEC_COS); float* sc = (float*)(ws + WS_ROPEC_SIN);
        for (int i = bid * 512 + tid; i < 2048 * 64 + 2048 * 32; i += G * 512) {
            if (i < 2048 * 64) { const int t = i >> 6, pi = i & 63; const int fi = pi & 31; const float pos = (float)(pi < 32 ? (t >> 6) : (t & 63));
                const float inv = exp2f(-(float)fi * (13.287712379549449f / 32.0f)); const float a = pos * inv; cb[i] = cosf(a); sb[i] = sinf(a); }
            else { const int j = i - 2048 * 64; const int t = j >> 5, pi = j & 31; const int fi = pi & 15; const float pos = (float)(pi < 16 ? (t >> 6) : (t & 63));
                const float inv = exp2f(-(float)fi * (13.287712379549449f / 16.0f)); const float a = pos * inv; cc[j] = cosf(a); sc[j] = sinf(a); }
        }
    }
    {
        bf16_t* WL = (bf16_t*)(ws + WS_WTLORA);
        for (int i = bid * 512 + tid; i < 2 * 4096 * 32; i += G * 512) {
            const int d = i >> 17, n = (i >> 5) & 4095, k8 = (i & 31) * 8; const int isa = n >> 11, nn = n & 2047;
            u32x4 o = (u32x4){0u, 0u, 0u, 0u};
            if ((k8 >> 7) == isa) {
                const float* src = (isa ? p->in[I_A2] : p->in[I_W2]) + (size_t)d * 128 * 2048 + nn; const int kb = k8 & 127;
                float v[8];
#pragma unroll
                for (int e = 0; e < 8; ++e) v[e] = src[(size_t)(kb + e) * 2048];
                o = (u32x4){cvt_pk_bf16(v[0], v[1]), cvt_pk_bf16(v[2], v[3]), cvt_pk_bf16(v[4], v[5]), cvt_pk_bf16(v[6], v[7])};
            }
            *(u32x4*)(WL + ((size_t)d * 4096 + n) * 256 + k8) = o;
        }
    }
    {
        unsigned* qhead = (unsigned*)(ws + WS_CTL) + 4096 + 64;
        float* S = (float*)lds;
        float* RED = (float*)(lds + 81920);
        bool have_s = false;
        for (;;) {
            unsigned qa = LDS_X + 64; asm volatile("" : "+s"(qa));
            volatile LAS unsigned* qslot = (volatile LAS unsigned*)(LAS char*)(uintptr_t)qa;
            __syncthreads();
            if (TIDX == 0) *qslot = __hip_atomic_fetch_add(qhead, 1u, __ATOMIC_RELAXED, __HIP_MEMORY_SCOPE_AGENT);
            __syncthreads();
            const int u = (int)__builtin_amdgcn_readfirstlane(*qslot);
            if (u >= 192 + 3456 + 1024) break;
            if (u >= 192) {
                const int t = u - 192;
                if (t < 3456) transpose_tile(p->in[I_ABWIN], N1, 4096, (t & 15) * 256, (t >> 4) * 64, (bf16_t*)(ws + WS_WTA), (t >> 4) * 64, lds);
                else { const int t2 = t - 3456; transpose_tile(p->in[I_ABWOUT], 4096, 4096, (t2 & 15) * 256, (t2 >> 4) * 64, (bf16_t*)(ws + WS_WTOUT), (t2 >> 4) * 64, lds); }
                continue;
            }
            if (!have_s) {
                for (int i = tid; i < 5 * 4096; i += 512) { const int r = i >> 12, k = i & 4095; const float x = r == 0 ? p->in[I_CCTX][k] : p->in[I_C][(r - 1) * 4096 + k]; S[i] = silu_f(x); }
                have_s = true;
            }
            __syncthreads();
            const int layer = u / 96, c0 = (u % 96) * 128;
            const int cg = tid & 31, ks = tid >> 5;
            const float* W = p->in[I_MODW] + (size_t)layer * 4096 * 12288 + c0 + cg * 4;
            f32x4 acc[5];
#pragma unroll
            for (int r = 0; r < 5; ++r) acc[r] = (f32x4){0.f, 0.f, 0.f, 0.f};
#pragma unroll 8
            for (int kk = 0; kk < 256; ++kk) {
                const int k = ks * 256 + kk;
                const f32x4 w = *(const f32x4*)(W + (size_t)k * 12288);
#pragma unroll
                for (int r = 0; r < 5; ++r) acc[r] += w * S[r * 4096 + k];
            }
#pragma unroll
            for (int r = 0; r < 5; ++r) *(f32x4*)(RED + (ks * 5 + r) * 128 + cg * 4) = acc[r];
            __syncthreads();
            for (int o = tid; o < 640; o += 512) {
                const int r = o >> 7, c = o & 127; float sacc = 0.f;
#pragma unroll
                for (int q = 0; q < 16; ++q) sacc += RED[(q * 5 + r) * 128 + c];
                ((float*)(ws + WS_MOD))[((size_t)layer * 5 + r) * 12288 + c0 + c] = sacc + p->in[I_MODB][layer * 12288 + c0 + c];
            }
        }
        __syncthreads();
    }
}

__device__ __forceinline__ void phase_cvt1(KP p, unsigned char* lds, int part, int G, int wg) {
    unsigned char* ws = p->ws; int u0 = 0;
    if (part == 0) {
        u0 += transpose_all(p->in[I_CWIN], 4096, 10304, (bf16_t*)(ws + WS_WTC), RowMla(), u0, lds, G, wg);
        u0 += transpose_all(p->in[I_WUQ], 1536, 12288, (bf16_t*)(ws + WS_WTUQ), RowId(), u0, lds, G, wg);
        bf16_t* pad = (bf16_t*)(ws + WS_WTC) + (size_t)10304 * 4096;
        for (int i = wg * 512 + TIDX; i < 192 * 4096 / 8; i += G * 512) *(u32x4*)(pad + (size_t)i * 8) = (u32x4){0u, 0u, 0u, 0u};
    } else if (part == 1) {
        u0 += transpose_all(p->in[I_WUKV], 512, 16384, (bf16_t*)(ws + WS_WTUKV), RowId(), u0, lds, G, wg);
    } else {
        u0 += transpose_all(p->in[I_CWOUT], 8192, 4096, (bf16_t*)(ws + WS_WTCOUT), RowId(), u0, lds, G, wg);
    }
}

__device__ __forceinline__ void phase_h(KP p, int layer, const float* x0  , const float* x1  , bf16_t* h) {
    const int lane = TIDX & 63, wave = TIDX >> 6, gw = blockIdx.x * 8 + wave, nw = gridDim.x * 8;
    const float* mod = (const float*)(p->ws + WS_MOD) + (size_t)layer * 5 * 12288;
    const float* g = p->in[I_NORMG] + layer * 4096;
    for (int row = gw; row < NT; row += nw) {
        const float* x = row < NP ? x0 + (size_t)row * DM : x1 + (size_t)(row - NP) * DM;
        const int mr = row < NP ? 0 : 1 + (row - NP) / 2048;
        f32x4 v[16]; float ss = 0.f;
#pragma unroll
        for (int i = 0; i < 16; ++i) { v[i] = ((const f32x4*)x)[lane + 64 * i]; ss += v[i][0] * v[i][0] + v[i][1] * v[i][1] + v[i][2] * v[i][2] + v[i][3] * v[i][3]; }
        ss = wave_sum(ss);
        const float inv = rsqrtf(ss * (1.0f / 4096.0f) + 1e-6f);
        const float* msh = mod + (size_t)mr * 12288; const float* msc = msh + 4096;
#pragma unroll
        for (int i = 0; i < 16; ++i) {
            const int c4 = lane + 64 * i;
            const f32x4 g4 = ((const f32x4*)g)[c4], sc = ((const f32x4*)msc)[c4], sh = ((const f32x4*)msh)[c4];
            const f32x4 o = v[i] * inv * g4 * (sc + 1.0f) + sh;
            u32x2 w; w.x = cvt_pk_bf16(o[0], o[1]); w.y = cvt_pk_bf16(o[2], o[3]);
            *(u32x2*)(h + (size_t)row * DM + c4 * 4) = w;
        }
    }
}

__device__ __forceinline__ void phase_h_bf(KP p, int layer, const bf16_t* xb, bf16_t* h) {
    const int lane = TIDX & 63, wave = TIDX >> 6, gw = blockIdx.x * 8 + wave, nw = gridDim.x * 8;
    const float* mod = (const float*)(p->ws + WS_MOD) + (size_t)layer * 5 * 12288;
    const float* g = p->in[I_NORMG] + layer * 4096;
    for (int row = gw; row < NT; row += nw) {
        const u32x2* x = (const u32x2*)(xb + (size_t)row * DM);
        const int mr = row < NP ? 0 : 1 + (row - NP) / 2048;
        f32x4 v[16]; float ss = 0.f;
#pragma unroll
        for (int i = 0; i < 16; ++i) { v[i] = up4(x[lane + 64 * i]); ss += v[i][0] * v[i][0] + v[i][1] * v[i][1] + v[i][2] * v[i][2] + v[i][3] * v[i][3]; }
        ss = wave_sum(ss);
        const float inv = rsqrtf(ss * (1.0f / 4096.0f) + 1e-6f);
        const float* msh = mod + (size_t)mr * 12288; const float* msc = msh + 4096;
#pragma unroll
        for (int i = 0; i < 16; ++i) {
            const int c4 = lane + 64 * i;
            const f32x4 g4 = ((const f32x4*)g)[c4], sc = ((const f32x4*)msc)[c4], sh = ((const f32x4*)msh)[c4];
            *(u32x2*)(h + (size_t)row * DM + c4 * 4) = pk4(v[i] * inv * g4 * (sc + 1.0f) + sh);
        }
    }
}

#define EPI_LOOP_BEGIN \
    _Pragma("unroll") for (int ai = 0; ai < 2; ++ai) _Pragma("unroll") for (int m = 0; m < 4; ++m) { const int row = u.pm * 256 + ai * 128 + wr * 64 + m * 16 + fr; \
    _Pragma("unroll") for (int bj = 0; bj < 2; ++bj) _Pragma("unroll") for (int n = 0; n < 2; ++n) { const int col = u.pn * 256 + bj * 128 + wc * 32 + fq * 8 + n * 4; const f32x4 a = acc[ai][bj][m][n];
#define EPI_LOOP_END } }

struct EpiG1 {
    bf16_t* F; bf16_t* B;
    __device__ __forceinline__ void operator()(const f32x4 (&acc)[2][2][4][2], const pg8::Unit& u, int wr, int wc, int fr, int fq) const {
        if (u.pn < 26) {
            EPI_LOOP_BEGIN *(u32x2*)(F + (size_t)row * N1F + col) = pk4(a); EPI_LOOP_END
        } else {
            EPI_LOOP_BEGIN *(u32x2*)(B + (size_t)row * N1B + (col - N1F)) = pk4(a); EPI_LOOP_END
        }
    }
};
struct EpiBf16Plain {
    bf16_t* O; int ldc;
    __device__ __forceinline__ void operator()(const f32x4 (&acc)[2][2][4][2], const pg8::Unit& u, int wr, int wc, int fr, int fq) const {
        EPI_LOOP_BEGIN u32x2 w; w.x = cvt_pk_bf16(a[0], a[1]); w.y = cvt_pk_bf16(a[2], a[3]); *(u32x2*)(O + (size_t)row * ldc + col) = w; EPI_LOOP_END
    }
};
struct EpiLora {
    const float* w0; const float* a0; bf16_t* Wd; bf16_t* Ad;
    __device__ __forceinline__ void operator()(const f32x4 (&acc)[2][2][4][2], const pg8::Unit& u, int wr, int wc, int fr, int fq) const {
        if (u.pn < 8) {
            EPI_LOOP_BEGIN const int c = col & 2047; const f32x4 b0 = *(const f32x4*)(w0 + c); f32x4 o;
#pragma unroll
                for (int e = 0; e < 4; ++e) o[e] = -0.8750270622f * sigmoid_f(a[e] + b0[e]);
                *(u32x2*)(Wd + (size_t)row * AW + c) = pk4(o); EPI_LOOP_END
        } else {
            EPI_LOOP_BEGIN const int c = col & 2047; const f32x4 b0 = *(const f32x4*)(a0 + c); f32x4 o;
#pragma unroll
                for (int e = 0; e < 4; ++e) o[e] = sigmoid_f(a[e] + b0[e]);
                *(u32x2*)(Ad + (size_t)row * AW + c) = pk4(o); EPI_LOOP_END
        }
    }
};
template <bool XBF> struct EpiRes {
    const float* x0; const float* x1; const bf16_t* xb; bf16_t* out; const float* gate;
    __device__ __forceinline__ void operator()(const f32x4 (&acc)[2][2][4][2], const pg8::Unit& u, int wr, int wc, int fr, int fq) const {
        const int rbase = u.pm * 256; const float* xin = rbase < NP ? x0 + (size_t)0 : x1 - (size_t)NP * DM; const int mr = rbase < NP ? 0 : 1 + (rbase - NP) / 2048;
        const float* gr = gate + (size_t)mr * 12288;
        EPI_LOOP_BEGIN f32x4 xv; if constexpr (XBF) xv = up4(*(const u32x2*)(xb + (size_t)row * DM + col)); else xv = *(const f32x4*)(xin + (size_t)row * DM + col);
            const f32x4 gv = *(const f32x4*)(gr + col);
            *(u32x2*)(out + (size_t)row * DM + col) = pk4(xv + gv * a); EPI_LOOP_END
    }
};
struct EpiG3 {
    bf16_t* Gt; bf16_t* C;
    __device__ __forceinline__ void operator()(const f32x4 (&acc)[2][2][4][2], const pg8::Unit& u, int wr, int wc, int fr, int fq) const {
        if (u.pn < 32) {
            EPI_LOOP_BEGIN *(u32x2*)(Gt + (size_t)row * N3G + col) = pk4(a); EPI_LOOP_END
        } else {
            EPI_LOOP_BEGIN *(u32x2*)(C + (size_t)row * N3C + (col - N3G)) = pk4(a); EPI_LOOP_END
        }
    }
};
struct EpiQ {
    bf16_t* Q; const float* cosC; const float* sinC;
    __device__ __forceinline__ void operator()(const f32x4 (&acc)[2][2][4][2], const pg8::Unit& u, int wr, int wc, int fr, int fq) const {
        const bool samp = u.pm * 256 >= NP;
        EPI_LOOP_BEGIN f32x4 o = a; const int hc = col % 192;
            if (samp && hc >= 128) { const int t = (row - NP) & 2047; const int pi = (hc - 128) >> 1;
                const f32x2 cs = *(const f32x2*)(cosC + t * 32 + pi), sn = *(const f32x2*)(sinC + t * 32 + pi);
                o[0] = a[0] * cs[0] - a[1] * sn[0]; o[1] = a[0] * sn[0] + a[1] * cs[0]; o[2] = a[2] * cs[1] - a[3] * sn[1]; o[3] = a[2] * sn[1] + a[3] * cs[1]; }
            u32x2 w; w.x = cvt_pk_bf16(o[0], o[1]); w.y = cvt_pk_bf16(o[2], o[3]); *(u32x2*)(Q + (size_t)row * 12288 + col) = w; EPI_LOOP_END
    }
};

__device__ __forceinline__ void unpack8(const u32x4 w, float (&x)[8]) { x[0] = bf_lo(w.x); x[1] = bf_hi(w.x); x[2] = bf_lo(w.y); x[3] = bf_hi(w.y); x[4] = bf_lo(w.z); x[5] = bf_hi(w.z); x[6] = bf_lo(w.w); x[7] = bf_hi(w.w); }
__device__ __forceinline__ u32x4 pack8(const float (&x)[8]) { return (u32x4){cvt_pk_bf16(x[0], x[1]), cvt_pk_bf16(x[2], x[3]), cvt_pk_bf16(x[4], x[5]), cvt_pk_bf16(x[6], x[7])}; }
__device__ __forceinline__ void rope8(float (&x)[8], const float* cs, const float* sn) {
    const f32x4 c = *(const f32x4*)cs, s = *(const f32x4*)sn;
#pragma unroll
    for (int e = 0; e < 4; ++e) { const float xr = x[2 * e], xi = x[2 * e + 1]; x[2 * e] = xr * c[e] - xi * s[e]; x[2 * e + 1] = xr * s[e] + xi * c[e]; }
}
__device__ __forceinline__ void phase_prepA(KP p) {
    unsigned char* ws = p->ws;
    const int lane = TIDX & 63, wave = TIDX >> 6, gw = blockIdx.x * 8 + wave, nw = gridDim.x * 8;
    const bf16_t* projF = (const bf16_t*)(ws + WS_PROJF); bf16_t* projB = (bf16_t*)(ws + WS_PROJB);
    bf16_t* Rb = (bf16_t*)(ws + WS_R); bf16_t* Kb = (bf16_t*)(ws + WS_K); bf16_t* KKb = (bf16_t*)(p->out + OUT_Y); bf16_t* Vb = (bf16_t*)(p->out + OUT_Y + (size_t)NT * AW);
    bf16_t* lora = (bf16_t*)(ws + WS_LORA);
    bf16_t* KbP = (bf16_t*)(ws + WS_KBP); bf16_t* VbP = (bf16_t*)(ws + WS_VBP); bf16_t* KbS = (bf16_t*)(ws + WS_KBS); bf16_t* VbS = (bf16_t*)(ws + WS_VBS);
    const float* cosB = (const float*)(ws + WS_ROPEB_COS); const float* sinB = (const float*)(ws + WS_ROPEB_SIN);
    const float* mix = p->in[I_ABMIX]; const float* k_k = p->in[I_KK]; const float* qg = p->in[I_QG]; const float* kg = p->in[I_KG];
    for (int row = gw; row < NT + 1024; row += nw) {
        if (row >= NT) {
            const int cr = row - NT, b = cr >> 8, t = cr & 255; const size_t drow = (size_t)(b * 2304 + t) * 512 + lane * 8;
            { const float* s = p->in[I_CGK] + (size_t)cr * 512 + lane * 8; const f32x4 a = *(const f32x4*)s, c = *(const f32x4*)(s + 4);
              *(u32x4*)(KbS + drow) = (u32x4){cvt_pk_bf16(a[0], a[1]), cvt_pk_bf16(a[2], a[3]), cvt_pk_bf16(c[0], c[1]), cvt_pk_bf16(c[2], c[3])}; }
            { const float* s = p->in[I_CGV] + (size_t)cr * 512 + lane * 8; const f32x4 a = *(const f32x4*)s, c = *(const f32x4*)(s + 4);
              *(u32x4*)(VbS + drow) = (u32x4){cvt_pk_bf16(a[0], a[1]), cvt_pk_bf16(a[2], a[3]), cvt_pk_bf16(c[0], c[1]), cvt_pk_bf16(c[2], c[3])}; }
            continue;
        }
        const bool samp = row >= NP; int b, t, T;
        if (!samp) { b = row >> 8; t = row & 255; T = 256; } else { const int rr = row - NP; b = rr >> 11; t = rr & 2047; T = 2048; }
        const bool hp = t > 0, hn = t < T - 1;
        const u32x2* pc = (const u32x2*)(projF + (size_t)row * N1F); const u32x2* pp = pc - N1F / 4; const u32x2* pn = pc + N1F / 4;
        const f32x4 z4 = (f32x4){0.f, 0.f, 0.f, 0.f};
        const u32x4* pc8 = (const u32x4*)pc; const u32x4* pp8 = (const u32x4*)pp; const u32x4* pn8 = (const u32x4*)pn;
#pragma unroll
        for (int it = 0; it < 13; ++it) {
            const int c8 = lane + 64 * it;
            float cur[8], prv[8], nxt[8], sh[8];
            unpack8(pc8[c8], cur);
            if (hp) unpack8(pp8[c8], prv); else {
#pragma unroll
                for (int e = 0; e < 8; ++e) prv[e] = 0.f; }
            if (hn) unpack8(pn8[c8], nxt); else {
#pragma unroll
                for (int e = 0; e < 8; ++e) nxt[e] = 0.f; }
            const f32x4 m0 = ((const f32x4*)mix)[2 * c8], m1 = ((const f32x4*)mix)[2 * c8 + 1];
#pragma unroll
            for (int e = 0; e < 8; ++e) { const float mx = e < 4 ? m0[e & 3] : m1[e & 3]; sh[e] = cur[e] + mx * ((prv[e] + nxt[e]) * 0.5f - cur[e]); }
            if (it < 12) {
                const int which = it >> 2, cc = (c8 & 255) * 8; const size_t o = (size_t)row * AW + cc;
                if (which == 0) *(u32x4*)(Rb + o) = pack8(sh);
                else if (which == 2) *(u32x4*)(Vb + o) = pack8(sh);
                else { *(u32x4*)(Kb + o) = pack8(sh);
                    const f32x4 k0 = *(const f32x4*)(k_k + cc), k1 = *(const f32x4*)(k_k + cc + 4); float kk[8]; float ss = 0.f;
#pragma unroll
                    for (int e = 0; e < 8; ++e) { kk[e] = sh[e] * (e < 4 ? k0[e & 3] : k1[e & 3]); ss += kk[e] * kk[e]; }
                    ss += __shfl_xor(ss, 1); ss += __shfl_xor(ss, 2); ss += __shfl_xor(ss, 4);
                    const float inv = 1.0f / fmaxf(sqrtf(ss), 1e-12f);
#pragma unroll
                    for (int e = 0; e < 8; ++e) kk[e] *= inv;
                    *(u32x4*)(KKb + o) = pack8(kk); }
            } else {
                const int cl = lane * 8;
                if ((cl & 255) < 128) {
#pragma unroll
                    for (int e = 0; e < 8; ++e) { const float ex = __expf(2.0f * sh[e]); sh[e] = 1.0f - 2.0f * __builtin_amdgcn_rcpf(ex + 1.0f); } }
                *(u32x4*)(lora + ((size_t)(cl >> 8) * NT + row) * 256 + (cl & 255)) = pack8(sh);
            }
        }
        bf16_t* pb = projB + (size_t)row * N1B;
        {
            const int col = lane * 8, hc = col & 127; float x[8]; unpack8(*(const u32x4*)(pb + 4096 + col), x);
            float ss = 0.f;
#pragma unroll
            for (int e = 0; e < 8; ++e) ss += x[e] * x[e];
            ss = sum16(ss); const float inv = rsqrtf(ss * (1.0f / 128.0f) + 1e-6f);
            const f32x4 g0 = *(const f32x4*)(kg + hc), g1 = *(const f32x4*)(kg + hc + 4);
#pragma unroll
            for (int e = 0; e < 4; ++e) { x[e] = x[e] * inv * g0[e]; x[4 + e] = x[4 + e] * inv * g1[e]; }
            if (!samp) {
                float* o = p->out + OUT_GK + (size_t)row * 512 + col; *(f32x4*)o = (f32x4){x[0], x[1], x[2], x[3]}; *(f32x4*)(o + 4) = (f32x4){x[4], x[5], x[6], x[7]};
                *(u32x4*)(KbP + (size_t)row * 512 + col) = pack8(x);
            } else {
                rope8(x, cosB + t * 64 + (hc >> 1), sinB + t * 64 + (hc >> 1));
                *(u32x4*)(KbS + (size_t)(b * 2304 + 256 + t) * 512 + col) = pack8(x);
            }
        }
        {
            const int col = lane * 8; const u32x4 w = *(const u32x4*)(pb + 4608 + col);
            if (!samp) { float x[8]; unpack8(w, x);
                float* o = p->out + OUT_GV + (size_t)row * 512 + col; *(f32x4*)o = (f32x4){x[0], x[1], x[2], x[3]}; *(f32x4*)(o + 4) = (f32x4){x[4], x[5], x[6], x[7]};
                *(u32x4*)(VbP + (size_t)row * 512 + col) = w;
            } else *(u32x4*)(VbS + (size_t)(b * 2304 + 256 + t) * 512 + col) = w;
        }
    }
}

#define KSWZ(row, colB) ((row) * 256 + ((colB) ^ ((((row) & 7) | ((((row) >> 4) & 1) << 3)) << 4)))
#define PSWZ(row, colB) ((row) * 128 + ((colB) ^ ((((row) >> 1) & 7) << 4)))
#define SBAR() __builtin_amdgcn_sched_barrier(0)
__device__ __forceinline__ int crow(int r, int hi) { return (r & 3) + 8 * (r >> 2) + 4 * hi; }
template <class C>
__device__ __forceinline__ void partialSM(f32x16& p0, f32x16& p1, float& m_reg, float& mn, float& alpha) {
    constexpr float Cc = C::SCALE * 1.4426950408889634f;
    float pmax = p0[0];
#pragma unroll
    for (int r = 1; r < 16; ++r) pmax = fmaxf(pmax, p0[r]);
#pragma unroll
    for (int r = 0; r < 16; ++r) pmax = fmaxf(pmax, p1[r]);
    { auto rr = __builtin_amdgcn_permlane32_swap(__float_as_uint(pmax), __float_as_uint(pmax), false, false);
      pmax = fmaxf(__uint_as_float(rr[0]), __uint_as_float(rr[1])); }
    if (__builtin_expect(__all(pmax - m_reg <= 8.0f / C::SCALE), 1)) { mn = m_reg; alpha = 1.f; }
    else { mn = fmaxf(m_reg, pmax); alpha = __builtin_amdgcn_exp2f((m_reg - mn) * Cc); m_reg = mn; }
    const float mnC = -mn * Cc;
#pragma unroll
    for (int r = 0; r < 16; ++r) p0[r] = fmaf(p0[r], Cc, mnC);
#pragma unroll
    for (int r = 0; r < 16; ++r) p1[r] = fmaf(p1[r], Cc, mnC);
#pragma unroll
    for (int r = 0; r < 16; ++r) p0[r] = __builtin_amdgcn_exp2f(p0[r]);
}
__device__ __forceinline__ void finishSM(f32x16& p0, f32x16& p1, float alpha, float& l_reg, bf16x8& pa0, bf16x8& pa1, bf16x8& pa2, bf16x8& pa3) {
#pragma unroll
    for (int r = 0; r < 16; ++r) p1[r] = __builtin_amdgcn_exp2f(p1[r]);
    float ps = 0;
#pragma unroll
    for (int r = 0; r < 16; ++r) ps += p0[r];
#pragma unroll
    for (int r = 0; r < 16; ++r) ps += p1[r];
    { auto rr = __builtin_amdgcn_permlane32_swap(__float_as_uint(ps), __float_as_uint(ps), false, false);
      ps = __uint_as_float(rr[0]) + __uint_as_float(rr[1]); }
    l_reg = l_reg * alpha + ps;
#define PK4(P, BASE, OUT) do { unsigned a0 = cvt_pk_bf16(P[BASE + 0], P[BASE + 1]), a1 = cvt_pk_bf16(P[BASE + 2], P[BASE + 3]);   \
    unsigned b0 = cvt_pk_bf16(P[BASE + 4], P[BASE + 5]), b1 = cvt_pk_bf16(P[BASE + 6], P[BASE + 7]);                              \
    auto r0 = __builtin_amdgcn_permlane32_swap(a0, b0, false, false); auto r1 = __builtin_amdgcn_permlane32_swap(a1, b1, false, false); \
    u32x4 w = {r0[0], r1[0], r0[1], r1[1]}; OUT = *reinterpret_cast<bf16x8*>(&w); } while (0)
    PK4(p0, 0, pa0); PK4(p0, 8, pa1); PK4(p1, 0, pa2); PK4(p1, 8, pa3);
#undef PK4
}
template <class C>
__device__ __forceinline__ void qkt(f32x16& p0, f32x16& p1, const char* Ks, const char* Ps, const bf16x8* qr, const char* Qpe, int r32, int hi) {
    p0 = f32x16{}; p1 = f32x16{};
#pragma unroll
    for (int d0 = 0; d0 < 8; ++d0) { const int cb = (d0 * 16 + hi * 8) * 2;
        const bf16x8 b0 = *reinterpret_cast<const bf16x8*>(Ks + KSWZ(r32, cb));
        const bf16x8 b1 = *reinterpret_cast<const bf16x8*>(Ks + KSWZ(32 + r32, cb));
        bf16x8 qf; if constexpr (true) { if (d0 < C::NDR) qf = qr[d0 < C::NDR ? d0 : 0]; else qf = *reinterpret_cast<const bf16x8*>(Qpe + (d0 - C::NDR) * 1024); }
        p0 = __builtin_amdgcn_mfma_f32_32x32x16_bf16(b0, qf, p0, 0, 0, 0);
        p1 = __builtin_amdgcn_mfma_f32_32x32x16_bf16(b1, qf, p1, 0, 0, 0); }
    if constexpr (C::PE) {
#pragma unroll
        for (int d1 = 0; d1 < 4; ++d1) { const int cb = (d1 * 16 + hi * 8) * 2;
            const bf16x8 b0 = *reinterpret_cast<const bf16x8*>(Ps + PSWZ(r32, cb));
            const bf16x8 b1 = *reinterpret_cast<const bf16x8*>(Ps + PSWZ(32 + r32, cb));
            const bf16x8 qf = *reinterpret_cast<const bf16x8*>(Qpe + (8 - C::NDR + d1) * 1024);
            p0 = __builtin_amdgcn_mfma_f32_32x32x16_bf16(b0, qf, p0, 0, 0, 0);
            p1 = __builtin_amdgcn_mfma_f32_32x32x16_bf16(b1, qf, p1, 0, 0, 0); }
    }
}
#define QK_PIPE 1
template <class C> __device__ __forceinline__ void qk_pipe() {
#ifdef QK_PIPE
    if constexpr (C::PE) {
        constexpr int NV = 7, NG = 12;
        __builtin_amdgcn_sched_group_barrier(0x100, 2, 0);
#pragma unroll
        for (int g_ = 0; g_ < NG; ++g_) {
            if (g_ + 1 < NG) { if (g_ + 1 < 8) __builtin_amdgcn_sched_group_barrier(0x100, 2, 0); else __builtin_amdgcn_sched_group_barrier(0x100, 3, 0); }
            __builtin_amdgcn_sched_group_barrier(0x400, 2, 0); __builtin_amdgcn_sched_group_barrier(0x002, NV - 2, 0); __builtin_amdgcn_sched_group_barrier(0x008, 2, 0); }
    } else {
        constexpr int NV = 10;
        __builtin_amdgcn_sched_group_barrier(0x100, 2, 0);
#pragma unroll
        for (int g_ = 0; g_ < 8; ++g_) { if (g_ + 1 < 8) __builtin_amdgcn_sched_group_barrier(0x100, 2, 0); __builtin_amdgcn_sched_group_barrier(0x400, 2, 0); __builtin_amdgcn_sched_group_barrier(0x002, NV - 2, 0); __builtin_amdgcn_sched_group_barrier(0x008, 2, 0); }
    }
#endif
}
__device__ __forceinline__ int v_st(int k, int c) { const int kk = (k & ~0xC) | ((k & 4) << 1) | ((k & 8) >> 1); return ((kk >> 3) * 4 + (c >> 5)) * 512 + ((kk & 7) * 32 + (c & 31)) * 2; }
__device__ __forceinline__ int v_rd_base(int lane) { return ((lane & 3) << 3) | (((lane >> 2) & 3) << 6) | (((lane >> 4) & 1) << 5) | (((lane >> 5) & 1) << 8); }
constexpr int v_rd_off(int d0, int ks, int half) { return d0 * 512 + ks * 4096 + half * 2048; }
template <int OFF> __device__ __forceinline__ s16x4 tr_read(int vb) {
    s16x4 r; asm volatile("ds_read_b64_tr_b16 %0, %1 offset:%2" : "=&v"(r) : "v"(vb), "i"(OFF) : "memory"); return r;
}
template <int D0> __device__ __forceinline__ void pv_one(f32x16& od, int vb, bf16x8 pa0, bf16x8 pa1, bf16x8 pa2, bf16x8 pa3) {
    const s16x4 l0 = tr_read<v_rd_off(D0, 0, 0)>(vb), h0 = tr_read<v_rd_off(D0, 0, 1)>(vb), l1 = tr_read<v_rd_off(D0, 1, 0)>(vb), h1 = tr_read<v_rd_off(D0, 1, 1)>(vb);
    const s16x4 l2 = tr_read<v_rd_off(D0, 2, 0)>(vb), h2 = tr_read<v_rd_off(D0, 2, 1)>(vb), l3 = tr_read<v_rd_off(D0, 3, 0)>(vb), h3 = tr_read<v_rd_off(D0, 3, 1)>(vb);
    asm volatile("s_waitcnt lgkmcnt(0)" ::: "memory"); SBAR();
#define PK(L, H) (bf16x8){L[0], L[1], L[2], L[3], H[0], H[1], H[2], H[3]}
    od = __builtin_amdgcn_mfma_f32_32x32x16_bf16(pa0, PK(l0, h0), od, 0, 0, 0);
    od = __builtin_amdgcn_mfma_f32_32x32x16_bf16(pa1, PK(l1, h1), od, 0, 0, 0);
    od = __builtin_amdgcn_mfma_f32_32x32x16_bf16(pa2, PK(l2, h2), od, 0, 0, 0);
    od = __builtin_amdgcn_mfma_f32_32x32x16_bf16(pa3, PK(l3, h3), od, 0, 0, 0);
#undef PK
}
__device__ __forceinline__ void pv_d0(f32x16* o, int vb, bf16x8 pa0, bf16x8 pa1, bf16x8 pa2, bf16x8 pa3) {
    pv_one<0>(o[0], vb, pa0, pa1, pa2, pa3); pv_one<1>(o[1], vb, pa0, pa1, pa2, pa3); pv_one<2>(o[2], vb, pa0, pa1, pa2, pa3); pv_one<3>(o[3], vb, pa0, pa1, pa2, pa3);
}
template <class C>
__device__ __forceinline__ void pv_psm(f32x16* o, int vb, bf16x8 pa0, bf16x8 pa1, bf16x8 pa2, bf16x8 pa3, f32x16& p0, f32x16& p1, float& m_reg, float& mn, float& alpha) {
    constexpr float Cc = C::SCALE * 1.4426950408889634f;
#define PK(L, H) (bf16x8){L[0], L[1], L[2], L[3], H[0], H[1], H[2], H[3]}
#define PVG_READ(D0) const s16x4 l0 = tr_read<v_rd_off(D0, 0, 0)>(vb), h0 = tr_read<v_rd_off(D0, 0, 1)>(vb), l1 = tr_read<v_rd_off(D0, 1, 0)>(vb), h1 = tr_read<v_rd_off(D0, 1, 1)>(vb); \
    const s16x4 l2 = tr_read<v_rd_off(D0, 2, 0)>(vb), h2 = tr_read<v_rd_off(D0, 2, 1)>(vb), l3 = tr_read<v_rd_off(D0, 3, 0)>(vb), h3 = tr_read<v_rd_off(D0, 3, 1)>(vb);
#define PVG_MMA(D0) asm volatile("s_waitcnt lgkmcnt(0)" ::: "memory"); SBAR(); \
    o[D0] = __builtin_amdgcn_mfma_f32_32x32x16_bf16(pa0, PK(l0, h0), o[D0], 0, 0, 0); o[D0] = __builtin_amdgcn_mfma_f32_32x32x16_bf16(pa1, PK(l1, h1), o[D0], 0, 0, 0); \
    o[D0] = __builtin_amdgcn_mfma_f32_32x32x16_bf16(pa2, PK(l2, h2), o[D0], 0, 0, 0); o[D0] = __builtin_amdgcn_mfma_f32_32x32x16_bf16(pa3, PK(l3, h3), o[D0], 0, 0, 0);
    float mnC;
    {   PVG_READ(0)
        float pmax = p0[0];
#pragma unroll
        for (int r = 1; r < 16; ++r) pmax = fmaxf(pmax, p0[r]);
#pragma unroll
        for (int r = 0; r < 16; ++r) pmax = fmaxf(pmax, p1[r]);
        { auto rr = __builtin_amdgcn_permlane32_swap(__float_as_uint(pmax), __float_as_uint(pmax), false, false);
          pmax = fmaxf(__uint_as_float(rr[0]), __uint_as_float(rr[1])); }
        const bool keep = __all(pmax - m_reg <= 8.0f / C::SCALE);
        mn = keep ? m_reg : fmaxf(m_reg, pmax);
        alpha = __builtin_amdgcn_exp2f((m_reg - mn) * Cc); m_reg = mn; mnC = -mn * Cc;
        PVG_MMA(0) }
    {   PVG_READ(1)
#pragma unroll
        for (int r = 0; r < 16; ++r) p0[r] = fmaf(p0[r], Cc, mnC);
#pragma unroll
        for (int r = 0; r < 4; ++r) p0[r] = __builtin_amdgcn_exp2f(p0[r]);
        PVG_MMA(1) }
    {   PVG_READ(2)
#pragma unroll
        for (int r = 0; r < 16; ++r) p1[r] = fmaf(p1[r], Cc, mnC);
#pragma unroll
        for (int r = 4; r < 10; ++r) p0[r] = __builtin_amdgcn_exp2f(p0[r]);
        PVG_MMA(2) }
    {   PVG_READ(3)
#pragma unroll
        for (int r = 10; r < 16; ++r) p0[r] = __builtin_amdgcn_exp2f(p0[r]);
        PVG_MMA(3) }
    asm volatile("" : "+v"(p0), "+v"(p1));
#undef PK
#undef PVG_READ
#undef PVG_MMA
}
#ifndef MLA_NDR
#define MLA_NDR 8
#endif
#ifndef MLA_SD
#define MLA_SD 1
#endif
struct CfgGqa { static constexpr bool QNORM = true; static constexpr bool PE = false; static constexpr int ND = 8, NDR = 8, LDQ = N1B, LDK = 512, LDV = 512, LDO = DM, LDG = N1B, SDEPTH = 2; static constexpr float SCALE = 0.08838834764831845f; };
struct CfgMla { static constexpr bool QNORM = false; static constexpr bool PE = true; static constexpr int ND = 12, NDR = MLA_NDR, LDQ = 12288, LDK = 16384, LDV = 16384, LDO = 8192, LDG = 8192, SDEPTH = MLA_SD; static constexpr float SCALE = 0.07216878364870323f; };

struct AttnPre { bf16x8 q[8]; u32x4 qp[4]; bf16x8 vs0, vs1, ks0, ks1, ps; };
struct AttnNext { const bf16_t* Q; const bf16_t* K; const bf16_t* V; const bf16_t* P; bool valid; };
template <class C, bool XP = false>
__device__ __forceinline__ void attn_body(const bf16_t* __restrict__ Qb, const bf16_t* __restrict__ Kh, const bf16_t* __restrict__ Vh, const bf16_t* __restrict__ Ph,
                                          bf16_t* __restrict__ Ob, const bf16_t* __restrict__ Gb, int seq, char* lds, const float* ropeC = nullptr, const float* ropeS = nullptr, int t0 = 0, const float* qg = nullptr,
                                          AttnPre* pre = nullptr, bool have = false, AttnNext nxt = AttnNext{nullptr, nullptr, nullptr, nullptr, false}) {
    constexpr int SD = C::SDEPTH; constexpr size_t SHM_V = 64 * 128 * 2, SHM_K = 64 * 128 * 2, SHM_P = C::PE ? 64 * 64 * 2 : 0;
    int tid_ = TIDX; asm volatile("" : "+v"(tid_));
    const int tid = tid_, wid = tid >> 6, lane = tid & 63, r32 = lane & 31, hi = lane >> 5;
    char* V_lds = lds; char* K_lds = lds + 2 * SHM_V; char* P_lds = lds + 2 * SHM_V + 2 * SHM_K;
    float* wsf = (float*)(lds + 2 * SHM_V + 2 * SHM_K + 2 * SHM_P) + wid * 64; float* li_l = wsf; float* al_l = wsf + 32;
    float m_reg = -1e30f, l_reg = 0; f32x16 o[4] = {}; bf16x8 qr[C::NDR];
    const bf16_t* Qw = Qb + (long)(wid * 32 + r32) * C::LDQ + hi * 8;
    char* Qpe = (char*)(wsf - wid * 64) + 2048 + wid * ((C::ND - C::NDR) * 1024) + lane * 16;
    __syncthreads();
    const int sr = tid >> 4, sc = (tid & 15) * 8, vst0 = v_st(sr, sc), vst1 = v_st(32 + sr, sc);
    const int pr = tid >> 3, pc = (tid & 7) * 8;
    const int vb0 = (int)(uintptr_t)V_lds + v_rd_base(lane);
    struct { bf16x8 vs0, vs1, ks0, ks1, ps; } sr_[SD];
#define GAS __attribute__((address_space(1)))
    static_assert(C::LDV == C::LDK, "K and V tiles share their lane offset");
    const unsigned vo = (unsigned)((sr * C::LDV + sc) * 2), po = (unsigned)((pr * 64 + pc) * 2);
#define SLOAD(i, k0) do { const char* vb_ = (const char*)Vh + (size_t)(k0) * (C::LDV * 2); const char* kb_ = (const char*)Kh + (size_t)(k0) * (C::LDK * 2); \
    const char* pb_ = C::PE ? (const char*)Ph + (size_t)(k0) * 128 : nullptr; asm volatile("" : "+s"(vb_), "+s"(kb_), "+s"(pb_)); \
    sr_[i].vs0 = *(const GAS bf16x8*)((const GAS char*)vb_ + vo); sr_[i].vs1 = *(const GAS bf16x8*)((const GAS char*)vb_ + (size_t)32 * C::LDV * 2 + vo); \
    sr_[i].ks0 = *(const GAS bf16x8*)((const GAS char*)kb_ + vo); sr_[i].ks1 = *(const GAS bf16x8*)((const GAS char*)kb_ + (size_t)32 * C::LDK * 2 + vo); \
    if constexpr (C::PE) sr_[i].ps = *(const GAS bf16x8*)((const GAS char*)pb_ + po); } while (0)
#define SWRITE(b, i) do { *(bf16x8*)(V_lds + (b) * SHM_V + vst0) = sr_[i].vs0; *(bf16x8*)(V_lds + (b) * SHM_V + vst1) = sr_[i].vs1; const int kc = sc * 2; \
    *(bf16x8*)(K_lds + (b) * SHM_K + KSWZ(sr, kc)) = sr_[i].ks0; *(bf16x8*)(K_lds + (b) * SHM_K + KSWZ(32 + sr, kc)) = sr_[i].ks1; \
    if constexpr (C::PE) *(bf16x8*)(P_lds + (b) * SHM_P + PSWZ(pr, pc * 2)) = sr_[i].ps; } while (0)
#define SWAIT() do { if constexpr (SD == 2) { if constexpr (C::PE) asm volatile("s_waitcnt vmcnt(5)" ::: "memory"); else asm volatile("s_waitcnt vmcnt(4)" ::: "memory"); } else asm volatile("s_waitcnt vmcnt(0)" ::: "memory"); } while (0)
#define RESC(a) do { if (__any((a) < 1.f)) { if (hi == 0) al_l[r32] = (a); asm volatile("s_waitcnt lgkmcnt(0)" ::: "memory"); \
    _Pragma("unroll") for (int d = 0; d < 4; ++d) _Pragma("unroll") for (int r = 0; r < 16; ++r) o[d][r] *= al_l[crow(r, hi)]; } } while (0)
    f32x16 pA0, pA1, pB0, pB1; float mnA, mnB, alA, alB; bf16x8 pa0, pa1, pa2, pa3; const int NTl = seq / 64;
    if (__builtin_amdgcn_readfirstlane(wid) >= 4) __builtin_amdgcn_s_setprio(1);
    constexpr int SE = 0, SO = SD - 1;
    constexpr int NPK = (C::ND - C::NDR) > 0 ? (C::ND - C::NDR) : 1; u32x4 qp[NPK];
    if (XP && have) {
        if constexpr (XP) {
#pragma unroll
            for (int d0 = 0; d0 < C::NDR; ++d0) qr[d0] = pre->q[d0];
#pragma unroll
            for (int d1 = 0; d1 < C::ND - C::NDR; ++d1) qp[d1] = pre->qp[d1];
            sr_[SE].vs0 = pre->vs0; sr_[SE].vs1 = pre->vs1; sr_[SE].ks0 = pre->ks0; sr_[SE].ks1 = pre->ks1; sr_[SE].ps = pre->ps;
        }
    } else {
#pragma unroll
        for (int d0 = 0; d0 < C::NDR; ++d0) qr[d0] = *reinterpret_cast<const bf16x8*>(Qw + d0 * 16);
        if constexpr (C::PE) {
#pragma unroll
            for (int d1 = 0; d1 < C::ND - C::NDR; ++d1) qp[d1] = *reinterpret_cast<const u32x4*>(Qw + (C::NDR + d1) * 16);
        }
        SLOAD(SE, 0); if constexpr (SD == 2) SLOAD(SO, 64);
    }
    if constexpr (C::QNORM) {
        float ss = 0.f;
#pragma unroll
        for (int d0 = 0; d0 < 8; ++d0) { float x[8]; unpack8(*reinterpret_cast<const u32x4*>(&qr[d0]), x);
#pragma unroll
            for (int e = 0; e < 8; ++e) ss += x[e] * x[e]; }
        { auto rr = __builtin_amdgcn_permlane32_swap(__float_as_uint(ss), __float_as_uint(ss), false, false); ss = __uint_as_float(rr[0]) + __uint_as_float(rr[1]); }
        const float inv = rsqrtf(ss * (1.0f / 128.0f) + 1e-6f);
#pragma unroll
        for (int d0 = 0; d0 < 8; ++d0) { float x[8]; unpack8(*reinterpret_cast<const u32x4*>(&qr[d0]), x); const int dim = d0 * 16 + hi * 8;
            const f32x4 g0 = *(const f32x4*)(qg + dim), g1 = *(const f32x4*)(qg + dim + 4);
#pragma unroll
            for (int e = 0; e < 4; ++e) { x[e] = x[e] * inv * g0[e]; x[4 + e] = x[4 + e] * inv * g1[e]; }
            if (ropeC != nullptr) { const int to = (t0 + wid * 32 + r32) * 64 + (dim >> 1); rope8(x, ropeC + to, ropeS + to); }
            const u32x4 w = pack8(x); qr[d0] = *reinterpret_cast<const bf16x8*>(&w); }
    }
    if constexpr (C::PE) {
#pragma unroll
        for (int d1 = 0; d1 < C::ND - C::NDR; ++d1) {
            u32x4 f = qp[d1];
            if (C::NDR + d1 >= 8 && ropeC != nullptr) {
                const int pe = C::NDR + d1 - 8; const int to = (t0 + wid * 32 + r32) * 32 + pe * 8 + hi * 4;
                float x[8]; unpack8(f, x); rope8(x, ropeC + to, ropeS + to); f = pack8(x); }
            *reinterpret_cast<u32x4*>(Qpe + d1 * 1024) = f; }
    }
    if constexpr (SD == 2) { if constexpr (C::PE) asm volatile("s_waitcnt vmcnt(5)" ::: "memory"); else asm volatile("s_waitcnt vmcnt(4)" ::: "memory"); } else asm volatile("s_waitcnt vmcnt(0)" ::: "memory");
    SWRITE(0, SE);
    if constexpr (SD == 1) SLOAD(SO, 64); else { if (2 < NTl) SLOAD(SE, 2 * 64); }
    __syncthreads();
    qkt<C>(pA0, pA1, K_lds, P_lds, qr, Qpe, r32, hi); partialSM<C>(pA0, pA1, m_reg, mnA, alA);
    SWAIT(); SWRITE(1, SO); if constexpr (SD == 1) { if (2 < NTl) SLOAD(SO, 2 * 64); } __syncthreads();
    for (int j = 1; j + 1 < NTl; j += 2) {
        SBAR(); qkt<C>(pB0, pB1, K_lds + SHM_K, P_lds + SHM_P, qr, Qpe, r32, hi);
        finishSM(pA0, pA1, alA, l_reg, pa0, pa1, pa2, pa3); qk_pipe<C>(); SBAR();
        if constexpr (SD == 2) SLOAD(SO, (j + SD) * 64); SBAR();
        pv_psm<C>(o, vb0, pa0, pa1, pa2, pa3, pB0, pB1, m_reg, mnB, alB);
        __syncthreads(); SWAIT(); SWRITE(0, SE); if constexpr (SD == 1) SLOAD(SE, (j + 2) * 64);
        RESC(alB); __syncthreads();
        SBAR(); qkt<C>(pA0, pA1, K_lds, P_lds, qr, Qpe, r32, hi);
        finishSM(pB0, pB1, alB, l_reg, pa0, pa1, pa2, pa3); qk_pipe<C>(); SBAR();
        if constexpr (SD == 2) { if (j + 3 < NTl) SLOAD(SE, (j + 1 + SD) * 64); } SBAR();
        pv_psm<C>(o, vb0 + (int)SHM_V, pa0, pa1, pa2, pa3, pA0, pA1, m_reg, mnA, alA);
        __syncthreads(); SWAIT(); SWRITE(1, SO); if constexpr (SD == 1) { if (j + 3 < NTl) SLOAD(SO, (j + 3) * 64); }
        RESC(alA); __syncthreads();
    }
    SBAR(); qkt<C>(pB0, pB1, K_lds + SHM_K, P_lds + SHM_P, qr, Qpe, r32, hi);
    finishSM(pA0, pA1, alA, l_reg, pa0, pa1, pa2, pa3); SBAR();
    const int widu = __builtin_amdgcn_readfirstlane(wid);
    const char* Gw = (const char*)(Gb + (long)(widu * 32) * C::LDG); char* Ow = (char*)(Ob + (long)(widu * 32) * C::LDO);
    asm volatile("" : "+s"(Gw));
    u32x4 gq[8];
#pragma unroll
    for (int i = 0; i < 8; ++i) { const int ch = i * 64 + lane; gq[i] = *(const GAS u32x4*)((const GAS char*)Gw + (unsigned)((ch >> 4) * C::LDG * 2 + (ch & 15) * 16)); }
    SBAR();
    pv_psm<C>(o, vb0, pa0, pa1, pa2, pa3, pB0, pB1, m_reg, mnB, alB);
    __syncthreads(); RESC(alB);
    finishSM(pB0, pB1, alB, l_reg, pa0, pa1, pa2, pa3); SBAR();
    pv_d0(o, vb0 + (int)SHM_V, pa0, pa1, pa2, pa3);
    if constexpr (XP) {
        static_assert(!XP || (SD == 1 && C::PE && C::NDR == 8 && C::ND == 12), "cross-unit prefetch is written for the MLA configuration");
        {
            int t2 = tid; asm volatile("" : "+v"(t2));
            const int w2 = t2 >> 6, l2 = t2 & 63, sr2 = t2 >> 4, sc2 = (t2 & 15) * 8, pr2 = t2 >> 3, pc2 = (t2 & 7) * 8;
            const bf16_t* nQw = nxt.Q + (long)(w2 * 32 + (l2 & 31)) * C::LDQ + (l2 >> 5) * 8;
#pragma unroll
            for (int d0 = 0; d0 < C::NDR; ++d0) pre->q[d0] = *reinterpret_cast<const bf16x8*>(nQw + d0 * 16);
#pragma unroll
            for (int d1 = 0; d1 < C::ND - C::NDR; ++d1) pre->qp[d1] = *reinterpret_cast<const u32x4*>(nQw + (C::NDR + d1) * 16);
            pre->vs0 = *reinterpret_cast<const bf16x8*>(&nxt.V[(long)sr2 * C::LDV + sc2]); pre->vs1 = *reinterpret_cast<const bf16x8*>(&nxt.V[(long)(32 + sr2) * C::LDV + sc2]);
            pre->ks0 = *reinterpret_cast<const bf16x8*>(&nxt.K[(long)sr2 * C::LDK + sc2]); pre->ks1 = *reinterpret_cast<const bf16x8*>(&nxt.K[(long)(32 + sr2) * C::LDK + sc2]);
            pre->ps = *reinterpret_cast<const bf16x8*>(&nxt.P[(long)pr2 * 64 + pc2]);
        }
    }
    if (hi == 0) li_l[r32] = l_reg; asm volatile("s_waitcnt lgkmcnt(0)" ::: "memory");
    float rli[16];
#pragma unroll
    for (int r = 0; r < 16; ++r) rli[r] = __builtin_amdgcn_rcpf(li_l[crow(r, hi)]);
    __builtin_amdgcn_s_setprio(0);
    __syncthreads();
    int te = tid; asm volatile("" : "+v"(te));
    const int lane_e = te & 63, r32e = te & 31, hie = (te >> 5) & 1;
    char* Ost = lds + (te >> 6) * 8192;
#pragma unroll
    for (int r = 0; r < 16; ++r)
#pragma unroll
        for (int d0 = 0; d0 < 4; ++d0) *(bf16_t*)(Ost + crow(r, hie) * 256 + (d0 * 32 + r32e) * 2) = (bf16_t)(cvt_pk_bf16(o[d0][r] * rli[r], 0.f) & 0xffffu);
    asm volatile("s_waitcnt lgkmcnt(0)" ::: "memory");
#pragma unroll
    for (int i = 0; i < 8; ++i) { const int ch = i * 64 + lane_e; const int row = ch >> 4, c8 = ch & 15;
        float ov[8], gvv[8]; unpack8(*(const u32x4*)(Ost + row * 256 + c8 * 16), ov); unpack8(gq[i], gvv);
#pragma unroll
        for (int e = 0; e < 8; ++e) ov[e] *= silu_f(gvv[e]);
        *(u32x4*)(Ow + (unsigned)(row * C::LDO * 2 + c8 * 16)) = pack8(ov); if constexpr (XP) SBAR(); }
#undef SLOAD
#undef GAS
#undef SWRITE
#undef SWAIT
#undef RESC
}

constexpr int SLOT_BYTES = 18688;
#define LFENCE() asm volatile("s_waitcnt lgkmcnt(0)" ::: "memory")
#ifdef USE_LF2
#define LF2() __builtin_amdgcn_sched_barrier(0)
#else
#define LF2() do {} while (0)
#endif
__device__ __forceinline__ float ldf(const float* base, unsigned boff) { return *(const float*)((const char*)base + boff); }
__device__ __forceinline__ void stf(float* base, unsigned boff, float v) { *(float*)((char*)base + boff) = v; }
struct Chain { const bf16_t* Rb; const bf16_t* KKb; const bf16_t* Vb; const bf16_t* Wd; const bf16_t* Ad; const bf16_t* Kb; bf16_t* Yd; float k_a; int row0, T, h, d; };
__device__ __forceinline__ unsigned chain_eoff(const Chain& c, int step, int col) { const int row = c.row0 + (c.d ? c.T - 1 - step : step); return ((unsigned)row * (unsigned)AW + (unsigned)col) * 4u; }

struct ScanOps { float w[16], ka[16], b[16], k[16], r[16], v[16]; };
struct ScanStage { u32x4 st[6][2]; };
__device__ __forceinline__ void scanA_issue(const Chain& c, int chunk, int lane_, ScanStage& g) {
    int lane = lane_; asm volatile("" : "+v"(lane));
    const bf16_t* arr[6] = {c.Wd, c.KKb, c.Ad, c.Kb, c.Rb, c.Vb};
#pragma unroll
    for (int k2 = 0; k2 < 2; ++k2) { const int idx = lane + 64 * k2, tau = idx >> 3, q = idx & 7; const int step = chunk * 16 + tau;
        const int row = c.row0 + (c.d ? c.T - 1 - step : step); const unsigned boff = ((unsigned)row * (unsigned)AW + (unsigned)(c.h * 64 + q * 8)) * 2u;
#pragma unroll
        for (int a = 0; a < 6; ++a) g.st[a][k2] = *(const u32x4*)((const char*)arr[a] + boff); }
}
__device__ __forceinline__ void scanA_unpack(const ScanStage& g, int lane_, char* slot, ScanOps& o) {
    int lane = lane_; asm volatile("" : "+v"(lane));
#pragma unroll
    for (int k2 = 0; k2 < 2; ++k2) { const int idx = lane + 64 * k2;
#pragma unroll
        for (int a = 0; a < 6; ++a) *(u32x4*)(slot + a * 2048 + idx * 16) = g.st[a][k2]; }
    asm volatile("s_waitcnt lgkmcnt(0)" ::: "memory");
#pragma unroll
    for (int t = 0; t < 16; ++t) { const char* e = slot + t * 128 + lane * 2;
        o.w[t] = bf2f(*(const bf16_t*)(e)); o.ka[t] = bf2f(*(const bf16_t*)(e + 2048)); o.b[t] = bf2f(*(const bf16_t*)(e + 4096));
        o.k[t] = bf2f(*(const bf16_t*)(e + 6144)); o.r[t] = bf2f(*(const bf16_t*)(e + 8192)); o.v[t] = bf2f(*(const bf16_t*)(e + 10240)); }
    asm volatile("s_waitcnt lgkmcnt(0)" ::: "memory");
}
__device__ __forceinline__ void scanA(const Chain& c, int chunk, const ScanOps& o, int lane_, char* slot) {
    int lane = lane_; asm volatile("" : "+v"(lane));
    float bt[16], kq[16]; float gL;
    float vv[16];
#pragma unroll
    for (int t = 0; t < 16; ++t) vv[t] = o.v[t];
    {
        float kt[16], rt[16]; float g = 1.0f;
        float cu = 0.f;
#pragma unroll
        for (int t = 0; t < 16; ++t) { const float gp = g; cu += o.w[t]; g = __builtin_amdgcn_exp2f(cu); const float ig = __builtin_amdgcn_exp2f(-cu);
            const float av = o.b[t], bb = o.ka[t] * av, kd = o.k[t] * (1.0f + (av - 1.0f) * c.k_a);
            kt[t] = o.ka[t] * gp; rt[t] = o.r[t] * g; bt[t] = bb * ig; kq[t] = kd * ig; }
        gL = g;
#pragma unroll
        for (int t = 0; t < 16; ++t) {
            const int o0 = t * 128 + ((lane * 2) ^ ((t & 7) << 4)), o1 = (16 + t) * 128 + ((lane * 2) ^ ((t & 7) << 4));
            *(bf16_t*)(slot + o0) = (bf16_t)(cvt_pk_bf16(bt[t], 0.f) & 0xffffu); *(bf16_t*)(slot + o1) = (bf16_t)(cvt_pk_bf16(kq[t], 0.f) & 0xffffu);
            *(bf16_t*)(slot + 8192 + o0) = (bf16_t)(cvt_pk_bf16(kt[t], 0.f) & 0xffffu); *(bf16_t*)(slot + 8192 + o1) = (bf16_t)(cvt_pk_bf16(rt[t], 0.f) & 0xffffu);
        }
#pragma unroll
        for (int q = 0; q < 2; ++q) {
            *(u32x4*)(slot + 12544 + lane * 64 + 16 * q) = (u32x4){cvt_pk_bf16(kt[8 * q], kt[8 * q + 1]), cvt_pk_bf16(kt[8 * q + 2], kt[8 * q + 3]), cvt_pk_bf16(kt[8 * q + 4], kt[8 * q + 5]), cvt_pk_bf16(kt[8 * q + 6], kt[8 * q + 7])};
            *(u32x4*)(slot + 12544 + lane * 64 + 32 + 16 * q) = (u32x4){cvt_pk_bf16(rt[8 * q], rt[8 * q + 1]), cvt_pk_bf16(rt[8 * q + 2], rt[8 * q + 3]), cvt_pk_bf16(rt[8 * q + 4], rt[8 * q + 5]), cvt_pk_bf16(rt[8 * q + 6], rt[8 * q + 7])};
        }

        *(float*)(slot + 12288 + lane * 4) = gL;
    }
    LFENCE();
    const int m = lane & 31, hi = lane >> 5;
    {
        f32x16 C = {};
#pragma unroll
        for (int ks = 0; ks < 4; ++ks) { const int o = m * 128 + (((2 * ks + hi) ^ (m & 7)) << 4);
            const bf16x8 a = *(const bf16x8*)(slot + o), b = *(const bf16x8*)(slot + 8192 + o);
            C = __builtin_amdgcn_mfma_f32_32x32x16_bf16(a, b, C, 0, 0, 0); }
        LFENCE();
#pragma unroll
        for (int r = 0; r < 16; ++r) *(float*)(slot + (crow(r, hi) * 32 + m) * 4) = C[r];
    }
    LFENCE();
    const float* G = (const float*)slot; float* Tm = (float*)(slot + 8192); float* Wm = (float*)(slot + 6144);
    char* B1T = slot + 9216; char* B2T = slot + 11264;
    {
        const int tcol = lane & 15, sq = lane >> 4;
        float Tc[16];
#pragma unroll
        for (int s = 0; s < 16; ++s) Tc[s] = (s == tcol) ? 1.0f : 0.0f;
#pragma unroll
        for (int s = 14; s >= 0; --s) {
            float a = 0.f;
#pragma unroll
            for (int q = (s + 1) / 4; q < 4; ++q) { const f32x4 gr = *(const f32x4*)(G + s * 32 + 4 * q);
#pragma unroll
                for (int e = 0; e < 4; ++e) if (4 * q + e > s) a += gr[e] * Tc[4 * q + e]; }
            if (s < tcol) Tc[s] = -a;
        }
        if (lane < 16) {
#pragma unroll
            for (int s = 0; s < 16; ++s) Tm[s * 16 + tcol] = Tc[s];
            const u32x4 z4 = (u32x4){0u, 0u, 0u, 0u};
            *(u32x4*)(B1T + tcol * 64) = (u32x4){cvt_pk_bf16(Tc[0], Tc[1]), cvt_pk_bf16(Tc[2], Tc[3]), cvt_pk_bf16(Tc[4], Tc[5]), cvt_pk_bf16(Tc[6], Tc[7])};
            *(u32x4*)(B1T + tcol * 64 + 16) = (u32x4){cvt_pk_bf16(Tc[8], Tc[9]), cvt_pk_bf16(Tc[10], Tc[11]), cvt_pk_bf16(Tc[12], Tc[13]), cvt_pk_bf16(Tc[14], Tc[15])};
            *(u32x4*)(B1T + tcol * 64 + 32) = z4; *(u32x4*)(B1T + tcol * 64 + 48) = z4;
            const unsigned one = (tcol & 1) ? 0x3F800000u : 0x00003F80u; const int wi = tcol >> 1;
            *(u32x4*)(B1T + (16 + tcol) * 64 + 32) = (u32x4){wi == 0 ? one : 0u, wi == 1 ? one : 0u, wi == 2 ? one : 0u, wi == 3 ? one : 0u};
            *(u32x4*)(B1T + (16 + tcol) * 64 + 48) = (u32x4){wi == 4 ? one : 0u, wi == 5 ? one : 0u, wi == 6 ? one : 0u, wi == 7 ? one : 0u};
        }
        float Wv[4];
#pragma unroll
        for (int si = 0; si < 4; ++si) { const int s = 4 * sq + si; float a = 0.f;
#pragma unroll
            for (int q = 0; q < 4; ++q) { const f32x4 gr = *(const f32x4*)(G + (16 + s) * 32 + 4 * q);
#pragma unroll
                for (int e = 0; e < 4; ++e) a += ((4 * q + e > s) ? gr[e] : 0.f) * Tc[4 * q + e]; }
            Wv[si] = a; Wm[s * 16 + tcol] = a; }
        *(u32x2*)(B2T + tcol * 32 + 8 * sq) = (u32x2){cvt_pk_bf16(Wv[0], Wv[1]), cvt_pk_bf16(Wv[2], Wv[3])};
        LFENCE();
        float nb[16];
#pragma unroll
        for (int u = 0; u < 16; ++u) { const float x = G[u * 32 + 16 + tcol]; nb[u] = (u <= tcol) ? x : 0.f; }
        float Zv[4], Nv[4];
#pragma unroll
        for (int si = 0; si < 4; ++si) { const int s = 4 * sq + si; const float nk = G[(16 + s) * 32 + 16 + tcol]; float a = (s <= tcol) ? nk : 0.f; float tn = 0.f;
#pragma unroll
            for (int q = 0; q < 4; ++q) { const f32x4 wr = *(const f32x4*)(Wm + s * 16 + 4 * q); const f32x4 tr = *(const f32x4*)(Tm + s * 16 + 4 * q);
#pragma unroll
                for (int e = 0; e < 4; ++e) { a -= wr[e] * nb[4 * q + e]; tn += tr[e] * nb[4 * q + e]; } }
            Zv[si] = a; Nv[si] = -tn; }
        *(u32x2*)(B2T + (16 + tcol) * 32 + 8 * sq) = (u32x2){cvt_pk_bf16(Zv[0], Zv[1]), cvt_pk_bf16(Zv[2], Zv[3])};
        *(u32x2*)(B1T + (16 + tcol) * 64 + 8 * sq) = (u32x2){cvt_pk_bf16(Nv[0], Nv[1]), cvt_pk_bf16(Nv[2], Nv[3])};
    }
    LFENCE();
    {
        f32x16 C0 = {}, C1 = {};
#pragma unroll
        for (int ks = 0; ks < 2; ++ks) { const bf16x8 b = *(const bf16x8*)(B1T + m * 64 + (16 * ks + 8 * hi) * 2);
            C0 = __builtin_amdgcn_mfma_f32_32x32x16_bf16(*(const bf16x8*)(slot + 12544 + m * 64 + (16 * ks + 8 * hi) * 2), b, C0, 0, 0, 0);
            C1 = __builtin_amdgcn_mfma_f32_32x32x16_bf16(*(const bf16x8*)(slot + 12544 + (32 + m) * 64 + (16 * ks + 8 * hi) * 2), b, C1, 0, 0, 0); }
        LFENCE();
        const int tile = m >> 4, t = m & 15;
#pragma unroll
        for (int half = 0; half < 2; ++half) { const int gq = 2 * half + hi;
            *(u32x4*)(slot + ((tile * 2 + 0) * 64 + t + 16 * gq) * 16) = (u32x4){cvt_pk_bf16(C0[4 * half], C0[4 * half + 1]), cvt_pk_bf16(C0[4 * half + 2], C0[4 * half + 3]),
                                                                             cvt_pk_bf16(C0[4 * half + 8], C0[4 * half + 9]), cvt_pk_bf16(C0[4 * half + 10], C0[4 * half + 11])};
            *(u32x4*)(slot + ((tile * 2 + 1) * 64 + t + 16 * gq) * 16) = (u32x4){cvt_pk_bf16(C1[4 * half], C1[4 * half + 1]), cvt_pk_bf16(C1[4 * half + 2], C1[4 * half + 3]),
                                                                             cvt_pk_bf16(C1[4 * half + 8], C1[4 * half + 9]), cvt_pk_bf16(C1[4 * half + 10], C1[4 * half + 11])}; }
    }
#pragma unroll
    for (int q = 0; q < 2; ++q)
        *(u32x4*)(slot + 16640 + lane * 32 + 16 * q) = (u32x4){cvt_pk_bf16(vv[8 * q], vv[8 * q + 1]), cvt_pk_bf16(vv[8 * q + 2], vv[8 * q + 3]), cvt_pk_bf16(vv[8 * q + 4], vv[8 * q + 5]), cvt_pk_bf16(vv[8 * q + 6], vv[8 * q + 7])};
    LFENCE();
    {
        const bf16x8 b = *(const bf16x8*)(B2T + m * 32 + 8 * hi * 2);
        const f32x16 z16 = {};
        const f32x16 C0 = __builtin_amdgcn_mfma_f32_32x32x16_bf16(*(const bf16x8*)(slot + 16640 + m * 32 + 8 * hi * 2), b, z16, 0, 0, 0);
        const f32x16 C1 = __builtin_amdgcn_mfma_f32_32x32x16_bf16(*(const bf16x8*)(slot + 16640 + (32 + m) * 32 + 8 * hi * 2), b, z16, 0, 0, 0);
        LFENCE();
        char* dst = slot + (m < 16 ? 8192 : 12544) + (m & 15) * 4;
#pragma unroll
        for (int r = 0; r < 16; ++r) { *(float*)(dst + crow(r, hi) * 64) = C0[r]; *(float*)(dst + (32 + crow(r, hi)) * 64) = C1[r]; }
    }
#pragma unroll
    for (int g4 = 0; g4 < 4; ++g4) {
        u32x4 w; w.x = cvt_pk_bf16(kq[4 * g4] * gL, kq[4 * g4 + 1] * gL); w.y = cvt_pk_bf16(kq[4 * g4 + 2] * gL, kq[4 * g4 + 3] * gL);
        w.z = cvt_pk_bf16(-bt[4 * g4] * gL, -bt[4 * g4 + 1] * gL); w.w = cvt_pk_bf16(-bt[4 * g4 + 2] * gL, -bt[4 * g4 + 3] * gL);
        *(u32x4*)(slot + 4096 + ((lane >> 4) * 64 + (lane & 15) + 16 * g4) * 16) = w;
    }
}

__device__ __forceinline__ void scanB(const Chain& c, int chunk, int lane_, int sl, const char* slot, f32x4 (&acc)[4]) {
    int lane = lane_; asm volatile("" : "+v"(lane));
    const int n = lane & 15, g = lane >> 4; const int col = c.h * 64 + 16 * sl + n;
    unsigned offs[4]; const int estride = c.d ? -AW * 4 : AW * 4; const unsigned e0 = chain_eoff(c, chunk * 16 + 4 * g, col);
#pragma unroll
    for (int e = 0; e < 4; ++e) offs[e] = e0 + (unsigned)(e * estride);
    const u32x2 vq2 = *(const u32x2*)(slot + 16640 + (16 * sl + n) * 32 + 8 * g);

    bf16x8 bfr[2];
#pragma unroll
    for (int s = 0; s < 2; ++s) { u32x4 w; w.x = cvt_pk_bf16(acc[2 * s][0], acc[2 * s][1]); w.y = cvt_pk_bf16(acc[2 * s][2], acc[2 * s][3]);
        w.z = cvt_pk_bf16(acc[2 * s + 1][0], acc[2 * s + 1][1]); w.w = cvt_pk_bf16(acc[2 * s + 1][2], acc[2 * s + 1][3]); bfr[s] = *reinterpret_cast<bf16x8*>(&w); }
    f32x4 aU = *(const f32x4*)(slot + 8192 + (16 * sl + n) * 64 + 16 * g);
    f32x4 aY = *(const f32x4*)(slot + 12544 + (16 * sl + n) * 64 + 16 * g);
#pragma unroll
    for (int s = 0; s < 2; ++s) {
        aU = __builtin_amdgcn_mfma_f32_16x16x32_bf16(*(const bf16x8*)(slot + ((0 * 2 + s) * 64 + lane) * 16), bfr[s], aU, 0, 0, 0);
        aY = __builtin_amdgcn_mfma_f32_16x16x32_bf16(*(const bf16x8*)(slot + ((1 * 2 + s) * 64 + lane) * 16), bfr[s], aY, 0, 0, 0);
    }
#pragma unroll
    for (int e = 0; e < 4; ++e) *(bf16_t*)((char*)c.Yd + (offs[e] >> 1)) = (bf16_t)(cvt_pk_bf16(aY[e], 0.f) & 0xffffu);
    bf16x8 b2; { u32x4 w; w.x = vq2.x; w.y = vq2.y; w.z = cvt_pk_bf16(aU[0], aU[1]); w.w = cvt_pk_bf16(aU[2], aU[3]); b2 = *reinterpret_cast<bf16x8*>(&w); }
#pragma unroll
    for (int tl = 0; tl < 4; ++tl) { const f32x4 gm = *(const f32x4*)(slot + 12288 + (16 * tl + 4 * g) * 4);
        acc[tl] = __builtin_amdgcn_mfma_f32_16x16x32_bf16(*(const bf16x8*)(slot + 4096 + (tl * 64 + lane) * 16), b2, acc[tl] * gm, 0, 0, 0); }
}

__device__ __forceinline__ void scan_pair(KP p, bool samp, int q, char* lds) {
    int tid_ = TIDX; asm volatile("" : "+v"(tid_));
    const int lane = tid_ & 63, wave = __builtin_amdgcn_readfirstlane(tid_ >> 6), grp = wave >> 2, sl = wave & 3;
    unsigned char* ws = p->ws;
    const int ci = 2 * q + grp, b = ci >> 6, h = (ci >> 1) & 31, d = ci & 1;
    Chain c; c.Rb = (const bf16_t*)(ws + WS_R); c.KKb = (const bf16_t*)(p->out + OUT_Y); c.Vb = (const bf16_t*)(p->out + OUT_Y + (size_t)NT * AW);
    c.Wd = (const bf16_t*)(ws + WS_WD + (size_t)d * 2 * SZA); c.Ad = (const bf16_t*)(ws + WS_WD + (size_t)d * 2 * SZA + SZA); c.Kb = (const bf16_t*)(ws + WS_K); c.k_a = p->in[I_KA][h * 64 + lane];
    c.Yd = (bf16_t*)(ws + WS_YA + (size_t)d * SZA); c.T = samp ? 2048 : 256; c.row0 = samp ? NP + b * 2048 : b * 256; c.h = h; c.d = d;
    const int n = lane & 15, g = lane >> 4;
    f32x4 acc[4];
    if (samp) { const float* s0 = p->in[I_STATE] + ((size_t)((b * 2 + d) * 32 + h)) * 4096 + (16 * sl + n) * 64 + 4 * g;
#pragma unroll
        for (int tl = 0; tl < 4; ++tl) acc[tl] = *(const f32x4*)(s0 + 16 * tl); }
    else {
#pragma unroll
        for (int tl = 0; tl < 4; ++tl) acc[tl] = (f32x4){0.f, 0.f, 0.f, 0.f}; }
    char* slots = lds + grp * 4 * SLOT_BYTES;
    const int NR = c.T / 64;
    ScanStage stg; scanA_issue(c, sl, lane, stg);
    for (int R = 0; R < NR; ++R) {
        { ScanOps ops; scanA_unpack(stg, lane, slots + sl * SLOT_BYTES, ops);
          if (R + 1 < NR) scanA_issue(c, 4 * (R + 1) + sl, lane, stg);
          scanA(c, 4 * R + sl, ops, lane, slots + sl * SLOT_BYTES); }
        asm volatile("s_waitcnt lgkmcnt(0)" ::: "memory"); __builtin_amdgcn_s_barrier(); asm volatile("" ::: "memory");
#pragma unroll
        for (int cc = 0; cc < 4; ++cc) scanB(c, 4 * R + cc, lane, sl, slots + cc * SLOT_BYTES, acc);
        asm volatile("s_waitcnt lgkmcnt(0)" ::: "memory"); __builtin_amdgcn_s_barrier(); asm volatile("" ::: "memory");
    }
    if (!samp) { float* so = p->out + OUT_STATE + ((size_t)((b * 2 + d) * 32 + h)) * 4096 + (16 * sl + n) * 64 + 4 * g;
#pragma unroll
        for (int tl = 0; tl < 4; ++tl) *(f32x4*)(so + 16 * tl) = acc[tl]; }
}

__device__ __forceinline__ void phase_scan_attn(KP p, char* lds) {
    unsigned char* ws = p->ws;
    unsigned* qhead = (unsigned*)(ws + WS_CTL) + 4096;
    bf16_t* projB = (bf16_t*)(ws + WS_PROJB); bf16_t* mixed = (bf16_t*)(ws + WS_MIXED);
#ifdef STATIC_Q
    for (int item = blockIdx.x; item < 1408; item += gridDim.x) {
        __syncthreads();
#else
    for (;;) {
        unsigned qa = LDS_X + 64; asm volatile("" : "+s"(qa));
        volatile LAS unsigned* qslot = (volatile LAS unsigned*)(LAS char*)(uintptr_t)qa;
        __syncthreads();
        if (TIDX == 0) *qslot = __hip_atomic_fetch_add(qhead, 1u, __ATOMIC_RELAXED, __HIP_MEMORY_SCOPE_AGENT);
        __syncthreads();
        const int item = (int)__builtin_amdgcn_readfirstlane(*qslot);
        if (item >= 1408) break;
#endif
#ifndef Q_NO_SCAN
        if (item < 128) scan_pair(p, true, item, lds); else
#endif
#ifndef Q_NO_ATTN
        if (item < 640) { const int su = item - 128;
            const int b = su >> 7, h = (su >> 3) & 15, qb = su & 7; const size_t row0 = (size_t)NP + b * 2048 + qb * 256; const size_t k0 = ((size_t)b * 2304) * 512 + (h >> 2) * 128;
            attn_body<CfgGqa>(projB + row0 * N1B + 2048 + h * 128, (const bf16_t*)(ws + WS_KBS) + k0, (const bf16_t*)(ws + WS_VBS) + k0, nullptr,
                              mixed + row0 * DM + 2048 + h * 128, projB + row0 * N1B + 5120 + h * 128, 2304, lds, (const float*)(ws + WS_ROPEB_COS), (const float*)(ws + WS_ROPEB_SIN), qb * 256, p->in[I_QG]); }
        else
#endif
#ifndef Q_NO_SCAN
        if (item < 1152) scan_pair(p, false, item - 640, lds); else
#endif
#ifndef Q_NO_ATTN
        { const int pu = item - 1152;
            const int b = pu >> 4, h = pu & 15; const size_t row0 = (size_t)b * 256; const size_t k0 = row0 * 512 + (h >> 2) * 128;
            attn_body<CfgGqa>(projB + row0 * N1B + 2048 + h * 128, (const bf16_t*)(ws + WS_KBP) + k0, (const bf16_t*)(ws + WS_VBP) + k0, nullptr,
                              mixed + row0 * DM + 2048 + h * 128, projB + row0 * N1B + 5120 + h * 128, 256, lds, nullptr, nullptr, 0, p->in[I_QG]); }
#else
        {}
#endif
    }
}

__device__ __forceinline__ void phase_mix(KP p) {
    unsigned char* ws = p->ws;
    const int lane = TIDX & 63, wave = TIDX >> 6, gw = blockIdx.x * 8 + wave, nw = gridDim.x * 8;
    const bf16_t* Y0 = (const bf16_t*)(ws + WS_YA); const bf16_t* Y1 = (const bf16_t*)(ws + WS_YA + SZA);
    const bf16_t* Rb = (const bf16_t*)(ws + WS_R); const bf16_t* Vb = (const bf16_t*)(p->out + OUT_Y + (size_t)NT * AW);
    const bf16_t* A0 = (const bf16_t*)(ws + WS_WD + SZA); const bf16_t* A1 = (const bf16_t*)(ws + WS_WD + 3 * SZA); const bf16_t* Kb = (const bf16_t*)(ws + WS_K); const float* k_a = p->in[I_KA];
    const bf16_t* projB = (const bf16_t*)(ws + WS_PROJB); bf16_t* mixed = (bf16_t*)(ws + WS_MIXED);
    const float* lnw = p->in[I_LNW]; const float* lnb = p->in[I_LNB]; const float* rk = p->in[I_RK];
    for (int row = gw; row < NT; row += nw) {
#pragma unroll
      for (int hh = 0; hh < 2; ++hh) {
        u32x4 qy0[4], qy1[4], qr[4], qk[4], qa0[4], qa1[4], qv[4], qg[4];
#pragma unroll
        for (int it = 2 * hh; it < 2 * hh + 2; ++it) { const int col = (lane + 64 * it) * 8; const size_t o = (size_t)row * AW + col;
            qy0[it] = *(const u32x4*)(Y0 + o); qy1[it] = *(const u32x4*)(Y1 + o); qr[it] = *(const u32x4*)(Rb + o); qk[it] = *(const u32x4*)(Kb + o);
            qa0[it] = *(const u32x4*)(A0 + o); qa1[it] = *(const u32x4*)(A1 + o); qv[it] = *(const u32x4*)(Vb + o); qg[it] = *(const u32x4*)(projB + (size_t)row * N1B + col); }
#pragma unroll
        for (int it = 2 * hh; it < 2 * hh + 2; ++it) { const int col = (lane + 64 * it) * 8;
            float y[8], t1[8], t2[8];
            unpack8(qy0[it], y); unpack8(qy1[it], t1);
            float sm = 0.f;
#pragma unroll
            for (int e = 0; e < 8; ++e) { y[e] += t1[e]; sm += y[e]; }
            sm += __shfl_xor(sm, 1); sm += __shfl_xor(sm, 2); sm += __shfl_xor(sm, 4);
            const float mean = sm * (1.0f / 64.0f); float vs = 0.f;
#pragma unroll
            for (int e = 0; e < 8; ++e) { y[e] -= mean; vs += y[e] * y[e]; }
            vs += __shfl_xor(vs, 1); vs += __shfl_xor(vs, 2); vs += __shfl_xor(vs, 4);
            const float rs = rsqrtf(vs * (1.0f / 64.0f) + 64e-5f);
            float rr[8], kk8[8]; unpack8(qr[it], rr); unpack8(qk[it], kk8); unpack8(qa0[it], t1); unpack8(qa1[it], t2);
            const f32x4 ka0 = *(const f32x4*)(k_a + col), ka1 = *(const f32x4*)(k_a + col + 4), rk0 = *(const f32x4*)(rk + col), rk1 = *(const f32x4*)(rk + col + 4);
            float bs = 0.f;
#pragma unroll
            for (int e = 0; e < 8; ++e) { const float kav = e < 4 ? ka0[e & 3] : ka1[e & 3], rkv = e < 4 ? rk0[e & 3] : rk1[e & 3];
                bs += rr[e] * kk8[e] * ((t1[e] + t2[e] - 2.0f) * kav + 2.0f) * rkv; }
            bs += __shfl_xor(bs, 1); bs += __shfl_xor(bs, 2); bs += __shfl_xor(bs, 4);
            float vv8[8], gg[8], ov[8]; unpack8(qv[it], vv8); unpack8(qg[it], gg);
            const f32x4 lw0 = *(const f32x4*)(lnw + col), lw1 = *(const f32x4*)(lnw + col + 4), lb0 = *(const f32x4*)(lnb + col), lb1 = *(const f32x4*)(lnb + col + 4);
#pragma unroll
            for (int e = 0; e < 8; ++e) { const float lw = e < 4 ? lw0[e & 3] : lw1[e & 3], lb = e < 4 ? lb0[e & 3] : lb1[e & 3];
                ov[e] = (y[e] * rs * lw + lb + vv8[e] * bs) * silu_f(gg[e]); }
            *(u32x4*)(mixed + (size_t)row * DM + col) = pack8(ov);
        }
        asm volatile("" ::: "memory");
      }
    }
}

__device__ __forceinline__ void phase_prepC(KP p) {
    unsigned char* ws = p->ws;
    const int lane = TIDX & 63, wave = TIDX >> 6, gw = blockIdx.x * 8 + wave, nw = gridDim.x * 8;
    const bf16_t* projC = (const bf16_t*)(ws + WS_PROJC); bf16_t* qn = (bf16_t*)(ws + WS_QN); bf16_t* ckv = (bf16_t*)(ws + WS_CKV); bf16_t* kpe = (bf16_t*)(ws + WS_KPE);
    const float* cosC = (const float*)(ws + WS_ROPEC_COS); const float* sinC = (const float*)(ws + WS_ROPEC_SIN);
    const float* qag = p->in[I_QAG]; const float* kvag = p->in[I_KVAG];
    for (int row = gw; row < NT + 1024; row += nw) {
        if (row >= NT) {
            const int cr = row - NT, b = cr >> 8, t = cr & 255; const size_t krow = (size_t)NP + b * 2304 + t;
            { const float* s = p->in[I_CCKV] + (size_t)cr * 512 + lane * 8; const f32x4 a = *(const f32x4*)s, c = *(const f32x4*)(s + 4);
              *(u32x4*)(ckv + krow * 512 + lane * 8) = (u32x4){cvt_pk_bf16(a[0], a[1]), cvt_pk_bf16(a[2], a[3]), cvt_pk_bf16(c[0], c[1]), cvt_pk_bf16(c[2], c[3])}; }
            if (lane < 32) { const f32x2 a = *(const f32x2*)(p->in[I_CKPE] + (size_t)cr * 64 + lane * 2); *(unsigned*)(kpe + krow * 64 + lane * 2) = cvt_pk_bf16(a[0], a[1]); }
            continue;
        }
        const bool samp = row >= NP; int b = 0, t = 0; if (samp) { const int rr = row - NP; b = rr >> 11; t = rr & 2047; }
        const size_t krow = samp ? (size_t)NP + b * 2304 + 256 + t : (size_t)row;
        const u32x2* pc = (const u32x2*)(projC + (size_t)row * N3C);
        {
            f32x4 v[6]; float ss = 0.f;
#pragma unroll
            for (int i = 0; i < 6; ++i) { v[i] = up4(pc[lane + 64 * i]); ss += (v[i][0] * v[i][0] + v[i][1] * v[i][1]) + (v[i][2] * v[i][2] + v[i][3] * v[i][3]); }
            ss = wave_sum(ss); const float inv = rsqrtf(ss * (1.0f / 1536.0f) + 1e-6f);
#pragma unroll
            for (int i = 0; i < 6; ++i) { const int c4 = lane + 64 * i; const f32x4 o = v[i] * inv * ((const f32x4*)qag)[c4];
                u32x2 w; w.x = cvt_pk_bf16(o[0], o[1]); w.y = cvt_pk_bf16(o[2], o[3]); *(u32x2*)(qn + (size_t)row * 1536 + c4 * 4) = w; }
        }
        {
            f32x4 v[2]; float ss = 0.f;
#pragma unroll
            for (int i = 0; i < 2; ++i) { v[i] = up4(pc[384 + lane + 64 * i]); ss += (v[i][0] * v[i][0] + v[i][1] * v[i][1]) + (v[i][2] * v[i][2] + v[i][3] * v[i][3]); }
            ss = wave_sum(ss); const float inv = rsqrtf(ss * (1.0f / 512.0f) + 1e-6f);
#pragma unroll
            for (int i = 0; i < 2; ++i) { const int c4 = lane + 64 * i; const f32x4 o = v[i] * inv * ((const f32x4*)kvag)[c4];
                u32x2 w; w.x = cvt_pk_bf16(o[0], o[1]); w.y = cvt_pk_bf16(o[2], o[3]); *(u32x2*)(ckv + krow * 512 + c4 * 4) = w;
                if (!samp) *(f32x4*)(p->out + OUT_CKV + (size_t)row * 512 + c4 * 4) = o; }
        }
        if (lane < 32) {
            const unsigned xw = *(const unsigned*)(projC + (size_t)row * N3C + 2048 + lane * 2); const f32x2 x = (f32x2){bf_lo(xw), bf_hi(xw)}; f32x2 o = x;
            if (samp) { const float c = cosC[t * 32 + lane], s = sinC[t * 32 + lane]; o[0] = x[0] * c - x[1] * s; o[1] = x[0] * s + x[1] * c; }
            else *(f32x2*)(p->out + OUT_KPE + (size_t)row * 64 + lane * 2) = x;
            *(unsigned*)(kpe + krow * 64 + lane * 2) = cvt_pk_bf16(o[0], o[1]);
        }
    }
}

__device__ __forceinline__ void phase_mla_attn(KP p, char* lds) {
    unsigned char* ws = p->ws; const int G = gridDim.x, bid = blockIdx.x;
    const bf16_t* q = (const bf16_t*)(ws + WS_Q); const bf16_t* kv = (const bf16_t*)(ws + WS_KV); const bf16_t* kpe = (const bf16_t*)(ws + WS_KPE);
    bf16_t* og = (bf16_t*)(ws + WS_OG); const bf16_t* gate = (const bf16_t*)(ws + WS_GATEB);
    const int vcu = (G % 8 == 0) ? (bid % 8) * (G / 8) + bid / 8 : bid;
    const int nS = vcu < 2048 ? (2048 - vcu + G - 1) / G : 0, nP = vcu < 1024 ? (1024 - vcu + G - 1) / G : 0;
    AttnPre pre; bool have = false;
    for (int i = 0; i < nS + nP; ++i) {
        const bf16_t *Qb, *Kb, *Vb, *Pb, *Gb; bf16_t* Ob; int seq, t0; const float *rc, *rs;
        AttnNext nx; nx.valid = (i + 1 < nS + nP);
        {   const int j = i;
            if (j < nS) { const int su = vcu + j * G; const int b = su >> 9, h = (su >> 3) & 63, qb = su & 7; const size_t row0 = (size_t)NP + b * 2048 + qb * 256, kr0 = (size_t)NP + b * 2304;
                Qb = q + row0 * 12288 + h * 192; Kb = kv + kr0 * 16384 + h * 256; Vb = Kb + 128; Pb = kpe + kr0 * 64; Ob = og + row0 * 8192 + h * 128; Gb = gate + row0 * 8192 + h * 128;
                seq = 2304; t0 = qb * 256; rc = (const float*)(ws + WS_ROPEC_COS); rs = (const float*)(ws + WS_ROPEC_SIN); }
            else { const int pu = vcu + (j - nS) * G; const int b = pu >> 6, h = pu & 63; const size_t row0 = (size_t)b * 256;
                Qb = q + row0 * 12288 + h * 192; Kb = kv + row0 * 16384 + h * 256; Vb = Kb + 128; Pb = kpe + row0 * 64; Ob = og + row0 * 8192 + h * 128; Gb = gate + row0 * 8192 + h * 128;
                seq = 256; t0 = 0; rc = nullptr; rs = nullptr; } }
        {   const int j = nx.valid ? i + 1 : i;
            if (j < nS) { const int su = vcu + j * G; const int b = su >> 9, h = (su >> 3) & 63, qb = su & 7; const size_t row0 = (size_t)NP + b * 2048 + qb * 256, kr0 = (size_t)NP + b * 2304;
                nx.Q = q + row0 * 12288 + h * 192; nx.K = kv + kr0 * 16384 + h * 256; nx.V = nx.K + 128; nx.P = kpe + kr0 * 64; }
            else { const int pu = vcu + (j - nS) * G; const int b = pu >> 6, h = pu & 63; const size_t row0 = (size_t)b * 256;
                nx.Q = q + row0 * 12288 + h * 192; nx.K = kv + row0 * 16384 + h * 256; nx.V = nx.K + 128; nx.P = kpe + row0 * 64; } }
        attn_body<CfgMla, true>(Qb, Kb, Vb, Pb, Ob, Gb, seq, lds, rc, rs, t0, nullptr, &pre, have, nx);
        have = nx.valid;
    }
}

__device__ __forceinline__ void phase_final(KP p) {
    const int lane = TIDX & 63, wave = TIDX >> 6, gw = blockIdx.x * 8 + wave, nw = gridDim.x * 8;
    const float* g = p->in[I_FINALG]; const bf16_t* x2 = (const bf16_t*)(p->ws + WS_Q);
    for (int row = gw; row < NT; row += nw) {
        const u32x2* x = (const u32x2*)(x2 + (size_t)row * DM); float* y = p->out + OUT_Y + (size_t)row * DM;
        f32x4 v[16]; float ss = 0.f;
#pragma unroll
        for (int i = 0; i < 16; ++i) { v[i] = up4(x[lane + 64 * i]); ss += v[i][0] * v[i][0] + v[i][1] * v[i][1] + v[i][2] * v[i][2] + v[i][3] * v[i][3]; }
        ss = wave_sum(ss);
        const float inv = rsqrtf(ss * (1.0f / 4096.0f) + 1e-6f);
#pragma unroll
        for (int i = 0; i < 16; ++i) { const int c4 = lane + 64 * i; ((f32x4*)y)[c4] = v[i] * inv * ((const f32x4*)g)[c4]; }
    }
}

__global__ void __launch_bounds__(512, 2) fwd(Params pv) {
    extern __shared__ __attribute__((aligned(16))) unsigned char lds[];
    LAS unsigned char* ldsl = (LAS unsigned char*)lds;
    volatile LAS unsigned* xbw = (volatile LAS unsigned*)(ldsl + LDS_X);
    if (threadIdx.x < 4) xbw[threadIdx.x] = 0u;
    if ((threadIdx.x & 63) == 0) *(volatile LAS unsigned*)(LAS char*)(uintptr_t)(TID_TAB_OFF + 4u * hw_wave_slot()) = threadIdx.x >> 6;
    __syncthreads();
    XcdBarrier bar; bar.bar = (unsigned*)(pv.ws + WS_CTL); bar.x = 0; bar.st = xbw;
    if (!MK_PER_PHASE) bar = xcd_barrier_post((unsigned*)(pv.ws + WS_CTL), xbw);
    const int lo = pv.ph_lo, hi = pv.ph_hi;
#ifndef PH_MASK
#define PH_MASK 0x7fff
#endif
#define IN(k) (((PH_MASK >> (k)) & 1) && lo <= (k) && (k) < hi)
#define SEAM(k) do { if (!MK_PER_PHASE && IN(k) && IN((k) + 1)) xcd_barrier(bar); } while (0)
#define PH_BEGIN KP p = get_params(); unsigned char* ws = p->ws; const int G = gridDim.x, bid = blockIdx.x; (void)ws; (void)G; (void)bid;

    if (IN(0)) { PH_BEGIN phase0(p, lds); } SEAM(0);
    if (IN(1)) { PH_BEGIN phase_h(p, 0, p->in[I_XP], p->in[I_XS], (bf16_t*)(ws + WS_H0)); } SEAM(1);
    if (IN(2)) { PH_BEGIN pg8::Gemm g{(const bf16_t*)(ws + WS_H0), (const bf16_t*)(ws + WS_WTA), NT, N1, DM}; pg8::StaticOrder S; S.init(NT, N1, G, bid);
        EpiG1 E{(bf16_t*)(ws + WS_PROJF), (bf16_t*)(ws + WS_PROJB)}; pg8::gemm_phase(ldsl, g, S, E);
        { const int extra = ((NT / 256) * (N1 / 256)) % G; if (bid >= extra) { phase_cvt1(p, lds, 0, G - extra, bid - extra); phase_cvt1(p, lds, 1, G - extra, bid - extra); } } } SEAM(2);
    if (IN(3)) { PH_BEGIN phase_prepA(p); } SEAM(3);
    if (IN(4)) { PH_BEGIN
#pragma unroll
        for (int d = 0; d < 2; ++d) {
            pg8::Gemm g{(const bf16_t*)(ws + WS_LORA) + (size_t)d * NT * 256, (const bf16_t*)(ws + WS_WTLORA) + (size_t)d * 4096 * 256, NT, 4096, 256}; pg8::StaticOrder S; S.init(NT, 4096, G, bid);
            EpiLora E{p->in[I_W0] + d * 2048, p->in[I_A0] + d * 2048, (bf16_t*)(ws + WS_WD + (size_t)d * 2 * SZA), (bf16_t*)(ws + WS_WD + (size_t)d * 2 * SZA + SZA)}; pg8::gemm_phase(ldsl, g, S, E);
        } } SEAM(4);
    if (IN(5)) { PH_BEGIN phase_scan_attn(p, (char*)lds); } SEAM(5);
    if (IN(6)) { PH_BEGIN phase_mix(p); } SEAM(6);
    if (IN(7)) { PH_BEGIN pg8::Gemm g{(const bf16_t*)(ws + WS_MIXED), (const bf16_t*)(ws + WS_WTOUT), NT, DM, DM}; pg8::StaticOrder S; S.init(NT, DM, G, bid);
        EpiRes<false> E{p->in[I_XP], p->in[I_XS], nullptr, (bf16_t*)(p->out + OUT_Y), (const float*)(ws + WS_MOD) + 8192}; pg8::gemm_phase(ldsl, g, S, E);
        } SEAM(7);
    if (IN(8)) { PH_BEGIN phase_h_bf(p, 1, (const bf16_t*)(p->out + OUT_Y), (bf16_t*)(ws + WS_H1)); } SEAM(8);
    if (IN(9)) { PH_BEGIN pg8::Gemm g{(const bf16_t*)(ws + WS_H1), (const bf16_t*)(ws + WS_WTC), NT, N3, DM}; pg8::StaticOrder S; S.init(NT, N3, G, bid);
        EpiG3 E{(bf16_t*)(ws + WS_GATEB), (bf16_t*)(ws + WS_PROJC)}; pg8::gemm_phase(ldsl, g, S, E);
        { const int extra = ((NT / 256) * (N3 / 256)) % G; if (extra != 0 && bid >= extra) phase_cvt1(p, lds, 2, G - extra, bid - extra); else if (extra == 0) phase_cvt1(p, lds, 2, G, bid); } } SEAM(9);
    if (IN(10)) { PH_BEGIN phase_prepC(p); } SEAM(10);
    if (IN(11)) { PH_BEGIN
        { pg8::Gemm g{(const bf16_t*)(ws + WS_QN), (const bf16_t*)(ws + WS_WTUQ), NT, 12288, 1536}; pg8::StaticOrder S; S.init(NT, 12288, G, bid);
          EpiBf16Plain E{(bf16_t*)(ws + WS_Q), 12288}; pg8::gemm_phase(ldsl, g, S, E); }
        { pg8::Gemm g{(const bf16_t*)(ws + WS_CKV), (const bf16_t*)(ws + WS_WTUKV), NKV, 16384, 512}; pg8::StaticOrder S; S.init(NKV, 16384, G, bid);
          EpiBf16Plain E{(bf16_t*)(ws + WS_KV), 16384}; pg8::gemm_phase(ldsl, g, S, E); }
    } SEAM(11);
    if (IN(12)) { PH_BEGIN phase_mla_attn(p, (char*)lds); } SEAM(12);
    if (IN(13)) { PH_BEGIN pg8::Gemm g{(const bf16_t*)(ws + WS_OG), (const bf16_t*)(ws + WS_WTCOUT), NT, DM, 8192}; pg8::StaticOrder S; S.init(NT, DM, G, bid);
        EpiRes<true> E{nullptr, nullptr, (const bf16_t*)(p->out + OUT_Y), (bf16_t*)(ws + WS_Q), (const float*)(ws + WS_MOD) + 5 * 12288 + 8192}; pg8::gemm_phase(ldsl, g, S, E); } SEAM(13);
    if (IN(14)) { PH_BEGIN phase_final(p); }
#undef IN
#undef SEAM
#undef PH_BEGIN
}

extern "C" void kernel_launch(void* const* d_in, const int* in_sizes, int n_in, void* d_out, int out_size, void* d_ws, size_t ws_size, hipStream_t stream) {
    static int grid = 0;
    if (grid == 0) {
        if (n_in != 33 || out_size != (int)OUT_TOTAL || ws_size < WS_NEED) { grid = -1; return; }
        int dev = 0, cus = 0;
        if (hipGetDevice(&dev) != hipSuccess || hipDeviceGetAttribute(&cus, hipDeviceAttributeMultiprocessorCount, dev) != hipSuccess) { grid = -1; return; }
        if (hipFuncSetAttribute((const void*)fwd, hipFuncAttributeMaxDynamicSharedMemorySize, LDS_BYTES) != hipSuccess) { grid = -1; return; }
        int per_cu = 0;
        if (hipOccupancyMaxActiveBlocksPerMultiprocessor(&per_cu, (const void*)fwd, 512, LDS_BYTES) != hipSuccess || per_cu < 1) { (void)hipGetLastError(); }
        grid = cus;
    }
    if (grid < 0) return;
    (void)hipMemsetAsync((char*)d_ws + WS_CTL, 0, 65536, stream);
    Params p{};
    for (int i = 0; i < 33; ++i) p.in[i] = (const float*)d_in[i];
    p.out = (float*)d_out; p.ws = (unsigned char*)d_ws;
#if MK_PER_PHASE
#ifndef PROBE_REP
#define PROBE_REP 0
#endif
    for (int k = 0; k < NPH; ++k) { p.ph_lo = k; p.ph_hi = k + 1; const int nrep = ((PROBE_REP >> k) & 1) ? 2 : 1;
        for (int r = 0; r < nrep; ++r) hipLaunchKernelGGL(fwd, dim3(grid), dim3(512), LDS_BYTES, stream, p); }
#else
    p.ph_lo = 0; p.ph_hi = NPH; hipLaunchKernelGGL(fwd, dim3(grid), dim3(512), LDS_BYTES, stream, p);
#endif
}
#ifdef TEST_ATTN
__global__ void __launch_bounds__(512, 2) t_attn(const bf16_t* Q, const bf16_t* K, const bf16_t* V, const bf16_t* P, bf16_t* O, const bf16_t* Gt, int seq) {
    extern __shared__ __attribute__((aligned(16))) unsigned char lds2[];
    attn_body<TEST_ATTN>(Q + (size_t)blockIdx.x * 256 * TEST_ATTN::LDQ, K, V, P, O + (size_t)blockIdx.x * 256 * TEST_ATTN::LDO, Gt + (size_t)blockIdx.x * 256 * TEST_ATTN::LDG, seq, (char*)lds2);
}
#endif
```
